# Optimizing an MI355X kernel written in HIP

```python
import math
import jax
import jax.numpy as jnp
from jax import lax
import numpy as np


D_MODEL = 1024
BATCH = 2
SEQ = 16384
DEPTH = 1

DN_HEADS = 4
DN_HEAD_DIM = 128
DN_WIDTH = DN_HEADS * DN_HEAD_DIM
DN_CHUNK = 64
CONV_WIDTH = 4
SG_GROUPS = 4
SG_GROUP_DIM = 128
SG_WIDTH = SG_GROUPS * SG_GROUP_DIM
SG_CHUNK = 128
IN_SPLITS = [3 * DN_WIDTH, 4 * DN_WIDTH, 4 * DN_WIDTH + DN_HEADS, 4 * DN_WIDTH + 2 * DN_HEADS, 4 * DN_WIDTH + 2 * DN_HEADS + SG_WIDTH]
IN_COLS = 4 * DN_WIDTH + 2 * DN_HEADS + 2 * SG_WIDTH
N_EXPERTS = 256
N_EXPERT_GROUPS = 8
TOPK_GROUPS = 4
TOP_K = 8
EXPERT_HIDDEN = 256
SHARED_HIDDEN = 256
ROUTED_SCALE = 2.5
MOE_BLOCK = 128
EPS = 1e-6

kernel_name = 'hybrid_gdn_sgmlp_moe_block'


def _rmsnorm(x, w):
    xf = x.astype(jnp.float32)
    y = xf * lax.rsqrt(jnp.mean(xf * xf, axis=-1, keepdims=True) + EPS)
    return (y * w.astype(jnp.float32)).astype(x.dtype)


def _layernorm(x, w, b):
    xf = x.astype(jnp.float32)
    mu = jnp.mean(xf, axis=-1, keepdims=True)
    var = jnp.mean(jnp.square(xf - mu), axis=-1, keepdims=True)
    y = (xf - mu) * lax.rsqrt(var + EPS) * w.astype(jnp.float32) + b.astype(jnp.float32)
    return y.astype(x.dtype)


def _l2norm(x):
    return x * lax.rsqrt(jnp.sum(x * x, axis=-1, keepdims=True) + EPS)


def _causal_conv_silu(x, w):
    s = x.shape[1]
    xp = jnp.pad(x, ((0, 0), (CONV_WIDTH - 1, 0), (0, 0)))
    y = xp[:, 0:s, :] * w[0]
    for i in range(1, CONV_WIDTH):
        y = y + xp[:, i:i + s, :] * w[i]
    return jax.nn.silu(y)


def _gated_delta_rule(q, k, v, g, beta):
    b_, s, h, dk = q.shape
    dv = v.shape[-1]
    c = DN_CHUNK
    n = s // c
    q = _l2norm(q) * (dk ** -0.5)
    k = _l2norm(k)
    q = q.reshape(b_, n, c, h, dk)
    k = k.reshape(b_, n, c, h, dk)
    v = v.reshape(b_, n, c, h, dv)
    g = g.reshape(b_, n, c, h)
    beta = beta.reshape(b_, n, c, h)
    gc = jnp.cumsum(g, axis=2)
    gch = jnp.swapaxes(gc, 2, 3)
    diff = gch[..., :, None] - gch[..., None, :]
    causal = jnp.tril(jnp.ones((c, c), dtype=bool))
    strict = jnp.tril(jnp.ones((c, c), dtype=bool), -1)
    decay = jnp.where(causal, jnp.exp(jnp.where(causal, diff, 0.0)), 0.0)
    kb = k * beta[..., None]
    lmat = jnp.where(strict, jnp.einsum('bnihk,bnjhk->bnhij', kb, k) * decay, 0.0)
    rhs = jnp.concatenate([v * beta[..., None], kb * jnp.exp(gc)[..., None]], axis=-1)
    rhs = jnp.transpose(rhs, (0, 1, 3, 2, 4))
    sol = lax.linalg.triangular_solve(lmat + jnp.eye(c, dtype=jnp.float32), rhs, left_side=True, lower=True, unit_diagonal=True)
    u_c = sol[..., :dv]
    w_c = sol[..., dv:]
    qk = jnp.einsum('bnihk,bnjhk->bnhij', q, k) * decay
    q_dec = jnp.transpose(q * jnp.exp(gc)[..., None], (0, 1, 3, 2, 4))
    g_last = gc[:, :, -1, :]
    k_dec = jnp.transpose(k * jnp.exp(g_last[:, :, None, :] - gc)[..., None], (0, 1, 3, 2, 4))

    def step(state, inp):
        u_n, w_n, q_n, k_n, qk_n, gl_n = inp
        v_new = u_n - jnp.einsum('bhck,bhkv->bhcv', w_n, state)
        o = jnp.einsum('bhck,bhkv->bhcv', q_n, state) + jnp.einsum('bhij,bhjv->bhiv', qk_n, v_new)
        state = state * jnp.exp(gl_n)[..., None, None] + jnp.einsum('bhck,bhcv->bhkv', k_n, v_new)
        return state, o

    xs = tuple(jnp.moveaxis(t, 1, 0) for t in (u_c, w_c, q_dec, k_dec, qk, g_last))
    s0 = jnp.zeros((b_, h, dk, dv), jnp.float32)
    _, o = lax.scan(step, s0, xs)
    return jnp.transpose(o, (1, 0, 3, 2, 4)).reshape(b_, s, h, dv)


def _token_mixer(h, w_in, conv_w, a_log, dt_bias, dn_norm_w, sg_ln_w, sg_ln_b, sg_w, sg_b, w_branch_gate, b_branch_gate, w_proj_dn, w_proj_sg, w_out):
    b_, s, _ = h.shape
    qkv, z, a, bl, u, vg = jnp.split(h @ w_in, IN_SPLITS, axis=-1)
    qkv = _causal_conv_silu(qkv, conv_w).astype(jnp.float32).reshape(b_, s, 3, DN_HEADS, DN_HEAD_DIM)
    q = qkv[:, :, 0]
    k = qkv[:, :, 1]
    v = qkv[:, :, 2]
    beta = jax.nn.sigmoid(bl.astype(jnp.float32))
    g = -jnp.exp(a_log.astype(jnp.float32)) * jax.nn.softplus(a.astype(jnp.float32) + dt_bias.astype(jnp.float32))
    o = _gated_delta_rule(q, k, v, g, beta)
    zf = z.astype(jnp.float32).reshape(b_, s, DN_HEADS, DN_HEAD_DIM)
    y_dn = (_rmsnorm(o, dn_norm_w) * jax.nn.silu(zf)).reshape(b_, s, DN_WIDTH).astype(h.dtype)
    u = jax.nn.gelu(u, approximate=False)
    vg = _layernorm(jax.nn.gelu(vg, approximate=False), sg_ln_w, sg_ln_b)
    vg = vg.reshape(b_, s // SG_CHUNK, SG_CHUNK, SG_GROUPS, SG_GROUP_DIM)
    ws = jnp.where(jnp.tril(jnp.ones((SG_CHUNK, SG_CHUNK), dtype=bool)), sg_w, 0.0)
    mixed = jnp.einsum('gts,bnsgc->bntgc', ws.astype(vg.dtype), vg) + sg_b.T[:, :, None].astype(vg.dtype)
    y_sg = u * mixed.reshape(b_, s, SG_WIDTH)
    gate_dn, gate_sg = jnp.split(jax.nn.sigmoid(h @ w_branch_gate + b_branch_gate), 2, axis=-1)
    merged = gate_dn * (y_dn @ w_proj_dn) + gate_sg * (y_sg @ w_proj_sg)
    return merged @ w_out


def _moe(h, w_router, router_bias, w_gate, w_up, w_down, ws_gate, ws_up, ws_down):
    b_, s, d = h.shape
    t = b_ * s
    ht = h.reshape(t, d)
    scores = jax.nn.sigmoid((ht @ w_router).astype(jnp.float32))
    sel = scores + router_bias.astype(jnp.float32)
    per_group = N_EXPERTS // N_EXPERT_GROUPS
    grp_score = jnp.sum(lax.top_k(sel.reshape(t, N_EXPERT_GROUPS, per_group), 2)[0], axis=-1)
    _, top_grp = lax.top_k(grp_score, TOPK_GROUPS)
    grp_mask = jnp.sum(jax.nn.one_hot(top_grp, N_EXPERT_GROUPS, dtype=jnp.float32), axis=1) > 0
    exp_mask = jnp.repeat(grp_mask, per_group, axis=1)
    _, idx = lax.top_k(jnp.where(exp_mask, sel, -jnp.inf), TOP_K)
    wts = jnp.take_along_axis(scores, idx, axis=1)
    wts = wts / jnp.sum(wts, axis=-1, keepdims=True) * ROUTED_SCALE
    a = t * TOP_K
    flat_e = idx.reshape(a)
    flat_tok = jnp.repeat(jnp.arange(t, dtype=jnp.int32), TOP_K)
    flat_w = wts.reshape(a)
    order = jnp.argsort(flat_e)
    sorted_e = flat_e[order]
    counts = jnp.bincount(flat_e, length=N_EXPERTS)
    padded = (counts + MOE_BLOCK - 1) // MOE_BLOCK * MOE_BLOCK
    starts = jnp.cumsum(counts) - counts
    pends = jnp.cumsum(padded)
    pstarts = pends - padded
    dest = pstarts[sorted_e] + jnp.arange(a, dtype=jnp.int32) - starts[sorted_e]
    nb = -(-a // MOE_BLOCK) + N_EXPERTS
    buf_tok = jnp.full((nb * MOE_BLOCK,), t, jnp.int32).at[dest].set(flat_tok[order])
    buf_w = jnp.zeros((nb * MOE_BLOCK,), jnp.float32).at[dest].set(flat_w[order])
    blk_e = jnp.minimum(jnp.searchsorted(pends, jnp.arange(nb, dtype=jnp.int32) * MOE_BLOCK, side='right'), N_EXPERTS - 1)
    x_pad = jnp.concatenate([ht, jnp.zeros((1, d), ht.dtype)], axis=0)

    def body(acc, blk):
        tok, wt, e = blk
        xb = x_pad[tok]
        hb = jax.nn.silu(xb @ w_gate[e]) * (xb @ w_up[e])
        yb = (hb @ w_down[e]).astype(jnp.float32) * wt[:, None]
        return acc.at[tok].add(yb), None

    acc, _ = lax.scan(body, jnp.zeros((t + 1, d), jnp.float32), (buf_tok.reshape(nb, MOE_BLOCK), buf_w.reshape(nb, MOE_BLOCK), blk_e))
    shared = (jax.nn.silu(ht @ ws_gate) * (ht @ ws_up)) @ ws_down
    return (acc[:t].astype(h.dtype) + shared).reshape(b_, s, d)


def setup_inputs(seed: int = 0):
    key = jax.random.key(seed)
    ks = iter(jax.random.split(key, 40))
    f32 = jnp.float32
    L = DEPTH
    D = D_MODEL

    def nrm(shape, scale):
        return jax.random.normal(next(ks), shape, f32) * scale

    def gain(shape):
        return 1.0 + nrm(shape, 0.05)

    x = nrm((BATCH, SEQ, D), 1.0)
    c = nrm((BATCH, D), 1.0)
    dt = jnp.exp(jax.random.uniform(next(ks), (L, DN_HEADS), f32, math.log(1e-3), math.log(1e-1)))
    dt_bias = dt + jnp.log(-jnp.expm1(-dt))
    a_log = jnp.log(jax.random.uniform(next(ks), (L, DN_HEADS), f32, 1.0, 16.0))
    return {
        'x': x,
        'c': c,
        'ada_w': nrm((L, D, 6 * D), 0.3 * D ** -0.5),
        'ada_b': nrm((L, 6 * D), 0.01),
        'mix_pre_norm': gain((L, D)),
        'mix_post_norm': gain((L, D)),
        'w_in': nrm((L, D, IN_COLS), D ** -0.5),
        'conv_w': nrm((L, CONV_WIDTH, 3 * DN_WIDTH), CONV_WIDTH ** -0.5),
        'a_log': a_log,
        'dt_bias': dt_bias,
        'dn_norm_w': gain((L, DN_HEAD_DIM)),
        'sg_ln_w': gain((L, SG_WIDTH)),
        'sg_ln_b': nrm((L, SG_WIDTH), 0.01),
        'sg_w': nrm((L, SG_GROUPS, SG_CHUNK, SG_CHUNK), SG_CHUNK ** -0.5),
        'sg_b': gain((L, SG_GROUPS, SG_CHUNK)),
        'w_branch_gate': nrm((L, D, 2 * D), D ** -0.5),
        'b_branch_gate': nrm((L, 2 * D), 0.01),
        'w_proj_dn': nrm((L, DN_WIDTH, D), DN_WIDTH ** -0.5),
        'w_proj_sg': nrm((L, SG_WIDTH, D), SG_WIDTH ** -0.5),
        'w_out': nrm((L, D, D), D ** -0.5),
        'ffn_pre_norm': gain((L, D)),
        'ffn_post_norm': gain((L, D)),
        'w_router': nrm((L, D, N_EXPERTS), D ** -0.5),
        'router_bias': nrm((L, N_EXPERTS), 0.01),
        'w_exp_gate': nrm((L, N_EXPERTS, D, EXPERT_HIDDEN), D ** -0.5),
        'w_exp_up': nrm((L, N_EXPERTS, D, EXPERT_HIDDEN), D ** -0.5),
        'w_exp_down': nrm((L, N_EXPERTS, EXPERT_HIDDEN, D), EXPERT_HIDDEN ** -0.5),
        'w_sh_gate': nrm((L, D, SHARED_HIDDEN), D ** -0.5),
        'w_sh_up': nrm((L, D, SHARED_HIDDEN), D ** -0.5),
        'w_sh_down': nrm((L, SHARED_HIDDEN, D), SHARED_HIDDEN ** -0.5),
    }


def reference(x, c, ada_w, ada_b, mix_pre_norm, mix_post_norm, w_in, conv_w, a_log, dt_bias, dn_norm_w, sg_ln_w, sg_ln_b, sg_w, sg_b, w_branch_gate, b_branch_gate, w_proj_dn, w_proj_sg, w_out, ffn_pre_norm, ffn_post_norm, w_router, router_bias, w_exp_gate, w_exp_up, w_exp_down, w_sh_gate, w_sh_up, w_sh_down):
    cs = jax.nn.silu(c)
    for l in range(DEPTH):
        mod = (cs @ ada_w[l] + ada_b[l])[:, None, :]
        sh1, sc1, g1, sh2, sc2, g2 = jnp.split(mod, 6, axis=-1)
        hm = _rmsnorm(x, mix_pre_norm[l]) * (1.0 + sc1) + sh1
        y = _token_mixer(hm, w_in[l], conv_w[l], a_log[l], dt_bias[l], dn_norm_w[l], sg_ln_w[l], sg_ln_b[l], sg_w[l], sg_b[l], w_branch_gate[l], b_branch_gate[l], w_proj_dn[l], w_proj_sg[l], w_out[l])
        x = x + g1 * _rmsnorm(y, mix_post_norm[l])
        hf = _rmsnorm(x, ffn_pre_norm[l]) * (1.0 + sc2) + sh2
        y = _moe(hf, w_router[l], router_bias[l], w_exp_gate[l], w_exp_up[l], w_exp_down[l], w_sh_gate[l], w_sh_up[l], w_sh_down[l])
        x = x + g2 * _rmsnorm(y, ffn_post_norm[l])
    return x
```

```cpp
#include <hip/hip_runtime.h>
#include <hip/hip_cooperative_groups.h>
#include <cstdint>
#include <cstdio>
namespace cg = cooperative_groups;

#ifndef MEGA
#define MEGA 0
#endif

constexpr int D = 1024, NBATCH = 2, SEQ = 16384, T = NBATCH * SEQ;
constexpr int INCOLS = 3080;
constexpr int NE = 256, EH = 256;
constexpr int NT = 512;
constexpr int LCAP = 32768;

typedef unsigned short bf16_t;
__device__ __forceinline__ float bf2f(bf16_t v) { return __uint_as_float(((unsigned)v) << 16); }
__device__ __forceinline__ bf16_t f2bf(float f) { unsigned u = __float_as_uint(f); u += 0x7fffu + ((u >> 16) & 1u); return (bf16_t)(u >> 16); }

constexpr size_t MiB = 1024ull * 1024ull;
constexpr size_t OFF_HF     = 384 * MiB;
constexpr size_t OFF_LISTS  = 448 * MiB;
constexpr size_t OFF_MOD    = 480 * MiB;
constexpr size_t OFF_CNT    = 480 * MiB + 64 * 1024;
constexpr size_t OFF_G      = 481 * MiB;
constexpr size_t OFF_BETA   = 481 * MiB + 512 * 1024;
constexpr size_t OFF_WTS    = 482 * MiB;
constexpr size_t OFF_IDX    = 483 * MiB;
constexpr size_t OFF_CONTRIB= 512 * MiB;
constexpr size_t OFF_GATE   = 512 * MiB;
constexpr size_t OFF_ZS     = 640 * MiB;
constexpr size_t OFF_YSG    = 672 * MiB;
constexpr size_t OFF_O      = 704 * MiB;
constexpr size_t OFF_QKV    = 736 * MiB;
constexpr size_t OFF_UG     = 832 * MiB;
constexpr size_t OFF_VGG    = 864 * MiB;
constexpr size_t OFF_HM     = 896 * MiB;
constexpr size_t OFF_Y      = 800 * MiB;
constexpr size_t OFF_QN     = 0;
constexpr size_t OFF_KN     = 64 * MiB;
constexpr size_t OFF_VC     = 128 * MiB;
constexpr size_t OFF_VGN    = 192 * MiB;
constexpr size_t OFF_MERGED = 256 * MiB;
constexpr size_t OFF_SCORES = 0;
constexpr size_t WS_NEED    = 1024 * MiB;

struct P {
    const float *x, *c, *ada_w, *ada_b, *mix_pre, *mix_post, *w_in, *conv_w, *a_log, *dt_bias, *dn_norm_w, *sg_ln_w, *sg_ln_b,
        *sg_w, *sg_b, *w_bg, *b_bg, *w_pdn, *w_psg, *w_out, *ffn_pre, *ffn_post, *w_router, *router_bias, *w_eg, *w_eu, *w_ed,
        *w_shg, *w_shu, *w_shd;
    float* out;
    char* ws;
};

__device__ __forceinline__ float wave_sum(float v) {
#pragma unroll
    for (int o = 32; o > 0; o >>= 1) v += __shfl_xor(v, o);
    return v;
}
__device__ __forceinline__ float sigmoid_(float x) { return 1.f / (1.f + expf(-x)); }
__device__ __forceinline__ float silu_(float x) { return x / (1.f + expf(-x)); }
__device__ __forceinline__ float gelu_(float x) { return 0.5f * x * (1.f + erff(x * 0.70710678118654752f)); }
__device__ __forceinline__ float softplus_(float x) { return fmaxf(x, 0.f) + log1pf(expf(-fabsf(x))); }

template <int TOK, class Epi>
__device__ __forceinline__ void ngemm(const float* As, int K, const float* __restrict__ W, int ldw, int ncols, Epi epi) {
    for (int n = threadIdx.x; n < ncols; n += NT) {
        float acc[TOK];
#pragma unroll
        for (int i = 0; i < TOK; ++i) acc[i] = 0.f;
        const float* wp = W + n;
        for (int k = 0; k < K; k += 4) {
            const float w0 = wp[(size_t)k * ldw], w1 = wp[(size_t)(k + 1) * ldw], w2 = wp[(size_t)(k + 2) * ldw], w3 = wp[(size_t)(k + 3) * ldw];
#pragma unroll
            for (int i = 0; i < TOK; ++i) {
                const float4 a = *(const float4*)(As + i * K + k);
                acc[i] += a.x * w0 + a.y * w1 + a.z * w2 + a.w * w3;
            }
        }
#pragma unroll
        for (int i = 0; i < TOK; ++i) epi(i, n, acc[i]);
    }
}

__device__ void st_mod(const P& p) {
    const int gtid = blockIdx.x * NT + threadIdx.x, gsz = gridDim.x * NT;
    float* mod = (float*)(p.ws + OFF_MOD);
    for (int i = gtid; i < 2 * 6144; i += gsz) {
        const int b = i / 6144, j = i % 6144;
        float acc = p.ada_b[j];
        for (int k = 0; k < 1024; ++k) acc += silu_(p.c[b * 1024 + k]) * p.ada_w[(size_t)k * 6144 + j];
        mod[i] = acc;
    }
    unsigned* cnt = (unsigned*)(p.ws + OFF_CNT);
    for (int i = gtid; i < NE; i += gsz) cnt[i] = 0u;
}

__device__ void st_hm(const P& p) {
    const int lane = threadIdx.x & 63, gw = (blockIdx.x * NT + threadIdx.x) >> 6, nw = (gridDim.x * NT) >> 6;
    const float* mod = (const float*)(p.ws + OFF_MOD);
    bf16_t* hm = (bf16_t*)(p.ws + OFF_HM);
    float* gb = (float*)(p.ws + OFF_G);
    float* bb = (float*)(p.ws + OFF_BETA);
    for (int t = gw; t < T; t += nw) {
        const int b = t / SEQ;
        const float* xr = p.x + (size_t)t * D;
        float4 v[4];
        float ss = 0.f;
#pragma unroll
        for (int i = 0; i < 4; ++i) { v[i] = *(const float4*)(xr + i * 256 + lane * 4); ss += v[i].x * v[i].x + v[i].y * v[i].y + v[i].z * v[i].z + v[i].w * v[i].w; }
        ss = wave_sum(ss);
        const float rstd = rsqrtf(ss * (1.f / 1024.f) + 1e-6f);
        float ab[8];
#pragma unroll
        for (int q = 0; q < 8; ++q) ab[q] = 0.f;
#pragma unroll
        for (int i = 0; i < 4; ++i) {
            const int k0 = i * 256 + lane * 4;
            const float xv[4] = {v[i].x, v[i].y, v[i].z, v[i].w};
            float h[4];
#pragma unroll
            for (int j = 0; j < 4; ++j) {
                const int k = k0 + j;
                h[j] = xv[j] * rstd * p.mix_pre[k] * (1.f + mod[b * 6144 + 1024 + k]) + mod[b * 6144 + k];
                const float* wr = p.w_in + (size_t)k * INCOLS + 2048;
#pragma unroll
                for (int q = 0; q < 8; ++q) ab[q] += h[j] * wr[q];
            }
            ushort4 o; o.x = f2bf(h[0]); o.y = f2bf(h[1]); o.z = f2bf(h[2]); o.w = f2bf(h[3]);
            *(ushort4*)(hm + (size_t)t * D + k0) = o;
        }
#pragma unroll
        for (int q = 0; q < 8; ++q) ab[q] = wave_sum(ab[q]);
#pragma unroll
        for (int q = 0; q < 4; ++q) {
            if (lane == q) gb[t * 4 + q] = -expf(p.a_log[q]) * softplus_(ab[q] + p.dt_bias[q]);
            if (lane == 4 + q) bb[t * 4 + q] = sigmoid_(ab[4 + q]);
        }
    }
}

__device__ void st_inproj_naive(const P& p, float* lds) {
    const bf16_t* hm = (const bf16_t*)(p.ws + OFF_HM);
    bf16_t* qkv = (bf16_t*)(p.ws + OFF_QKV); bf16_t* zs = (bf16_t*)(p.ws + OFF_ZS); bf16_t* ug = (bf16_t*)(p.ws + OFF_UG);
    bf16_t* vgg = (bf16_t*)(p.ws + OFF_VGG); bf16_t* gate = (bf16_t*)(p.ws + OFF_GATE);
    for (int tile = blockIdx.x; tile < T / 16; tile += gridDim.x) {
        const int t0 = tile * 16;
        __syncthreads();
        for (int i = threadIdx.x; i < 16 * D; i += NT) lds[i] = bf2f(hm[(size_t)t0 * D + i]);
        __syncthreads();
        ngemm<16>(lds, D, p.w_in, INCOLS, INCOLS, [&](int i, int n, float acc) {
            const size_t t = t0 + i;
            if (n < 1536) qkv[t * 1536 + n] = f2bf(acc);
            else if (n < 2048) zs[t * 512 + (n - 1536)] = f2bf(silu_(acc));
            else if (n < 2056) {}
            else if (n < 2568) ug[t * 512 + (n - 2056)] = f2bf(gelu_(acc));
            else vgg[t * 512 + (n - 2568)] = f2bf(gelu_(acc));
        });
        ngemm<16>(lds, D, p.w_bg, 2048, 2048, [&](int i, int n, float acc) {
            gate[(size_t)(t0 + i) * 2048 + n] = f2bf(sigmoid_(acc + p.b_bg[n]));
        });
    }
}

__device__ void st_dnprep_naive(const P& p) {
    const int lane = threadIdx.x & 63, gw = (blockIdx.x * NT + threadIdx.x) >> 6, nw = (gridDim.x * NT) >> 6;
    const bf16_t* qkv = (const bf16_t*)(p.ws + OFF_QKV);
    float* qn = (float*)(p.ws + OFF_QN); float* kn = (float*)(p.ws + OFF_KN); float* vc = (float*)(p.ws + OFF_VC);
    for (int u = gw; u < T * 4; u += nw) {
        const int t = u >> 2, h = u & 3, s = t % SEQ;
        float r[3][2];
#pragma unroll
        for (int part = 0; part < 3; ++part)
#pragma unroll
            for (int j = 0; j < 2; ++j) {
                const int col = part * 512 + h * 128 + lane * 2 + j;
                float y = 0.f;
#pragma unroll
                for (int i = 0; i < 4; ++i) {
                    const int sp = s - 3 + i;
                    if (sp >= 0) y += bf2f(qkv[(size_t)(t - 3 + i) * 1536 + col]) * p.conv_w[i * 1536 + col];
                }
                r[part][j] = silu_(y);
            }
        const float qs = wave_sum(r[0][0] * r[0][0] + r[0][1] * r[0][1]);
        const float ks = wave_sum(r[1][0] * r[1][0] + r[1][1] * r[1][1]);
        const float qsc = rsqrtf(qs + 1e-6f) * 0.08838834764831845f, ksc = rsqrtf(ks + 1e-6f);
        const size_t o = (size_t)t * 512 + h * 128 + lane * 2;
        *(float2*)(qn + o) = make_float2(r[0][0] * qsc, r[0][1] * qsc);
        *(float2*)(kn + o) = make_float2(r[1][0] * ksc, r[1][1] * ksc);
        *(float2*)(vc + o) = make_float2(r[2][0], r[2][1]);
    }
}

__device__ void st_dnrec_naive(const P& p) {
    const int lane = threadIdx.x & 63, gw = (blockIdx.x * NT + threadIdx.x) >> 6, nw = (gridDim.x * NT) >> 6;
    const float* qn = (const float*)(p.ws + OFF_QN); const float* kn = (const float*)(p.ws + OFF_KN); const float* vc = (const float*)(p.ws + OFF_VC);
    const float* gb = (const float*)(p.ws + OFF_G); const float* bb = (const float*)(p.ws + OFF_BETA);
    bf16_t* ob = (bf16_t*)(p.ws + OFF_O);
    for (int u = gw; u < NBATCH * 4 * 128; u += nw) {
        const int b = u >> 9, h = (u >> 7) & 3, vcol = u & 127;
        float S0 = 0.f, S1 = 0.f;
        size_t t = (size_t)b * SEQ;
        float2 kk = *(const float2*)(kn + t * 512 + h * 128 + 2 * lane);
        float2 qq = *(const float2*)(qn + t * 512 + h * 128 + 2 * lane);
        float vv = vc[t * 512 + h * 128 + vcol], g = gb[t * 4 + h], be = bb[t * 4 + h];
        for (int s = 0; s < SEQ; ++s, ++t) {
            float2 kk2 = kk, qq2 = qq; float vv2 = vv, g2 = g, be2 = be;
            if (s + 1 < SEQ) {
                const size_t tn = t + 1;
                kk2 = *(const float2*)(kn + tn * 512 + h * 128 + 2 * lane);
                qq2 = *(const float2*)(qn + tn * 512 + h * 128 + 2 * lane);
                vv2 = vc[tn * 512 + h * 128 + vcol]; g2 = gb[tn * 4 + h]; be2 = bb[tn * 4 + h];
            }
            const float a = expf(g);
            const float dk = wave_sum(kk.x * S0 + kk.y * S1);
            const float dq = wave_sum(qq.x * S0 + qq.y * S1);
            const float qk = wave_sum(qq.x * kk.x + qq.y * kk.y);
            const float vnew = be * (vv - a * dk);
            const float o = a * dq + qk * vnew;
            S0 = a * S0 + kk.x * vnew; S1 = a * S1 + kk.y * vnew;
            if (lane == 0) ob[t * 512 + h * 128 + vcol] = f2bf(o);
            kk = kk2; qq = qq2; vv = vv2; g = g2; be = be2;
        }
    }
}

__device__ void st_sgln_naive(const P& p) {
    const int lane = threadIdx.x & 63, gw = (blockIdx.x * NT + threadIdx.x) >> 6, nw = (gridDim.x * NT) >> 6;
    const bf16_t* vgg = (const bf16_t*)(p.ws + OFF_VGG);
    float* vgn = (float*)(p.ws + OFF_VGN);
    for (int t = gw; t < T; t += nw) {
        float v[8]; float s = 0.f;
#pragma unroll
        for (int j = 0; j < 8; ++j) { v[j] = bf2f(vgg[(size_t)t * 512 + j * 64 + lane]); s += v[j]; }
        const float mu = wave_sum(s) * (1.f / 512.f);
        float q = 0.f;
#pragma unroll
        for (int j = 0; j < 8; ++j) { const float d = v[j] - mu; q += d * d; }
        const float rstd = rsqrtf(wave_sum(q) * (1.f / 512.f) + 1e-6f);
#pragma unroll
        for (int j = 0; j < 8; ++j) { const int c = j * 64 + lane; vgn[(size_t)t * 512 + c] = (v[j] - mu) * rstd * p.sg_ln_w[c] + p.sg_ln_b[c]; }
    }
}
__device__ void st_sgmix_naive(const P& p) {
    const int gtid = blockIdx.x * NT + threadIdx.x, gsz = gridDim.x * NT;
    const float* vgn = (const float*)(p.ws + OFF_VGN);
    const bf16_t* ug = (const bf16_t*)(p.ws + OFF_UG);
    bf16_t* ysg = (bf16_t*)(p.ws + OFF_YSG);
    for (int i = gtid; i < T * 512; i += gsz) {
        const int t = i >> 9, c = i & 511, g = c >> 7, tt = t & 127, t0 = t - tt;
        const float* w = p.sg_w + ((size_t)g * 128 + tt) * 128;
        float acc = p.sg_b[g * 128 + tt];
        for (int s = 0; s <= tt; ++s) acc += w[s] * vgn[(size_t)(t0 + s) * 512 + c];
        ysg[i] = f2bf(bf2f(ug[i]) * acc);
    }
}

__device__ void st_ydn_naive(const P& p) {
    const int lane = threadIdx.x & 63, gw = (blockIdx.x * NT + threadIdx.x) >> 6, nw = (gridDim.x * NT) >> 6;
    bf16_t* ob = (bf16_t*)(p.ws + OFF_O); const bf16_t* zs = (const bf16_t*)(p.ws + OFF_ZS);
    for (int u = gw; u < T * 4; u += nw) {
        const size_t base = (size_t)(u >> 2) * 512 + (u & 3) * 128 + lane * 2;
        const float o0 = bf2f(ob[base]), o1 = bf2f(ob[base + 1]);
        const float rstd = rsqrtf(wave_sum(o0 * o0 + o1 * o1) * (1.f / 128.f) + 1e-6f);
        ob[base] = f2bf(o0 * rstd * p.dn_norm_w[lane * 2] * bf2f(zs[base]));
        ob[base + 1] = f2bf(o1 * rstd * p.dn_norm_w[lane * 2 + 1] * bf2f(zs[base + 1]));
    }
}
__device__ void st_merged_naive(const P& p, float* lds) {
    const bf16_t* ydn = (const bf16_t*)(p.ws + OFF_O); const bf16_t* ysg = (const bf16_t*)(p.ws + OFF_YSG);
    const bf16_t* gate = (const bf16_t*)(p.ws + OFF_GATE);
    float* mg = (float*)(p.ws + OFF_MERGED);
    float* A1 = lds; float* A2 = lds + 16 * 512;
    for (int tile = blockIdx.x; tile < T / 16; tile += gridDim.x) {
        const int t0 = tile * 16;
        __syncthreads();
        for (int i = threadIdx.x; i < 16 * 512; i += NT) { A1[i] = bf2f(ydn[(size_t)t0 * 512 + i]); A2[i] = bf2f(ysg[(size_t)t0 * 512 + i]); }
        __syncthreads();
        ngemm<16>(A1, 512, p.w_pdn, D, D, [&](int i, int n, float acc) { const size_t t = t0 + i; mg[t * D + n] = bf2f(gate[t * 2048 + n]) * acc; });
        ngemm<16>(A2, 512, p.w_psg, D, D, [&](int i, int n, float acc) { const size_t t = t0 + i; mg[t * D + n] += bf2f(gate[t * 2048 + 1024 + n]) * acc; });
    }
}
__device__ void st_wout_naive(const P& p, float* lds) {
    const float* mg = (const float*)(p.ws + OFF_MERGED);
    float* y = (float*)(p.ws + OFF_Y);
    for (int tile = blockIdx.x; tile < T / 16; tile += gridDim.x) {
        const int t0 = tile * 16;
        __syncthreads();
        for (int i = threadIdx.x; i < 16 * D; i += NT) lds[i] = mg[(size_t)t0 * D + i];
        __syncthreads();
        ngemm<16>(lds, D, p.w_out, D, D, [&](int i, int n, float acc) { y[(size_t)(t0 + i) * D + n] = acc; });
    }
}
__device__ void st_x1hf(const P& p) {
    const int lane = threadIdx.x & 63, gw = (blockIdx.x * NT + threadIdx.x) >> 6, nw = (gridDim.x * NT) >> 6;
    const float* mod = (const float*)(p.ws + OFF_MOD);
    const float* y = (const float*)(p.ws + OFF_Y);
    bf16_t* hf = (bf16_t*)(p.ws + OFF_HF);
    for (int t = gw; t < T; t += nw) {
        const int b = t / SEQ;
        float4 yv[4]; float ss = 0.f;
#pragma unroll
        for (int i = 0; i < 4; ++i) { yv[i] = *(const float4*)(y + (size_t)t * D + i * 256 + lane * 4); ss += yv[i].x * yv[i].x + yv[i].y * yv[i].y + yv[i].z * yv[i].z + yv[i].w * yv[i].w; }
        const float rstd = rsqrtf(wave_sum(ss) * (1.f / 1024.f) + 1e-6f);
        float x1[16]; float s2 = 0.f;
#pragma unroll
        for (int i = 0; i < 4; ++i) {
            const int k0 = i * 256 + lane * 4;
            const float4 xv = *(const float4*)(p.x + (size_t)t * D + k0);
            const float xa[4] = {xv.x, xv.y, xv.z, xv.w}, ya[4] = {yv[i].x, yv[i].y, yv[i].z, yv[i].w};
#pragma unroll
            for (int j = 0; j < 4; ++j) {
                const int k = k0 + j;
                const float v = xa[j] + mod[b * 6144 + 2048 + k] * (ya[j] * rstd * p.mix_post[k]);
                x1[i * 4 + j] = v; s2 += v * v;
            }
            *(float4*)(p.out + (size_t)t * D + k0) = make_float4(x1[i * 4], x1[i * 4 + 1], x1[i * 4 + 2], x1[i * 4 + 3]);
        }
        const float rstd2 = rsqrtf(wave_sum(s2) * (1.f / 1024.f) + 1e-6f);
#pragma unroll
        for (int i = 0; i < 4; ++i) {
            const int k0 = i * 256 + lane * 4;
            ushort4 o; bf16_t ov[4];
#pragma unroll
            for (int j = 0; j < 4; ++j) { const int k = k0 + j; ov[j] = f2bf(x1[i * 4 + j] * rstd2 * p.ffn_pre[k] * (1.f + mod[b * 6144 + 4096 + k]) + mod[b * 6144 + 3072 + k]); }
            o.x = ov[0]; o.y = ov[1]; o.z = ov[2]; o.w = ov[3];
            *(ushort4*)(hf + (size_t)t * D + k0) = o;
        }
    }
}
__device__ void st_router_naive(const P& p, float* lds) {
    const bf16_t* hf = (const bf16_t*)(p.ws + OFF_HF);
    float* sc = (float*)(p.ws + OFF_SCORES);
    for (int tile = blockIdx.x; tile < T / 16; tile += gridDim.x) {
        const int t0 = tile * 16;
        __syncthreads();
        for (int i = threadIdx.x; i < 16 * D; i += NT) lds[i] = bf2f(hf[(size_t)t0 * D + i]);
        __syncthreads();
        ngemm<16>(lds, D, p.w_router, NE, NE, [&](int i, int n, float acc) { sc[(size_t)(t0 + i) * NE + n] = sigmoid_(acc); });
    }
}
__device__ void st_topk_naive(const P& p) {
    const int gtid = blockIdx.x * NT + threadIdx.x, gsz = gridDim.x * NT;
    const float* sc = (const float*)(p.ws + OFF_SCORES);
    unsigned* cnt = (unsigned*)(p.ws + OFF_CNT);
    int* lists = (int*)(p.ws + OFF_LISTS);
    float* wts = (float*)(p.ws + OFF_WTS); int* idxo = (int*)(p.ws + OFF_IDX);
    for (int t = gtid; t < T; t += gsz) {
        const float* s = sc + (size_t)t * NE;
        float gs[8];
#pragma unroll
        for (int g = 0; g < 8; ++g) {
            float m1 = -INFINITY, m2 = -INFINITY;
            for (int j = 0; j < 32; ++j) { const float v = s[g * 32 + j] + p.router_bias[g * 32 + j]; if (v > m1) { m2 = m1; m1 = v; } else if (v > m2) m2 = v; }
            gs[g] = m1 + m2;
        }
        unsigned gmask = 0;
#pragma unroll
        for (int g = 0; g < 8; ++g) {
            int rank = 0;
#pragma unroll
            for (int h = 0; h < 8; ++h) rank += (gs[h] > gs[g] || (gs[h] == gs[g] && h < g)) ? 1 : 0;
            if (rank < 4) gmask |= 1u << g;
        }
        float pv = INFINITY; int pi = -1;
        int sel[8]; float sw[8]; float wsum = 0.f;
#pragma unroll
        for (int k = 0; k < 8; ++k) {
            float bv = -INFINITY; int bi = 0;
            for (int e = 0; e < NE; ++e) {
                if (!((gmask >> (e >> 5)) & 1u)) continue;
                const float v = s[e] + p.router_bias[e];
                const bool elig = (v < pv) || (v == pv && e > pi);
                if (elig && v > bv) { bv = v; bi = e; }
            }
            pv = bv; pi = bi; sel[k] = bi; sw[k] = s[bi]; wsum += sw[k];
        }
        const float inv = 2.5f / wsum;
#pragma unroll
        for (int k = 0; k < 8; ++k) {
            const int e = sel[k];
            const unsigned pos = atomicAdd(&cnt[e], 1u);
            lists[(size_t)e * LCAP + pos] = t * 8 + k;
            wts[t * 8 + k] = sw[k] * inv; idxo[t * 8 + k] = e;
        }
    }
}

__device__ void st_shared_naive(const P& p, float* lds) {
    const bf16_t* hf = (const bf16_t*)(p.ws + OFF_HF);
    bf16_t* contrib = (bf16_t*)(p.ws + OFF_CONTRIB);
    float* A = lds; float* G = lds + 16 * D; float* H = G + 16 * EH;
    for (int tile = blockIdx.x; tile < T / 16; tile += gridDim.x) {
        const int t0 = tile * 16;
        __syncthreads();
        for (int i = threadIdx.x; i < 16 * D; i += NT) A[i] = bf2f(hf[(size_t)t0 * D + i]);
        __syncthreads();
        ngemm<16>(A, D, p.w_shg, EH, EH, [&](int i, int n, float acc) { G[i * EH + n] = acc; });
        ngemm<16>(A, D, p.w_shu, EH, EH, [&](int i, int n, float acc) { H[i * EH + n] = silu_(G[i * EH + n]) * acc; });
        __syncthreads();
        ngemm<16>(H, EH, p.w_shd, D, D, [&](int i, int n, float acc) { contrib[((size_t)(t0 + i) * 8) * D + n] = f2bf(acc); });
    }
}
__device__ void st_experts_naive(const P& p, float* lds) {
    const bf16_t* hf = (const bf16_t*)(p.ws + OFF_HF);
    bf16_t* contrib = (bf16_t*)(p.ws + OFF_CONTRIB);
    const unsigned* cnt = (const unsigned*)(p.ws + OFF_CNT);
    const int* lists = (const int*)(p.ws + OFF_LISTS);
    const float* wts = (const float*)(p.ws + OFF_WTS);
    float* A = lds; float* G = lds + 16 * D; float* H = G + 16 * EH;
    int* ent = (int*)(H + 16 * EH);
    int* tstart = ent + 16;
    __syncthreads();
    if (threadIdx.x == 0) { int acc = 0; for (int e = 0; e < NE; ++e) { tstart[e] = acc; acc += ((int)cnt[e] + 15) >> 4; } tstart[NE] = acc; }
    __syncthreads();
    const int ntiles = tstart[NE];
    int e = 0;
    for (int tile = blockIdx.x; tile < ntiles; tile += gridDim.x) {
        while (tstart[e + 1] <= tile) ++e;
        const int r0 = (tile - tstart[e]) * 16, ce = (int)cnt[e];
        __syncthreads();
        if (threadIdx.x < 16) ent[threadIdx.x] = (r0 + (int)threadIdx.x < ce) ? lists[(size_t)e * LCAP + r0 + threadIdx.x] : -1;
        __syncthreads();
        for (int i = threadIdx.x; i < 16 * D; i += NT) { const int en = ent[i >> 10]; A[i] = en >= 0 ? bf2f(hf[(size_t)(en >> 3) * D + (i & 1023)]) : 0.f; }
        __syncthreads();
        ngemm<16>(A, D, p.w_eg + (size_t)e * D * EH, EH, EH, [&](int i, int n, float acc) { G[i * EH + n] = acc; });
        ngemm<16>(A, D, p.w_eu + (size_t)e * D * EH, EH, EH, [&](int i, int n, float acc) { H[i * EH + n] = silu_(G[i * EH + n]) * acc; });
        __syncthreads();
        ngemm<16>(H, EH, p.w_ed + (size_t)e * EH * D, D, D, [&](int i, int n, float acc) {
            const int en = ent[i];
            if (en >= 0) {
                float v = acc * wts[en];
                bf16_t* dst = contrib + (size_t)en * D + n;
                if ((en & 7) == 0) v += bf2f(*dst);
                *dst = f2bf(v);
            }
        });
    }
}
__device__ void st_combine(const P& p) {
    const int lane = threadIdx.x & 63, gw = (blockIdx.x * NT + threadIdx.x) >> 6, nw = (gridDim.x * NT) >> 6;
    const float* mod = (const float*)(p.ws + OFF_MOD);
    const bf16_t* contrib = (const bf16_t*)(p.ws + OFF_CONTRIB);
    for (int t = gw; t < T; t += nw) {
        const int b = t / SEQ;
        float y[16];
#pragma unroll
        for (int i = 0; i < 16; ++i) y[i] = 0.f;
#pragma unroll
        for (int k = 0; k < 8; ++k) {
            const bf16_t* r = contrib + ((size_t)t * 8 + k) * D;
#pragma unroll
            for (int i = 0; i < 4; ++i) {
                const ushort4 v = *(const ushort4*)(r + i * 256 + lane * 4);
                y[i * 4] += bf2f(v.x); y[i * 4 + 1] += bf2f(v.y); y[i * 4 + 2] += bf2f(v.z); y[i * 4 + 3] += bf2f(v.w);
            }
        }
        float ss = 0.f;
#pragma unroll
        for (int i = 0; i < 16; ++i) ss += y[i] * y[i];
        const float rstd = rsqrtf(wave_sum(ss) * (1.f / 1024.f) + 1e-6f);
#pragma unroll
        for (int i = 0; i < 4; ++i) {
            const int k0 = i * 256 + lane * 4;
            float4 xv = *(const float4*)(p.out + (size_t)t * D + k0);
            xv.x += mod[b * 6144 + 5120 + k0] * (y[i * 4] * rstd * p.ffn_post[k0]);
            xv.y += mod[b * 6144 + 5120 + k0 + 1] * (y[i * 4 + 1] * rstd * p.ffn_post[k0 + 1]);
            xv.z += mod[b * 6144 + 5120 + k0 + 2] * (y[i * 4 + 2] * rstd * p.ffn_post[k0 + 2]);
            xv.w += mod[b * 6144 + 5120 + k0 + 3] * (y[i * 4 + 3] * rstd * p.ffn_post[k0 + 3]);
            *(float4*)(p.out + (size_t)t * D + k0) = xv;
        }
    }
}

constexpr int NSTAGE = 15;
template <int S> __device__ __forceinline__ void run_stage(const P& p, float* lds) {
    if constexpr (S == 0) st_mod(p);
    else if constexpr (S == 1) st_hm(p);
    else if constexpr (S == 2) st_inproj_naive(p, lds);
    else if constexpr (S == 3) { st_dnprep_naive(p); st_sgln_naive(p); }
    else if constexpr (S == 4) { st_dnrec_naive(p); st_sgmix_naive(p); }
    else if constexpr (S == 5) st_ydn_naive(p);
    else if constexpr (S == 6) st_merged_naive(p, lds);
    else if constexpr (S == 7) st_wout_naive(p, lds);
    else if constexpr (S == 8) st_x1hf(p);
    else if constexpr (S == 9) st_router_naive(p, lds);
    else if constexpr (S == 10) st_topk_naive(p);
    else if constexpr (S == 11) st_shared_naive(p, lds);
    else if constexpr (S == 12) st_experts_naive(p, lds);
    else if constexpr (S == 13) st_combine(p);
}

constexpr int LDS_BYTES = 112 * 1024;

#if !MEGA
template <int S> __global__ void __launch_bounds__(NT) k_stage(P p) {
    extern __shared__ __attribute__((aligned(16))) float lds[];
    run_stage<S>(p, lds);
}
template <int S> static void launch_all(const P& p, int grid, hipStream_t stream) {
    if constexpr (S < 14) {
        (void)hipFuncSetAttribute((const void*)k_stage<S>, hipFuncAttributeMaxDynamicSharedMemorySize, LDS_BYTES);
        k_stage<S><<<grid, NT, LDS_BYTES, stream>>>(p);
        launch_all<S + 1>(p, grid, stream);
    }
}
#else
template <int S> __device__ __forceinline__ void run_from(const P& p, float* lds, cg::grid_group& grid) {
    if constexpr (S < 14) {
        run_stage<S>(p, lds);
        if constexpr (S < 13) grid.sync();
        run_from<S + 1>(p, lds, grid);
    }
}
__global__ void __launch_bounds__(NT) k_mega(P p) {
    extern __shared__ __attribute__((aligned(16))) float lds[];
    cg::grid_group grid = cg::this_grid();
    run_from<0>(p, lds, grid);
}
#endif

extern "C" void kernel_launch(void* const* d_in, const int* in_sizes, int n_in, void* d_out, int out_size, void* d_ws, size_t ws_size,
                              hipStream_t stream) {
    if (n_in != 30 || out_size != T * D || ws_size < WS_NEED) {
        fprintf(stderr, "kernel_launch: unexpected problem (n_in %d, out %d, ws %zu)\n", n_in, out_size, ws_size);
        return;
    }
    P p{};
    const float** f = (const float**)&p;
    for (int i = 0; i < 30; ++i) f[i] = (const float*)d_in[i];
    p.out = (float*)d_out;
    p.ws = (char*)d_ws;
    static int grid = 0;
    if (!grid) {
        int dev = 0, cus = 0;
        (void)hipGetDevice(&dev);
        (void)hipDeviceGetAttribute(&cus, hipDeviceAttributeMultiprocessorCount, dev);
#if MEGA
        int per_cu = 0;
        (void)hipFuncSetAttribute((const void*)k_mega, hipFuncAttributeMaxDynamicSharedMemorySize, LDS_BYTES);
        (void)hipOccupancyMaxActiveBlocksPerMultiprocessor(&per_cu, (const void*)k_mega, NT, LDS_BYTES);
        if (per_cu < 1) per_cu = 1;
        if (per_cu > 1) per_cu = 1;
        grid = cus * per_cu;
#else
        grid = cus;
#endif
    }
#if MEGA
    void* args[] = {&p};
    hipError_t e = hipLaunchCooperativeKernel((const void*)k_mega, dim3(grid), dim3(NT), args, LDS_BYTES, stream);
    if (e != hipSuccess) fprintf(stderr, "cooperative launch failed: %s (grid %d)\n", hipGetErrorString(e), grid);
#else
    launch_all<0>(p, grid, stream);
#endif
}
```

```cpp
#include <hip/hip_runtime.h>
#include <hip/hip_cooperative_groups.h>
#include <cstdint>
#include <cstdio>
namespace cg = cooperative_groups;

#ifndef MEGA
#define MEGA 1
#ifndef IN8
#define IN8 0
#endif
#endif

constexpr int D = 1024, NBATCH = 2, SEQ = 16384, T = NBATCH * SEQ;
constexpr int INCOLS = 3080;
constexpr int NE = 256, EH = 256;
constexpr int NT = 512;
constexpr int LCAP = 32768;

typedef unsigned short bf16_t;
__device__ __forceinline__ float bf2f(bf16_t v) { return __uint_as_float(((unsigned)v) << 16); }
__device__ __forceinline__ bf16_t f2bf(float f) { unsigned u = __float_as_uint(f); u += 0x7fffu + ((u >> 16) & 1u); return (bf16_t)(u >> 16); }

constexpr size_t MiB = 1024ull * 1024ull;
constexpr size_t OFF_HF     = 384 * MiB;
constexpr size_t OFF_WT_IN8 = 192 * MiB;
constexpr size_t OFF_HM8    = 160 * MiB;
constexpr size_t OFF_HF8    = 128 * MiB;
constexpr size_t OFF_LISTS  = 448 * MiB;
constexpr size_t OFF_MOD    = 480 * MiB;
constexpr size_t OFF_CNT    = 480 * MiB + 64 * 1024;
constexpr size_t OFF_WAB    = 480 * MiB + 384 * 1024;
constexpr size_t OFF_G      = 481 * MiB;
constexpr size_t OFF_BETA   = 481 * MiB + 512 * 1024;
constexpr size_t OFF_WTS    = 482 * MiB;
constexpr size_t OFF_IDX    = 483 * MiB;
constexpr size_t OFF_CONTRIB= 512 * MiB;
constexpr size_t OFF_GATE   = 512 * MiB;
constexpr size_t OFF_ZS     = 640 * MiB;
constexpr size_t OFF_YSG    = 672 * MiB;
constexpr size_t OFF_O      = 704 * MiB;
constexpr size_t OFF_QKV    = 736 * MiB;
constexpr size_t OFF_UG     = 832 * MiB;
constexpr size_t OFF_VGG    = 864 * MiB;
constexpr size_t OFF_HM     = 896 * MiB;
constexpr size_t OFF_Y      = 800 * MiB;
constexpr size_t OFF_WT_GU  = 0;
constexpr size_t OFF_WT_D   = 256 * MiB;
constexpr size_t OFF_WT_IN  = 484 * MiB;
constexpr size_t OFF_WT_DN  = 494 * MiB;
constexpr size_t OFF_WT_SG  = 495 * MiB;
constexpr size_t OFF_WT_OUT = 496 * MiB;
constexpr size_t OFF_WT_RT  = 498 * MiB;
constexpr size_t OFF_WT_SHGU= 499 * MiB;
constexpr size_t OFF_WT_SHD = 500 * MiB;
constexpr size_t OFF_TRILW  = 501 * MiB;
constexpr size_t OFF_VC     = 960 * MiB;
constexpr size_t OFF_VGN    = 896 * MiB;
constexpr size_t OFF_SCORES = 832 * MiB;
constexpr size_t WS_NEED    = 1024 * MiB;

struct P {
    const float *x, *c, *ada_w, *ada_b, *mix_pre, *mix_post, *w_in, *conv_w, *a_log, *dt_bias, *dn_norm_w, *sg_ln_w, *sg_ln_b,
        *sg_w, *sg_b, *w_bg, *b_bg, *w_pdn, *w_psg, *w_out, *ffn_pre, *ffn_post, *w_router, *router_bias, *w_eg, *w_eu, *w_ed,
        *w_shg, *w_shu, *w_shd;
    float* out;
    char* ws;
};

__device__ __forceinline__ int tidx() { int t = threadIdx.x; asm volatile("" : "+v"(t)); return t; }
__device__ __forceinline__ float wave_sum(float v) {
#pragma unroll
    for (int o = 32; o > 0; o >>= 1) v += __shfl_xor(v, o);
    return v;
}
__device__ __forceinline__ float sigmoid_(float x) { return 1.f / (1.f + expf(-x)); }
__device__ __forceinline__ float silu_(float x) { return x / (1.f + expf(-x)); }
__device__ __forceinline__ float gelu_(float x) { return 0.5f * x * (1.f + erff(x * 0.70710678118654752f)); }
__device__ __forceinline__ float softplus_(float x) { return fmaxf(x, 0.f) + log1pf(expf(-fabsf(x))); }

typedef __bf16 bf2_t __attribute__((ext_vector_type(2)));
typedef float f2_t __attribute__((ext_vector_type(2)));
__device__ __forceinline__ unsigned pk2(float a, float b) { const f2_t v = {a, b}; return __builtin_bit_cast(unsigned, __builtin_convertvector(v, bf2_t)); }
__device__ __forceinline__ uint4 pack8(const float (&v)[8]) { return make_uint4(pk2(v[0], v[1]), pk2(v[2], v[3]), pk2(v[4], v[5]), pk2(v[6], v[7])); }

__device__ __forceinline__ void unpack8(const uint4 u, float (&o)[8]) {
    o[0] = __uint_as_float(u.x << 16); o[1] = __uint_as_float(u.x & 0xffff0000u); o[2] = __uint_as_float(u.y << 16); o[3] = __uint_as_float(u.y & 0xffff0000u);
    o[4] = __uint_as_float(u.z << 16); o[5] = __uint_as_float(u.z & 0xffff0000u); o[6] = __uint_as_float(u.w << 16); o[7] = __uint_as_float(u.w & 0xffff0000u);
}

template <int TOK, class Epi>
__device__ __forceinline__ void ngemm(const float* As, int K, const float* __restrict__ W, int ldw, int ncols, Epi epi) {
    for (int n = tidx(); n < ncols; n += NT) {
        float acc[TOK];
#pragma unroll
        for (int i = 0; i < TOK; ++i) acc[i] = 0.f;
        const float* wp = W + n;
        for (int k = 0; k < K; k += 4) {
            const float w0 = wp[(size_t)k * ldw], w1 = wp[(size_t)(k + 1) * ldw], w2 = wp[(size_t)(k + 2) * ldw], w3 = wp[(size_t)(k + 3) * ldw];
#pragma unroll
            for (int i = 0; i < TOK; ++i) {
                const float4 a = *(const float4*)(As + i * K + k);
                acc[i] += a.x * w0 + a.y * w1 + a.z * w2 + a.w * w3;
            }
        }
#pragma unroll
        for (int i = 0; i < TOK; ++i) epi(i, n, acc[i]);
    }
}

__device__ void st_mod(const P& p, float* lds) {
    const int tid = tidx(), lane = tid & 63, wid = tid >> 6;
    const int gtid = blockIdx.x * NT + tid, gsz = gridDim.x * NT;
    float* mod = (float*)(p.ws + OFF_MOD);
    for (int task = blockIdx.x; task < 192; task += gridDim.x) {
        const int b = task / 96, j = (task % 96) * 64 + lane;
        float acc = 0.f;
        for (int k = wid * 128; k < wid * 128 + 128; ++k) acc += silu_(p.c[b * 1024 + k]) * p.ada_w[(size_t)k * 6144 + j];
        __syncthreads();
        lds[wid * 64 + lane] = acc;
        __syncthreads();
        if (wid == 0) {
            float s = p.ada_b[j];
#pragma unroll
            for (int w = 0; w < 8; ++w) s += lds[w * 64 + lane];
            mod[b * 6144 + j] = s;
        }
    }
    __syncthreads();
    unsigned* cnt = (unsigned*)(p.ws + OFF_CNT);
    for (int i = gtid; i < NE; i += gsz) cnt[i] = 0u;
    unsigned* zr = (unsigned*)(p.ws + 480 * MiB + 320 * 1024);
    for (int i = gtid; i < 1024; i += gsz) zr[i] = 0u;
    float* wab = (float*)(p.ws + OFF_WAB);
    for (int i = gtid; i < 8192; i += gsz) wab[i] = p.w_in[(size_t)(i & 1023) * INCOLS + 2048 + (i >> 10)];
}

__device__ void st_hm(const P& p) {
    const int lane = tidx() & 63, gw = (blockIdx.x * NT + tidx()) >> 6, nw = (gridDim.x * NT) >> 6;
    const float* mod = (const float*)(p.ws + OFF_MOD);
    bf16_t* hm = (bf16_t*)(p.ws + OFF_HM);
    float* gb = (float*)(p.ws + OFF_G);
    float* bb = (float*)(p.ws + OFF_BETA);
    const float* wab = (const float*)(p.ws + OFF_WAB);
    const int lane0 = lane;
    for (int t = gw; t < T; t += nw) {
        int lane = lane0; asm volatile("" : "+v"(lane));
        const int b = t / SEQ;
        const float* xr = p.x + (size_t)t * D;
        float4 v[4];
        float ss = 0.f;
#pragma unroll
        for (int i = 0; i < 4; ++i) { v[i] = *(const float4*)(xr + i * 256 + lane * 4); ss += v[i].x * v[i].x + v[i].y * v[i].y + v[i].z * v[i].z + v[i].w * v[i].w; }
        ss = wave_sum(ss);
        const float rstd = rsqrtf(ss * (1.f / 1024.f) + 1e-6f);
        float ab[8];
#pragma unroll
        for (int q = 0; q < 8; ++q) ab[q] = 0.f;
#pragma unroll
        for (int i = 0; i < 4; ++i) {
            const int k0 = i * 256 + lane * 4;
            const float xv[4] = {v[i].x, v[i].y, v[i].z, v[i].w};
            const float4 mw = *(const float4*)(p.mix_pre + k0), sc = *(const float4*)(mod + b * 6144 + 1024 + k0), sh = *(const float4*)(mod + b * 6144 + k0);
            const float mwa[4] = {mw.x, mw.y, mw.z, mw.w}, sca[4] = {sc.x, sc.y, sc.z, sc.w}, sha[4] = {sh.x, sh.y, sh.z, sh.w};
            float h[4];
#pragma unroll
            for (int j = 0; j < 4; ++j) h[j] = xv[j] * rstd * mwa[j] * (1.f + sca[j]) + sha[j];
#pragma unroll
            for (int q = 0; q < 8; ++q) {
                const float4 w4 = *(const float4*)(wab + q * 1024 + k0);
                ab[q] += h[0] * w4.x + h[1] * w4.y + h[2] * w4.z + h[3] * w4.w;
            }
            if (IN8) {
                int w8 = __builtin_amdgcn_cvt_pk_fp8_f32(h[0], h[1], 0, false); w8 = __builtin_amdgcn_cvt_pk_fp8_f32(h[2], h[3], w8, true);
                *(int*)(p.ws + OFF_HM8 + (size_t)t * D + k0) = w8;
            }
            { ushort4 o; o.x = f2bf(h[0]); o.y = f2bf(h[1]); o.z = f2bf(h[2]); o.w = f2bf(h[3]);
              *(ushort4*)(hm + (size_t)t * D + k0) = o; }
        }
#pragma unroll
        for (int q = 0; q < 8; ++q) ab[q] = wave_sum(ab[q]);
#pragma unroll
        for (int q = 0; q < 4; ++q) {
            if (lane == q) gb[t * 4 + q] = -expf(p.a_log[q]) * softplus_(ab[q] + p.dt_bias[q]);
            if (lane == 4 + q) bb[t * 4 + q] = sigmoid_(ab[4 + q]);
        }
    }
}

__device__ void st_inproj_naive(const P& p, float* lds) {
    const bf16_t* hm = (const bf16_t*)(p.ws + OFF_HM);
    bf16_t* qkv = (bf16_t*)(p.ws + OFF_QKV); bf16_t* zs = (bf16_t*)(p.ws + OFF_ZS); bf16_t* ug = (bf16_t*)(p.ws + OFF_UG);
    bf16_t* vgg = (bf16_t*)(p.ws + OFF_VGG); bf16_t* gate = (bf16_t*)(p.ws + OFF_GATE);
    for (int tile = blockIdx.x; tile < T / 16; tile += gridDim.x) {
        const int t0 = tile * 16;
        __syncthreads();
        for (int i = tidx(); i < 16 * D; i += NT) lds[i] = bf2f(hm[(size_t)t0 * D + i]);
        __syncthreads();
        ngemm<16>(lds, D, p.w_in, INCOLS, INCOLS, [&](int i, int n, float acc) {
            const size_t t = t0 + i;
            if (n < 1536) qkv[t * 1536 + n] = f2bf(acc);
            else if (n < 2048) zs[t * 512 + (n - 1536)] = f2bf(silu_(acc));
            else if (n < 2056) {}
            else if (n < 2568) ug[t * 512 + (n - 2056)] = f2bf(gelu_(acc));
            else vgg[t * 512 + (n - 2568)] = f2bf(gelu_(acc));
        });
        ngemm<16>(lds, D, p.w_bg, 2048, 2048, [&](int i, int n, float acc) {
            gate[(size_t)(t0 + i) * 2048 + n] = f2bf(sigmoid_(acc + p.b_bg[n]));
        });
    }
}

__device__ void st_dnprep_naive(const P& p) {
    const int lane = tidx() & 63, gw = (blockIdx.x * NT + tidx()) >> 6, nw = (gridDim.x * NT) >> 6;
    const bf16_t* qkv = (const bf16_t*)(p.ws + OFF_QKV);
    float* qn = (p.out); float* kn = (p.out + (size_t)T * 512); float* vc = (float*)(p.ws + OFF_VC);
    for (int u = gw; u < T * 4; u += nw) {
        const int t = u >> 2, h = u & 3, s = t % SEQ;
        float r[3][2];
#pragma unroll
        for (int part = 0; part < 3; ++part)
#pragma unroll
            for (int j = 0; j < 2; ++j) {
                const int col = part * 512 + h * 128 + lane * 2 + j;
                float y = 0.f;
#pragma unroll
                for (int i = 0; i < 4; ++i) {
                    const int sp = s - 3 + i;
                    if (sp >= 0) y += bf2f(qkv[(size_t)(t - 3 + i) * 1536 + col]) * p.conv_w[i * 1536 + col];
                }
                r[part][j] = silu_(y);
            }
        const float qs = wave_sum(r[0][0] * r[0][0] + r[0][1] * r[0][1]);
        const float ks = wave_sum(r[1][0] * r[1][0] + r[1][1] * r[1][1]);
        const float qsc = rsqrtf(qs + 1e-6f) * 0.08838834764831845f, ksc = rsqrtf(ks + 1e-6f);
        const size_t o = (size_t)t * 512 + h * 128 + lane * 2;
        *(float2*)(qn + o) = make_float2(r[0][0] * qsc, r[0][1] * qsc);
        *(float2*)(kn + o) = make_float2(r[1][0] * ksc, r[1][1] * ksc);
        *(float2*)(vc + o) = make_float2(r[2][0], r[2][1]);
    }
}

__device__ void st_dnrec_naive(const P& p) {
    const int lane = tidx() & 63, gw = (blockIdx.x * NT + tidx()) >> 6, nw = (gridDim.x * NT) >> 6;
    const float* qn = (p.out); const float* kn = (p.out + (size_t)T * 512); const float* vc = (const float*)(p.ws + OFF_VC);
    const float* gb = (const float*)(p.ws + OFF_G); const float* bb = (const float*)(p.ws + OFF_BETA);
    bf16_t* ob = (bf16_t*)(p.ws + OFF_O);
    for (int u = gw; u < NBATCH * 4 * 128; u += nw) {
        const int b = u >> 9, h = (u >> 7) & 3, vcol = u & 127;
        float S0 = 0.f, S1 = 0.f;
        size_t t = (size_t)b * SEQ;
        float2 kk = *(const float2*)(kn + t * 512 + h * 128 + 2 * lane);
        float2 qq = *(const float2*)(qn + t * 512 + h * 128 + 2 * lane);
        float vv = vc[t * 512 + h * 128 + vcol], g = gb[t * 4 + h], be = bb[t * 4 + h];
        for (int s = 0; s < SEQ; ++s, ++t) {
            float2 kk2 = kk, qq2 = qq; float vv2 = vv, g2 = g, be2 = be;
            if (s + 1 < SEQ) {
                const size_t tn = t + 1;
                kk2 = *(const float2*)(kn + tn * 512 + h * 128 + 2 * lane);
                qq2 = *(const float2*)(qn + tn * 512 + h * 128 + 2 * lane);
                vv2 = vc[tn * 512 + h * 128 + vcol]; g2 = gb[tn * 4 + h]; be2 = bb[tn * 4 + h];
            }
            const float a = expf(g);
            const float dk = wave_sum(kk.x * S0 + kk.y * S1);
            const float dq = wave_sum(qq.x * S0 + qq.y * S1);
            const float qk = wave_sum(qq.x * kk.x + qq.y * kk.y);
            const float vnew = be * (vv - a * dk);
            const float o = a * dq + qk * vnew;
            S0 = a * S0 + kk.x * vnew; S1 = a * S1 + kk.y * vnew;
            if (lane == 0) ob[t * 512 + h * 128 + vcol] = f2bf(o);
            kk = kk2; qq = qq2; vv = vv2; g = g2; be = be2;
        }
    }
}

__device__ void st_sgln_naive(const P& p) {
    const int lane = tidx() & 63, gw = (blockIdx.x * NT + tidx()) >> 6, nw = (gridDim.x * NT) >> 6;
    const bf16_t* vgg = (const bf16_t*)(p.ws + OFF_VGG);
    float* vgn = (float*)(p.ws + OFF_VGN);
    for (int t = gw; t < T; t += nw) {
        float v[8]; float s = 0.f;
#pragma unroll
        for (int j = 0; j < 8; ++j) { v[j] = bf2f(vgg[(size_t)t * 512 + j * 64 + lane]); s += v[j]; }
        const float mu = wave_sum(s) * (1.f / 512.f);
        float q = 0.f;
#pragma unroll
        for (int j = 0; j < 8; ++j) { const float d = v[j] - mu; q += d * d; }
        const float rstd = rsqrtf(wave_sum(q) * (1.f / 512.f) + 1e-6f);
#pragma unroll
        for (int j = 0; j < 8; ++j) { const int c = j * 64 + lane; vgn[(size_t)t * 512 + c] = (v[j] - mu) * rstd * p.sg_ln_w[c] + p.sg_ln_b[c]; }
    }
}
__device__ void st_sgmix_naive(const P& p) {
    const int gtid = blockIdx.x * NT + tidx(), gsz = gridDim.x * NT;
    const float* vgn = (const float*)(p.ws + OFF_VGN);
    const bf16_t* ug = (const bf16_t*)(p.ws + OFF_UG);
    bf16_t* ysg = (bf16_t*)(p.ws + OFF_YSG);
    for (int i = gtid; i < T * 512; i += gsz) {
        const int t = i >> 9, c = i & 511, g = c >> 7, tt = t & 127, t0 = t - tt;
        const float* w = p.sg_w + ((size_t)g * 128 + tt) * 128;
        float acc = p.sg_b[g * 128 + tt];
        for (int s = 0; s <= tt; ++s) acc += w[s] * vgn[(size_t)(t0 + s) * 512 + c];
        ysg[i] = f2bf(bf2f(ug[i]) * acc);
    }
}

__device__ __forceinline__ void ydn_unit(const P& p, int u, int lane) {
    bf16_t* ob = (bf16_t*)(p.ws + OFF_O); const bf16_t* zs = (const bf16_t*)(p.ws + OFF_ZS);
    const size_t base = (size_t)(u >> 2) * 512 + (u & 3) * 128 + lane * 2;
    const float o0 = bf2f(ob[base]), o1 = bf2f(ob[base + 1]);
    const float rstd = rsqrtf(wave_sum(o0 * o0 + o1 * o1) * (1.f / 128.f) + 1e-6f);
    ob[base] = f2bf(o0 * rstd * p.dn_norm_w[lane * 2] * bf2f(zs[base]));
    ob[base + 1] = f2bf(o1 * rstd * p.dn_norm_w[lane * 2 + 1] * bf2f(zs[base + 1]));
}
__device__ __forceinline__ void ydn_token(const P& p, int t, int lane) {
    bf16_t* ob = (bf16_t*)(p.ws + OFF_O); const bf16_t* zs = (const bf16_t*)(p.ws + OFF_ZS);
    const float2 nw = *(const float2*)(p.dn_norm_w + lane * 2);
    unsigned ov[4], zv[4]; float ss[4];
#pragma unroll
    for (int h = 0; h < 4; ++h) { const size_t base = (size_t)t * 512 + h * 128 + lane * 2; ov[h] = *(const unsigned*)(ob + base); zv[h] = *(const unsigned*)(zs + base); }
#pragma unroll
    for (int h = 0; h < 4; ++h) { const float o0 = __uint_as_float(ov[h] << 16), o1 = __uint_as_float(ov[h] & 0xffff0000u); ss[h] = o0 * o0 + o1 * o1; }
#pragma unroll
    for (int o = 32; o > 0; o >>= 1) {
#pragma unroll
        for (int h = 0; h < 4; ++h) ss[h] += __shfl_xor(ss[h], o);
    }
#pragma unroll
    for (int h = 0; h < 4; ++h) {
        const float rstd = rsqrtf(ss[h] * (1.f / 128.f) + 1e-6f);
        const float o0 = __uint_as_float(ov[h] << 16), o1 = __uint_as_float(ov[h] & 0xffff0000u);
        *(unsigned*)(ob + (size_t)t * 512 + h * 128 + lane * 2) = pk2(o0 * rstd * nw.x * __uint_as_float(zv[h] << 16), o1 * rstd * nw.y * __uint_as_float(zv[h] & 0xffff0000u));
    }
}
__device__ void st_ydn_naive(const P& p) {
    const int lane = tidx() & 63, gw = (blockIdx.x * NT + tidx()) >> 6, nw = (gridDim.x * NT) >> 6;
    for (int u = gw; u < T * 4; u += nw) ydn_unit(p, u, lane);
}
__device__ void st_merged_naive(const P& p, float* lds) {
    const bf16_t* ydn = (const bf16_t*)(p.ws + OFF_O); const bf16_t* ysg = (const bf16_t*)(p.ws + OFF_YSG);
    const bf16_t* gate = (const bf16_t*)(p.ws + OFF_GATE);
    float* mg = (p.out);
    float* A1 = lds; float* A2 = lds + 16 * 512;
    for (int tile = blockIdx.x; tile < T / 16; tile += gridDim.x) {
        const int t0 = tile * 16;
        __syncthreads();
        for (int i = tidx(); i < 16 * 512; i += NT) { A1[i] = bf2f(ydn[(size_t)t0 * 512 + i]); A2[i] = bf2f(ysg[(size_t)t0 * 512 + i]); }
        __syncthreads();
        ngemm<16>(A1, 512, p.w_pdn, D, D, [&](int i, int n, float acc) { const size_t t = t0 + i; mg[t * D + n] = bf2f(gate[t * 2048 + n]) * acc; });
        ngemm<16>(A2, 512, p.w_psg, D, D, [&](int i, int n, float acc) { const size_t t = t0 + i; mg[t * D + n] += bf2f(gate[t * 2048 + 1024 + n]) * acc; });
    }
}
__device__ void st_wout_naive(const P& p, float* lds) {
    const float* mg = (p.out);
    float* y = (float*)(p.ws + OFF_Y);
    for (int tile = blockIdx.x; tile < T / 16; tile += gridDim.x) {
        const int t0 = tile * 16;
        __syncthreads();
        for (int i = tidx(); i < 16 * D; i += NT) lds[i] = mg[(size_t)t0 * D + i];
        __syncthreads();
        ngemm<16>(lds, D, p.w_out, D, D, [&](int i, int n, float acc) { y[(size_t)(t0 + i) * D + n] = acc; });
    }
}
__device__ __forceinline__ void x1hf_row(const P& p, int t, int lane) {
    const float* mod = (const float*)(p.ws + OFF_MOD);
    const float* y = (const float*)(p.ws + OFF_Y);
    bf16_t* hf = (bf16_t*)(p.ws + OFF_HF);
    const int b = t / SEQ;
    float4 yv[4]; float ss = 0.f;
#pragma unroll
    for (int i = 0; i < 4; ++i) { yv[i] = *(const float4*)(y + (size_t)t * D + i * 256 + lane * 4); ss += yv[i].x * yv[i].x + yv[i].y * yv[i].y + yv[i].z * yv[i].z + yv[i].w * yv[i].w; }
    const float rstd = rsqrtf(wave_sum(ss) * (1.f / 1024.f) + 1e-6f);
    float4 x1[4]; float s2 = 0.f;
#pragma unroll
    for (int i = 0; i < 4; ++i) {
        const int k0 = i * 256 + lane * 4;
        const float4 xv = *(const float4*)(p.x + (size_t)t * D + k0), g1 = *(const float4*)(mod + b * 6144 + 2048 + k0), mp = *(const float4*)(p.mix_post + k0);
        float4 v;
        v.x = xv.x + g1.x * (yv[i].x * rstd * mp.x); v.y = xv.y + g1.y * (yv[i].y * rstd * mp.y);
        v.z = xv.z + g1.z * (yv[i].z * rstd * mp.z); v.w = xv.w + g1.w * (yv[i].w * rstd * mp.w);
        x1[i] = v; s2 += v.x * v.x + v.y * v.y + v.z * v.z + v.w * v.w;
        *(float4*)(p.out + (size_t)t * D + k0) = v;
    }
    const float rstd2 = rsqrtf(wave_sum(s2) * (1.f / 1024.f) + 1e-6f);
#pragma unroll
    for (int i = 0; i < 4; ++i) {
        const int k0 = i * 256 + lane * 4;
        const float4 fp = *(const float4*)(p.ffn_pre + k0), sc = *(const float4*)(mod + b * 6144 + 4096 + k0), sh = *(const float4*)(mod + b * 6144 + 3072 + k0);
        const float h0 = x1[i].x * rstd2 * fp.x * (1.f + sc.x) + sh.x, h1 = x1[i].y * rstd2 * fp.y * (1.f + sc.y) + sh.y;
        const float h2 = x1[i].z * rstd2 * fp.z * (1.f + sc.z) + sh.z, h3 = x1[i].w * rstd2 * fp.w * (1.f + sc.w) + sh.w;
        uint2 o;
        o.x = pk2(h0, h1); o.y = pk2(h2, h3);
        *(uint2*)(hf + (size_t)t * D + k0) = o;
        int w8 = __builtin_amdgcn_cvt_pk_fp8_f32(h0, h1, 0, false); w8 = __builtin_amdgcn_cvt_pk_fp8_f32(h2, h3, w8, true);
        *(int*)(p.ws + OFF_HF8 + (size_t)t * D + k0) = w8;
    }
}
__device__ void st_x1hf(const P& p) {
    const int lane = tidx() & 63, gw = (blockIdx.x * NT + tidx()) >> 6, nw = (gridDim.x * NT) >> 6;
    for (int t = gw; t < T; t += nw) x1hf_row(p, t, lane);
}
__device__ void st_router_naive(const P& p, float* lds) {
    const bf16_t* hf = (const bf16_t*)(p.ws + OFF_HF);
    float* sc = (float*)(p.ws + OFF_SCORES);
    for (int tile = blockIdx.x; tile < T / 16; tile += gridDim.x) {
        const int t0 = tile * 16;
        __syncthreads();
        for (int i = tidx(); i < 16 * D; i += NT) lds[i] = bf2f(hf[(size_t)t0 * D + i]);
        __syncthreads();
        ngemm<16>(lds, D, p.w_router, NE, NE, [&](int i, int n, float acc) { sc[(size_t)(t0 + i) * NE + n] = sigmoid_(acc); });
    }
}
__device__ void st_topk_naive(const P& p) {
    const int gtid = blockIdx.x * NT + tidx(), gsz = gridDim.x * NT;
    const float* sc = (const float*)(p.ws + OFF_SCORES);
    unsigned* cnt = (unsigned*)(p.ws + OFF_CNT);
    int* lists = (int*)(p.ws + OFF_LISTS);
    float* wts = (float*)(p.ws + OFF_WTS); int* idxo = (int*)(p.ws + OFF_IDX);
    for (int t = gtid; t < T; t += gsz) {
        const float* s = sc + (size_t)t * NE;
        float gs[8];
#pragma unroll
        for (int g = 0; g < 8; ++g) {
            float m1 = -INFINITY, m2 = -INFINITY;
            for (int j = 0; j < 32; ++j) { const float v = s[g * 32 + j] + p.router_bias[g * 32 + j]; if (v > m1) { m2 = m1; m1 = v; } else if (v > m2) m2 = v; }
            gs[g] = m1 + m2;
        }
        unsigned gmask = 0;
#pragma unroll
        for (int g = 0; g < 8; ++g) {
            int rank = 0;
#pragma unroll
            for (int h = 0; h < 8; ++h) rank += (gs[h] > gs[g] || (gs[h] == gs[g] && h < g)) ? 1 : 0;
            if (rank < 4) gmask |= 1u << g;
        }
        float pv = INFINITY; int pi = -1;
        int sel[8]; float sw[8]; float wsum = 0.f;
#pragma unroll
        for (int k = 0; k < 8; ++k) {
            float bv = -INFINITY; int bi = 0;
            for (int e = 0; e < NE; ++e) {
                if (!((gmask >> (e >> 5)) & 1u)) continue;
                const float v = s[e] + p.router_bias[e];
                const bool elig = (v < pv) || (v == pv && e > pi);
                if (elig && v > bv) { bv = v; bi = e; }
            }
            pv = bv; pi = bi; sel[k] = bi; sw[k] = s[bi]; wsum += sw[k];
        }
        const float inv = 2.5f / wsum;
#pragma unroll
        for (int k = 0; k < 8; ++k) {
            const int e = sel[k];
            const unsigned pos = atomicAdd(&cnt[e], 1u);
            lists[(size_t)e * LCAP + pos] = t * 8 + k;
            wts[t * 8 + k] = sw[k] * inv; idxo[t * 8 + k] = e;
        }
    }
}

__device__ void st_shared_naive(const P& p, float* lds) {
    const bf16_t* hf = (const bf16_t*)(p.ws + OFF_HF);
    bf16_t* contrib = (bf16_t*)(p.ws + OFF_CONTRIB);
    float* A = lds; float* G = lds + 16 * D; float* H = G + 16 * EH;
    for (int tile = blockIdx.x; tile < T / 16; tile += gridDim.x) {
        const int t0 = tile * 16;
        __syncthreads();
        for (int i = tidx(); i < 16 * D; i += NT) A[i] = bf2f(hf[(size_t)t0 * D + i]);
        __syncthreads();
        ngemm<16>(A, D, p.w_shg, EH, EH, [&](int i, int n, float acc) { G[i * EH + n] = acc; });
        ngemm<16>(A, D, p.w_shu, EH, EH, [&](int i, int n, float acc) { H[i * EH + n] = silu_(G[i * EH + n]) * acc; });
        __syncthreads();
        ngemm<16>(H, EH, p.w_shd, D, D, [&](int i, int n, float acc) { contrib[((size_t)(t0 + i) * 8) * D + n] = f2bf(acc); });
    }
}
__device__ void st_experts_naive(const P& p, float* lds) {
    const bf16_t* hf = (const bf16_t*)(p.ws + OFF_HF);
    bf16_t* contrib = (bf16_t*)(p.ws + OFF_CONTRIB);
    const unsigned* cnt = (const unsigned*)(p.ws + OFF_CNT);
    const int* lists = (const int*)(p.ws + OFF_LISTS);
    const float* wts = (const float*)(p.ws + OFF_WTS);
    float* A = lds; float* G = lds + 16 * D; float* H = G + 16 * EH;
    int* ent = (int*)(H + 16 * EH);
    int* tstart = ent + 16;
    __syncthreads();
    if (tidx() == 0) { int acc = 0; for (int e = 0; e < NE; ++e) { tstart[e] = acc; acc += ((int)cnt[e] + 15) >> 4; } tstart[NE] = acc; }
    __syncthreads();
    const int ntiles = tstart[NE];
    int e = 0;
    for (int tile = blockIdx.x; tile < ntiles; tile += gridDim.x) {
        while (tstart[e + 1] <= tile) ++e;
        const int r0 = (tile - tstart[e]) * 16, ce = (int)cnt[e];
        __syncthreads();
        if (tidx() < 16) ent[tidx()] = (r0 + (int)tidx() < ce) ? lists[(size_t)e * LCAP + r0 + tidx()] : -1;
        __syncthreads();
        for (int i = tidx(); i < 16 * D; i += NT) { const int en = ent[i >> 10]; A[i] = en >= 0 ? bf2f(hf[(size_t)(en >> 3) * D + (i & 1023)]) : 0.f; }
        __syncthreads();
        ngemm<16>(A, D, p.w_eg + (size_t)e * D * EH, EH, EH, [&](int i, int n, float acc) { G[i * EH + n] = acc; });
        ngemm<16>(A, D, p.w_eu + (size_t)e * D * EH, EH, EH, [&](int i, int n, float acc) { H[i * EH + n] = silu_(G[i * EH + n]) * acc; });
        __syncthreads();
        ngemm<16>(H, EH, p.w_ed + (size_t)e * EH * D, D, D, [&](int i, int n, float acc) {
            const int en = ent[i];
            if (en >= 0) {
                float v = acc * wts[en];
                bf16_t* dst = contrib + (size_t)en * D + n;
                if ((en & 7) == 0) v += bf2f(*dst);
                *dst = f2bf(v);
            }
        });
    }
}
__device__ void st_combine(const P& p, bool fin) {
    const int lane0 = tidx() & 63, gw = (blockIdx.x * NT + tidx()) >> 6, nw = (gridDim.x * NT) >> 6;
    const float* mod = (const float*)(p.ws + OFF_MOD);
    const bf16_t* contrib = (const bf16_t*)(p.ws + OFF_CONTRIB);
    for (int t = gw; t < T; t += nw) {
        int lane = lane0; asm volatile("" : "+v"(lane));
        const int b = t / SEQ;
        uint4 cv[8][2];
#pragma unroll
        for (int k = 0; k < 8; ++k) {
            const bf16_t* r = contrib + ((size_t)t * 8 + k) * D + lane * 8;
            cv[k][0] = *(const uint4*)r; cv[k][1] = *(const uint4*)(r + 512);
        }
        float4 xv[4];
#pragma unroll
        for (int q = 0; q < 4; ++q) xv[q] = *(const float4*)(p.out + (size_t)t * D + (q >> 1) * 512 + lane * 8 + (q & 1) * 4);
        float y[16];
#pragma unroll
        for (int i = 0; i < 16; ++i) y[i] = 0.f;
#pragma unroll
        for (int k = 0; k < 8; ++k)
#pragma unroll
            for (int hh = 0; hh < 2; ++hh) {
                float v8[8]; unpack8(cv[k][hh], v8);
#pragma unroll
                for (int j = 0; j < 8; ++j) y[hh * 8 + j] += v8[j];
            }
        float ss = 0.f;
#pragma unroll
        for (int i = 0; i < 16; ++i) ss += y[i] * y[i];
        const float rstd = rsqrtf(wave_sum(ss) * (1.f / 1024.f) + 1e-6f);
#pragma unroll
        for (int q = 0; q < 4; ++q) {
            const int k0 = (q >> 1) * 512 + lane * 8 + (q & 1) * 4;
            const float4 g2 = *(const float4*)(mod + b * 6144 + 5120 + k0), fw = *(const float4*)(p.ffn_post + k0);
            float4 o = xv[q];
            o.x += g2.x * (y[q * 4] * rstd * fw.x); o.y += g2.y * (y[q * 4 + 1] * rstd * fw.y);
            o.z += g2.z * (y[q * 4 + 2] * rstd * fw.z); o.w += g2.w * (y[q * 4 + 3] * rstd * fw.w);
            if (fin) *(float4*)(p.out + (size_t)t * D + k0) = o;
            else if (o.x == 12345.678f) *(float4*)(p.out + (size_t)t * D + k0) = o;
        }
    }
}

typedef short bf16x8 __attribute__((ext_vector_type(8)));
typedef float f32x4 __attribute__((ext_vector_type(4)));

__device__ __forceinline__ float fexp_(float x) { return __builtin_amdgcn_exp2f(x * 1.4426950408889634f); }
__device__ __forceinline__ float fsigmoid_(float x) { return __builtin_amdgcn_rcpf(1.f + fexp_(-x)); }
__device__ __forceinline__ float fsilu_(float x) { return x * fsigmoid_(x); }
__device__ __forceinline__ float fgelu_(float v) {
    const float av = fabsf(v), t = __builtin_amdgcn_rcpf(av * 0.2316418882f + 1.0f);
    float q = t * 0.5307027145f + (-0.7265760135f); q = q * t + 0.7107068705f; q = q * t + (-0.142248368f); q = q * t + 0.127414796f; q = q * t;
    const float e = __builtin_amdgcn_exp2f((v * v) * (-0.72134752044f));
    const float m = v * (q * e);
    return v < 0.f ? m : v - m;
}

constexpr float W8_SCALE = 32.f, W8_INV = 1.f / 32.f;
struct CTile { const float* src; char* dst; int ld, ldd, esz; };
__device__ __forceinline__ CTile conv_decode(const P& p, int id) {
    const int NDENSE = 2048;
    const float* src; int ld, K, cb, kt, colbase = 0, esz = 2; char* dst; int drow0;
    if (id < NDENSE) {
        int r = id;
        if (r < 512) { src = p.w_in; ld = INCOLS; K = 1024; cb = r >> 3; kt = r & 7; dst = p.ws + OFF_WT_IN; drow0 = cb * 32; }
        else if ((r -= 512) < 256) { src = p.w_in; ld = INCOLS; K = 1024; cb = r >> 3; kt = r & 7; colbase = 2056; dst = p.ws + (IN8 ? OFF_WT_IN8 : OFF_WT_IN); drow0 = 2048 + cb * 32; esz = IN8 ? 1 : 2; }
        else if ((r -= 256) < 512) { src = p.w_bg; ld = 2048; K = 1024; cb = r >> 3; kt = r & 7; dst = p.ws + (IN8 ? OFF_WT_IN8 : OFF_WT_IN); drow0 = 3072 + cb * 32; esz = IN8 ? 1 : 2; }
        else if ((r -= 512) < 128) { src = p.w_pdn; ld = 1024; K = 512; cb = r >> 2; kt = r & 3; dst = p.ws + OFF_WT_DN; drow0 = cb * 32; }
        else if ((r -= 128) < 128) { src = p.w_psg; ld = 1024; K = 512; cb = r >> 2; kt = r & 3; dst = p.ws + OFF_WT_SG; drow0 = cb * 32; }
        else if ((r -= 128) < 256) { src = p.w_out; ld = 1024; K = 1024; cb = r >> 3; kt = r & 7; dst = p.ws + OFF_WT_OUT; drow0 = cb * 32; }
        else if ((r -= 256) < 64) { src = p.w_router; ld = 256; K = 1024; cb = r >> 3; kt = r & 7; dst = p.ws + OFF_WT_RT; drow0 = cb * 32; }
        else if ((r -= 64) < 128) { const int pp = r >> 6; r &= 63; src = pp ? p.w_shu : p.w_shg; ld = 256; K = 1024; cb = r >> 3; kt = r & 7; dst = p.ws + OFF_WT_SHGU; drow0 = (cb >> 2) * 256 + (cb & 3) * 64 + pp * 32; esz = 1; }
        else { r -= 128; src = p.w_shd; ld = 1024; K = 256; cb = r >> 1; kt = r & 1; dst = p.ws + OFF_WT_SHD; drow0 = cb * 32; esz = 1; }
    } else {
        const int r = id - NDENSE, m = r / (256 * 64), e = (r >> 6) & 255, tl = r & 63;
        esz = 1;
        if (m < 2) { src = (m ? p.w_eu : p.w_eg) + (size_t)e * 1024 * 256; ld = 256; K = 1024; cb = tl >> 3; kt = tl & 7;
                     dst = p.ws + OFF_WT_GU + (size_t)e * 512 * 1024; drow0 = (cb >> 2) * 256 + (cb & 3) * 64 + m * 32; }
        else { src = p.w_ed + (size_t)e * 256 * 1024; ld = 1024; K = 256; cb = tl >> 1; kt = tl & 1; dst = p.ws + OFF_WT_D + (size_t)e * 1024 * 256; drow0 = cb * 32; }
    }
    CTile t; t.src = src + (size_t)(kt * 128) * ld + colbase + cb * 32; t.dst = dst + ((size_t)drow0 * K + kt * 128) * esz; t.ld = ld; t.ldd = K * esz; t.esz = esz;
    return t;
}
__device__ __forceinline__ uint2 pack8_fp8(const float (&v)[8]) {
    int w0 = __builtin_amdgcn_cvt_pk_fp8_f32(v[0], v[1], 0, false); w0 = __builtin_amdgcn_cvt_pk_fp8_f32(v[2], v[3], w0, true);
    int w1 = __builtin_amdgcn_cvt_pk_fp8_f32(v[4], v[5], 0, false); w1 = __builtin_amdgcn_cvt_pk_fp8_f32(v[6], v[7], w1, true);
    return make_uint2((unsigned)w0, (unsigned)w1);
}
__device__ void st_convert(const P& p, float* lds) {
    const int tid = tidx();
    const int NTOT = 2048 + 3 * 256 * 64;
    float4 v[4][2];
    auto issue = [&](int base) {
#pragma unroll
        for (int j = 0; j < 4; ++j) {
            const CTile t = conv_decode(p, base + j);
#pragma unroll
            for (int i = 0; i < 2; ++i) v[j][i] = *(const float4*)(t.src + (size_t)((tid >> 3) + 64 * i) * t.ld + (tid & 7) * 4);
        }
    };
    if (blockIdx.x * 4 < NTOT) issue(blockIdx.x * 4);
    for (int base = blockIdx.x * 4; base < NTOT; base += gridDim.x * 4) {
        __syncthreads();
#pragma unroll
        for (int j = 0; j < 4; ++j)
#pragma unroll
            for (int i = 0; i < 2; ++i) {
                float* d = lds + j * (128 * 33) + ((tid >> 3) + 64 * i) * 33 + (tid & 7) * 4;
                d[0] = v[j][i].x; d[1] = v[j][i].y; d[2] = v[j][i].z; d[3] = v[j][i].w;
            }
        __syncthreads();
        if (base + (int)gridDim.x * 4 < NTOT) issue(base + gridDim.x * 4);
#pragma unroll
        for (int j = 0; j < 4; ++j) {
            const CTile t = conv_decode(p, base + j);
            const int n = tid >> 4, kc = tid & 15;
            float o[8];
#pragma unroll
            for (int q = 0; q < 8; ++q) o[q] = lds[j * (128 * 33) + (kc * 8 + q) * 33 + n];
            if (t.esz == 2) *(uint4*)(t.dst + (size_t)n * t.ldd + kc * 16) = pack8(o);
            else {
#pragma unroll
                for (int q = 0; q < 8; ++q) o[q] *= W8_SCALE;
                *(uint2*)(t.dst + (size_t)n * t.ldd + kc * 8) = pack8_fp8(o);
            }
        }
    }
    __syncthreads();
    bf16_t* tw = (bf16_t*)(p.ws + OFF_TRILW);
    for (int i = blockIdx.x * NT + tidx(); i < 4 * 128 * 128; i += gridDim.x * NT) { const int t = (i >> 7) & 127, s = i & 127; tw[i] = s <= t ? f2bf(p.sg_w[i]) : (bf16_t)0; }
}

constexpr int XT_BYTES = 128 * 128, WT_BYTES = 256 * 128, STG_BYTES = XT_BYTES + WT_BYTES;
constexpr size_t OFF_ZERO = 480 * MiB + 320 * 1024;
#define LAS3 __attribute__((address_space(3)))

template <class F> __device__ __forceinline__ void epi_each(const f32x4 (&acc)[4][4], F f) {
    const int lane = tidx() & 63, wid = tidx() >> 6, wr = wid >> 2, wc = wid & 3, fr = lane & 15, fg = lane >> 4;
#pragma unroll
    for (int mi = 0; mi < 4; ++mi)
#pragma unroll
        for (int pp = 0; pp < 2; ++pp) {
            const float v[8] = {acc[mi][2 * pp][0], acc[mi][2 * pp][1], acc[mi][2 * pp][2], acc[mi][2 * pp][3],
                                acc[mi][2 * pp + 1][0], acc[mi][2 * pp + 1][1], acc[mi][2 * pp + 1][2], acc[mi][2 * pp + 1][3]};
            f(wr * 64 + mi * 16 + fr, wc * 64 + pp * 32 + 8 * fg, v);
        }
}

template <bool A_LDS, class RowPtr, class WPtr, class Epi>
__device__ __forceinline__ void gemm_panel(RowPtr rp, const char* Hs, int hstride, WPtr wp, int ldw, int nk, int nv, char* stage, Epi epi) {
    const int tid = tidx(), lane = tid & 63, wid = tid >> 6, wr = wid >> 2, wc = wid & 3, fr = lane & 15, fg = lane >> 4;
    constexpr int XOFF = A_LDS ? 0 : XT_BYTES, BUFB = A_LDS ? WT_BYTES : STG_BYTES;
    const int l8 = lane >> 3, kcl = ((lane & 7) ^ l8) * 8;
    auto gload = [&](int v, int kt, int buf) {
        char* b = stage + buf * BUFB + lane * 16;
        const int k0 = kt * 64 + kcl;
        if constexpr (!A_LDS) {
#pragma unroll
            for (int i = 0; i < 2; ++i) {
                const int q = wid + 8 * i;
                __builtin_amdgcn_global_load_lds((const unsigned*)(rp(v, q * 8 + l8) + k0), (LAS3 unsigned*)(b + q * 1024), 16, 0, 0);
            }
        }
        const bf16_t* wb = wp(v) + k0;
#pragma unroll
        for (int i = 0; i < 4; ++i) {
            const int q = wid + 8 * i, rho = q * 8 + l8, ii = rho & 15;
            const int n = (rho & ~31) + 8 * (ii >> 2) + (ii & 3) + ((rho >> 2) & 4);
            __builtin_amdgcn_global_load_lds((const unsigned*)(wb + (size_t)n * ldw), (LAS3 unsigned*)(b + XOFF + q * 1024), 16, 0, 0);
        }
    };
    const int S = nk * nv;
    constexpr int NST = A_LDS ? 2 : 3;
    gload(0, 0, 0);
    if constexpr (NST == 3) { if (S > 1) gload(nk > 1 ? 0 : 1, nk > 1 ? 1 : 0, 1); }
    f32x4 acc[4][4];
    int v = 0, kt = 0;
    int vp = 0, ktp = 0;
#pragma unroll
    for (int i = 0; i < NST - 1; ++i) { if (++ktp == nk) { ktp = 0; ++vp; } }
    int bufc = 0, bufp = NST - 1;
    const int xc0 = (fg ^ (fr & 7)) * 16;
    const int wrow_off = (wc * 64 + fr) * 128;
    const int xrow_off = (wr * 64 + fr) * 128;
    bool pend = false; int vpend = 0;
    for (int s = 0; s < S; ++s) {
        if (NST == 3 && s + 1 < S) { if constexpr (A_LDS) asm volatile("s_waitcnt vmcnt(4)" ::: "memory"); else asm volatile("s_waitcnt vmcnt(6)" ::: "memory"); }
        else asm volatile("s_waitcnt vmcnt(0)" ::: "memory");
        __builtin_amdgcn_s_barrier();
        if (pend) { epi(vpend, acc); pend = false; }
        if (s + NST - 1 < S) gload(vp, ktp, bufp);
        if (kt == 0) {
#pragma unroll
            for (int mi = 0; mi < 4; ++mi)
#pragma unroll
                for (int ni = 0; ni < 4; ++ni) acc[mi][ni] = (f32x4){0.f, 0.f, 0.f, 0.f};
        }
        const char* b = stage + bufc * BUFB;
#pragma unroll
        for (int ks = 0; ks < 2; ++ks) {
            bf16x8 xf[4], wf[4];
#pragma unroll
            for (int mi = 0; mi < 4; ++mi) {
                if constexpr (A_LDS) xf[mi] = *(const bf16x8*)(Hs + (wr * 64 + mi * 16 + fr) * hstride + (kt * 64 + ks * 32 + fg * 8) * 2);
                else xf[mi] = *(const bf16x8*)(b + xrow_off + mi * 2048 + (xc0 ^ (ks * 64)));
            }
#pragma unroll
            for (int ni = 0; ni < 4; ++ni) wf[ni] = *(const bf16x8*)(b + XOFF + wrow_off + ni * 2048 + (xc0 ^ (ks * 64)));
#pragma unroll
            for (int mi = 0; mi < 4; ++mi)
#pragma unroll
                for (int ni = 0; ni < 4; ++ni) acc[mi][ni] = __builtin_amdgcn_mfma_f32_16x16x32_bf16(wf[ni], xf[mi], acc[mi][ni], 0, 0, 0);
        }
        if (kt == nk - 1) { pend = true; vpend = v; }
        if (++kt == nk) { kt = 0; ++v; }
        if (++ktp == nk) { ktp = 0; ++vp; }
        if (++bufc == NST) bufc = 0;
        if (++bufp == NST) bufp = 0;
    }
    if (pend) epi(vpend, acc);
    __syncthreads();
}

typedef unsigned char u8_t;
template <bool A_LDS, class RowPtr, class WPtr, class Epi>
__device__ __forceinline__ void gemm_panel8(RowPtr rp, const char* Hs, int hstride, WPtr wp, int ldw, int nk, int nv, char* stage, Epi epi) {
    const int tid = tidx(), lane = tid & 63, wid = __builtin_amdgcn_readfirstlane(tid >> 6), wr = wid >> 2, wc = wid & 3, fr = lane & 15, fg = lane >> 4;
    constexpr int XOFF = A_LDS ? 0 : XT_BYTES, BUFB = A_LDS ? WT_BYTES : STG_BYTES;
    const int l8 = lane >> 3;
    auto gload = [&](int v, int kt, int buf) {
        char* b = stage + buf * BUFB + lane * 16;
        if constexpr (!A_LDS) {
#pragma unroll
            for (int i = 0; i < 2; ++i) {
                const int q = wid + 8 * i, k0 = kt * 128 + (((lane & 7) ^ l8 ^ (q & 1)) << 4);
                __builtin_amdgcn_global_load_lds((const unsigned*)(rp(v, q * 8 + l8) + k0), (LAS3 unsigned*)(b + q * 1024), 16, 0, 0);
            }
        }
        const u8_t* wb = wp(v) + kt * 128;
#pragma unroll
        for (int i = 0; i < 4; ++i) {
            const int q = wid + 8 * i, rho = q * 8 + l8, ii = rho & 15;
            const int n = (rho & ~31) + 8 * (ii >> 2) + (ii & 3) + ((rho >> 2) & 4);
            __builtin_amdgcn_global_load_lds((const unsigned*)(wb + (size_t)n * ldw + (((lane & 7) ^ l8 ^ (q & 1)) << 4)), (LAS3 unsigned*)(b + XOFF + q * 1024), 16, 0, 0);
        }
    };
    const int S = nk * nv;
    gload(0, 0, 0);
    if (S > 1) gload(nk > 1 ? 0 : 1, nk > 1 ? 1 : 0, 1);
    f32x4 acc[4][4];
    int v = 0, kt = 0, vp = 0, ktp = 0;
#pragma unroll
    for (int i = 0; i < 2; ++i) { if (++ktp == nk) { ktp = 0; ++vp; } }
    int bufc = 0, bufp = 2;
    const int sw = (fr & 7) ^ (fr >> 3);
    const int wrow_off = XOFF + (wc * 64 + fr) * 128 + (fg & 1) * 8;
    const int xrow_off = (wr * 64 + fr) * 128 + (fg & 1) * 8;
    bool pend = false; int vpend = 0;
    for (int s = 0; s < S; ++s) {
        if (s + 1 < S) { if constexpr (A_LDS) asm volatile("s_waitcnt vmcnt(4)" ::: "memory"); else asm volatile("s_waitcnt vmcnt(6)" ::: "memory"); }
        else asm volatile("s_waitcnt vmcnt(0)" ::: "memory");
        __builtin_amdgcn_s_barrier();
        if (pend) { epi(vpend, acc); pend = false; }
        if (s + 2 < S) gload(vp, ktp, bufp);
        if (kt == 0) {
#pragma unroll
            for (int mi = 0; mi < 4; ++mi)
#pragma unroll
                for (int ni = 0; ni < 4; ++ni) acc[mi][ni] = (f32x4){0.f, 0.f, 0.f, 0.f};
        }
        const char* b = stage + bufc * BUFB;
#pragma unroll
        for (int ks = 0; ks < 4; ++ks) {
            long xf[4], wf[4];
            const int co = ((ks * 2 + (fg >> 1)) ^ sw) << 4;
#pragma unroll
            for (int mi = 0; mi < 4; ++mi) {
                if constexpr (A_LDS) xf[mi] = *(const long*)(Hs + (wr * 64 + mi * 16 + fr) * hstride + kt * 128 + ks * 32 + fg * 8);
                else xf[mi] = *(const long*)(b + xrow_off + mi * 2048 + co);
            }
#pragma unroll
            for (int ni = 0; ni < 4; ++ni) wf[ni] = *(const long*)(b + wrow_off + ni * 2048 + co);
#pragma unroll
            for (int mi = 0; mi < 4; ++mi)
#pragma unroll
                for (int ni = 0; ni < 4; ++ni) acc[mi][ni] = __builtin_amdgcn_mfma_f32_16x16x32_fp8_fp8(wf[ni], xf[mi], acc[mi][ni], 0, 0, 0);
        }
        if (kt == nk - 1) { pend = true; vpend = v; }
        if (++kt == nk) { kt = 0; ++v; }
        if (++ktp == nk) { ktp = 0; ++vp; }
        if (++bufc == 3) bufc = 0;
        if (++bufp == 3) bufp = 0;
    }
    if (pend) epi(vpend, acc);
    __syncthreads();
}

__device__ void st_inproj_fast(const P& p, char* lds) {
    const bf16_t* hm = (const bf16_t*)(p.ws + OFF_HM);
    const bf16_t* wt = (const bf16_t*)(p.ws + OFF_WT_IN);
    bf16_t* qkv = (bf16_t*)(p.ws + OFF_QKV); bf16_t* zs = (bf16_t*)(p.ws + OFF_ZS); bf16_t* ug = (bf16_t*)(p.ws + OFF_UG);
    bf16_t* vgg = (bf16_t*)(p.ws + OFF_VGG); bf16_t* gate = (bf16_t*)(p.ws + OFF_GATE);
    for (int panel = blockIdx.x; panel < T / 128; panel += gridDim.x) {
        const size_t t0 = (size_t)panel * 128;
        auto epi = [&](int v, const f32x4 (&acc)[4][4]) {
                              epi_each(acc, [&](int r, int c, const float (&a_)[8]) {
                                  const size_t t = t0 + r; const int col = v * 256 + c;
                                  float a[8], o[8];
#pragma unroll
                                  for (int j = 0; j < 8; ++j) a[j] = (IN8 && v >= 8) ? a_[j] * W8_INV : a_[j];
                                  if (v < 6) {
#pragma unroll
                                      for (int j = 0; j < 8; ++j) o[j] = a[j];
                                      *(uint4*)(qkv + t * 1536 + col) = pack8(o);
                                  } else if (v < 8) {
#pragma unroll
                                      for (int j = 0; j < 8; ++j) o[j] = fsilu_(a[j]);
                                      *(uint4*)(zs + t * 512 + (col - 1536)) = pack8(o);
                                  } else if (v < 12) {
#pragma unroll
                                      for (int j = 0; j < 8; ++j) o[j] = fgelu_(a[j]);
                                      if (v < 10) *(uint4*)(ug + t * 512 + (col - 2048)) = pack8(o);
                                      else *(uint4*)(vgg + t * 512 + (col - 2560)) = pack8(o);
                                  } else {
#pragma unroll
                                      for (int j = 0; j < 8; ++j) o[j] = fsigmoid_(a[j] + p.b_bg[col - 3072 + j]);
                                      *(uint4*)(gate + t * 2048 + (col - 3072)) = pack8(o);
                                  }
                              });
                          };
        if (IN8) {
            gemm_panel<false>([&](int, int r) { return hm + (t0 + r) * D; }, nullptr, 0, [&](int v) { return wt + (size_t)v * 256 * D; }, D, 16, 8, lds, epi);
            gemm_panel8<false>([&](int, int r) { return (const u8_t*)(p.ws + OFF_HM8) + (t0 + r) * D; }, nullptr, 0,
                               [&](int v) { return (const u8_t*)(p.ws + OFF_WT_IN8) + (size_t)(v + 8) * 256 * D; }, D, 8, 12, lds,
                               [&](int v, const f32x4 (&acc)[4][4]) { epi(v + 8, acc); });
        } else gemm_panel<false>([&](int, int r) { return hm + (t0 + r) * D; }, nullptr, 0, [&](int v) { return wt + (size_t)v * 256 * D; }, D, 16, 20, lds, epi);
    }
}

constexpr int HSTRIDE = 272;
constexpr int HS_BYTES = 35 * 1024;
constexpr int LDS_ENT = 150 * 1024;

template <class RowSrc, class Store>
__device__ __forceinline__ void moe_tile(RowSrc rowsrc, const u8_t* wgu, const u8_t* wd, char* lds, Store store) {
    const int lane = tidx() & 63, wid = tidx() >> 6, wr = wid >> 2, wc = wid & 3, fr = lane & 15, fg = lane >> 4;
    uint2 h0[4], h1[4];
    gemm_panel8<false>([&](int, int r) { return rowsrc(r); }, nullptr, 0, [&](int v) { return wgu + (size_t)v * 256 * D; }, D, 8, 2, lds,
                       [&](int v, const f32x4 (&acc)[4][4]) {
#pragma unroll
                           for (int mi = 0; mi < 4; ++mi) {
                               float h[8];
#pragma unroll
                               for (int j = 0; j < 4; ++j) {
                                   h[j] = fsilu_(acc[mi][0][j] * W8_INV) * (acc[mi][2][j] * W8_INV);
                                   h[4 + j] = fsilu_(acc[mi][1][j] * W8_INV) * (acc[mi][3][j] * W8_INV);
                               }
                               if (v == 0) h0[mi] = pack8_fp8(h); else h1[mi] = pack8_fp8(h);
                           }
                       });
#pragma unroll
    for (int mi = 0; mi < 4; ++mi) {
        char* hp = lds + (wr * 64 + mi * 16 + fr) * HSTRIDE + wc * 32 + 8 * fg;
        *(uint2*)(hp) = h0[mi]; *(uint2*)(hp + 128) = h1[mi];
    }
    __syncthreads();
    gemm_panel8<true>([&](int, int) { return (const u8_t*)nullptr; }, lds, HSTRIDE, [&](int v) { return wd + (size_t)v * 256 * EH; }, EH, 2, 4, lds + HS_BYTES,
                      [&](int v, const f32x4 (&acc)[4][4]) { epi_each(acc, [&](int r, int c, const float (&a)[8]) { store(r, v * 256 + c, a); }); });
}

__device__ void st_shared_fast(const P& p, char* lds) {
    const u8_t* hf8 = (const u8_t*)(p.ws + OFF_HF8);
    bf16_t* contrib = (bf16_t*)(p.ws + OFF_CONTRIB);
    for (int panel = blockIdx.x; panel < T / 128; panel += gridDim.x) {
        const size_t t0 = (size_t)panel * 128;
        moe_tile([&](int r) { return hf8 + (t0 + r) * D; }, (const u8_t*)(p.ws + OFF_WT_SHGU), (const u8_t*)(p.ws + OFF_WT_SHD), lds,
                 [&](int r, int col, const float (&a)[8]) {
                     float o[8];
#pragma unroll
                     for (int j = 0; j < 8; ++j) o[j] = a[j] * W8_INV;
                     *(uint4*)(contrib + (t0 + r) * 8 * D + col) = pack8(o);
                 });
    }
}

__device__ void st_experts_fast(const P& p, char* lds, bool fin) {
    const u8_t* hf8 = (const u8_t*)(p.ws + OFF_HF8);
    bf16_t* contrib = (bf16_t*)(p.ws + OFF_CONTRIB);
    const unsigned* cnt = (const unsigned*)(p.ws + OFF_CNT);
    const int* lists = (const int*)(p.ws + OFF_LISTS);
    const float* wts = (const float*)(p.ws + OFF_WTS);
    int* ent = (int*)(lds + LDS_ENT);
    int* tstart = ent + 128;
    __syncthreads();
    if (tidx() == 0) { int acc = 0; for (int e = 0; e < NE; ++e) { tstart[e] = acc; acc += ((int)cnt[e] + 127) >> 7; } tstart[NE] = acc; }
    __syncthreads();
    const int ntiles = tstart[NE];
    int e = 0;
    for (int tile = blockIdx.x; tile < ntiles; tile += gridDim.x) {
        while (tstart[e + 1] <= tile) ++e;
        const int r0 = (tile - tstart[e]) * 128, ce = (int)cnt[e];
        __syncthreads();
        if (tidx() < 128) ent[tidx()] = (r0 + (int)tidx() < ce) ? lists[(size_t)e * LCAP + r0 + tidx()] : -1;
        __syncthreads();
        moe_tile([&](int r) { const int en = ent[r]; return en >= 0 ? hf8 + (size_t)(en >> 3) * D : (const u8_t*)(p.ws + OFF_ZERO); },
                 (const u8_t*)(p.ws + OFF_WT_GU) + (size_t)e * 512 * D, (const u8_t*)(p.ws + OFF_WT_D) + (size_t)e * D * EH, lds,
                 [&](int r, int col, const float (&a)[8]) {
                     const int en = ent[r];
                     if (en >= 0 && fin) {
                         const float w = wts[en] * W8_INV;
                         float o[8];
#pragma unroll
                         for (int j = 0; j < 8; ++j) o[j] = a[j] * w;
                         bf16_t* dst = contrib + (size_t)en * D + col;
                         if ((en & 7) == 0) {
                             const uint4 old = *(const uint4*)dst;
                             o[0] += __uint_as_float(old.x << 16); o[1] += __uint_as_float(old.x & 0xffff0000u);
                             o[2] += __uint_as_float(old.y << 16); o[3] += __uint_as_float(old.y & 0xffff0000u);
                             o[4] += __uint_as_float(old.z << 16); o[5] += __uint_as_float(old.z & 0xffff0000u);
                             o[6] += __uint_as_float(old.w << 16); o[7] += __uint_as_float(old.w & 0xffff0000u);
                         }
                         *(uint4*)dst = pack8(o);
                     }
                 });
    }
}

constexpr size_t OFF_MERGEDB = 736 * MiB;
__device__ __forceinline__ void wg_sync() { asm volatile("s_waitcnt vmcnt(0)" ::: "memory"); __syncthreads(); }
struct TopE { float v; int e; };
__device__ __forceinline__ bool better(const TopE& a, const TopE& b) { return a.v > b.v || (a.v == b.v && a.e < b.e); }

__device__ void st_post_fast(const P& p, char* lds, bool fin) {
    const int tid = tidx(), lane = tid & 63, wid = tid >> 6, wr = wid >> 2, wc = wid & 3, fr = lane & 15, fg = lane >> 4;
    const bf16_t* ydn = (const bf16_t*)(p.ws + OFF_O); const bf16_t* ysg = (const bf16_t*)(p.ws + OFF_YSG);
    const bf16_t* gate = (const bf16_t*)(p.ws + OFF_GATE);
    bf16_t* mg = (bf16_t*)(p.ws + OFF_MERGEDB);
    float* y = (float*)(p.ws + OFF_Y);
    const bf16_t* hf = (const bf16_t*)(p.ws + OFF_HF);
    unsigned* cnt = (unsigned*)(p.ws + OFF_CNT);
    int* lists = (int*)(p.ws + OFF_LISTS);
    float* wts = (float*)(p.ws + OFF_WTS);
    float* sc = (float*)lds;
    float* bias = (float*)(lds + 131584);
    int* hist = (int*)(lds + 132608);
    int* base = (int*)(lds + 133632);
    for (int panel = blockIdx.x; panel < T / 128; panel += gridDim.x) {
        const size_t t0 = (size_t)panel * 128;
        if (fin) for (int r = wid; r < 128; r += 8) ydn_token(p, (int)t0 + r, lane);
        wg_sync();
        {
            gemm_panel<false>([&](int v, int r) { return ((v & 1) ? ysg : ydn) + (t0 + r) * 512; }, nullptr, 0,
                              [&](int v) { return (const bf16_t*)(p.ws + ((v & 1) ? OFF_WT_SG : OFF_WT_DN)) + (size_t)(v >> 1) * 256 * 512; }, 512, 8, 8, lds,
                              [&](int v, const f32x4 (&acc)[4][4]) {
                                  epi_each(acc, [&](int r, int c, const float (&a)[8]) {
                                      const size_t t = t0 + r; const int col = (v >> 1) * 256 + c;
                                      float g[8], o[8]; unpack8(*(const uint4*)(gate + t * 2048 + (v & 1) * 1024 + col), g);
                                      if (v & 1) {
                                          float m[8]; unpack8(*(const uint4*)(mg + t * D + col), m);
#pragma unroll
                                          for (int j = 0; j < 8; ++j) o[j] = m[j] + g[j] * a[j];
                                      } else {
#pragma unroll
                                          for (int j = 0; j < 8; ++j) o[j] = g[j] * a[j];
                                      }
                                      *(uint4*)(mg + t * D + col) = pack8(o);
                                  });
                              });
        }
        wg_sync();
        gemm_panel<false>([&](int, int r) { return mg + (t0 + r) * D; }, nullptr, 0, [&](int v) { return (const bf16_t*)(p.ws + OFF_WT_OUT) + (size_t)v * 256 * D; }, D, 16, 4, lds,
                          [&](int v, const f32x4 (&acc)[4][4]) {
                              epi_each(acc, [&](int r, int c, const float (&a)[8]) {
                                  float* dst = y + (t0 + r) * D + v * 256 + c;
                                  *(float4*)dst = make_float4(a[0], a[1], a[2], a[3]); *(float4*)(dst + 4) = make_float4(a[4], a[5], a[6], a[7]);
                              });
                          });
        wg_sync();
        for (int r = wid; r < 128; r += 8) x1hf_row(p, (int)t0 + r, lane);
        wg_sync();
        {
            f32x4 racc[4][4];
            gemm_panel<false>([&](int, int r) { return hf + (t0 + r) * D; }, nullptr, 0, [&](int) { return (const bf16_t*)(p.ws + OFF_WT_RT); }, D, 16, 1, lds,
                              [&](int, const f32x4 (&acc)[4][4]) {
#pragma unroll
                                  for (int mi = 0; mi < 4; ++mi)
#pragma unroll
                                      for (int ni = 0; ni < 4; ++ni) racc[mi][ni] = acc[mi][ni];
                              });
            epi_each(racc, [&](int r, int c, const float (&a)[8]) {
#pragma unroll
                for (int j = 0; j < 8; ++j) sc[r * 257 + c + j] = fsigmoid_(a[j]);
            });
        }
        { int tt = tid; asm volatile("" : "+v"(tt)); if (tt < 256) { bias[tt] = p.router_bias[tt]; hist[tt] = 0; } }
        __syncthreads();
        {
            const int tok = tid >> 2, q = tid & 3;
            const float* srow = sc + tok * 257;
            TopE l[8];
#pragma unroll
            for (int k = 0; k < 8; ++k) { l[k].v = -INFINITY; l[k].e = 1 << 30; }
            float a1 = -INFINITY, a2 = -INFINITY, b1 = -INFINITY, b2 = -INFINITY;
            for (int i = 0; i < 64; ++i) {
                const int idx = (i + 8 * q) & 63, e = 64 * q + idx;
                const float v = srow[e] + bias[e];
                if (idx < 32) { if (v > a1) { a2 = a1; a1 = v; } else if (v > a2) a2 = v; }
                else { if (v > b1) { b2 = b1; b1 = v; } else if (v > b2) b2 = v; }
            }
            const float gs0 = a1 + a2, gs1 = b1 + b2;
            int r0 = 0, r1 = 0;
#pragma unroll
            for (int h = 0; h < 8; ++h) {
                const float gh = __shfl((h & 1) ? gs1 : gs0, (lane & ~3) | (h >> 1));
                r0 += (gh > gs0 || (gh == gs0 && h < 2 * q)) ? 1 : 0;
                r1 += (gh > gs1 || (gh == gs1 && h < 2 * q + 1)) ? 1 : 0;
            }
            const bool sel0 = r0 < 4, sel1 = r1 < 4;
            for (int i = 0; i < 64; ++i) {
                const int idx = (i + 8 * q) & 63, e = 64 * q + idx;
                if (idx < 32 ? sel0 : sel1) {
                    TopE cur; cur.v = srow[e] + bias[e]; cur.e = e;
                    if (better(cur, l[7])) {
#pragma unroll
                        for (int k = 0; k < 8; ++k) if (better(cur, l[k])) { const TopE tmp = l[k]; l[k] = cur; cur = tmp; }
                    }
                }
            }
            int we[8]; float wv[8]; float wsum = 0.f;
#pragma unroll
            for (int k = 0; k < 8; ++k) {
                TopE h = l[0];
#pragma unroll
                for (int o = 1; o < 4; o <<= 1) { TopE t2; t2.v = __shfl_xor(h.v, o); t2.e = __shfl_xor(h.e, o); if (better(t2, h)) h = t2; }
                if (l[0].e == h.e) {
#pragma unroll
                    for (int j = 0; j < 7; ++j) l[j] = l[j + 1];
                    l[7].v = -INFINITY; l[7].e = 1 << 30;
                }
                we[k] = h.e; wv[k] = srow[h.e]; wsum += wv[k];
            }
            const float inv = 2.5f / wsum;
            int rk0 = 0, rk1 = 0, e0 = 0, e1 = 0; float w0 = 0.f, w1 = 0.f;
#pragma unroll
            for (int k = 0; k < 8; ++k) if ((k >> 1) == q) { if (k & 1) { e1 = we[k]; w1 = wv[k] * inv; } else { e0 = we[k]; w0 = wv[k] * inv; } }
            rk0 = atomicAdd(&hist[e0], 1); rk1 = atomicAdd(&hist[e1], 1);
            __syncthreads();
            { int tt = tid; asm volatile("" : "+v"(tt)); if (tt < 256) { const int c = hist[tt]; base[tt] = (c > 0 && fin) ? (int)atomicAdd(&cnt[tt], (unsigned)c) : 0; } }
            __syncthreads();
            const int tg = (int)t0 + tok;
            if (fin) {
            lists[(size_t)e0 * LCAP + base[e0] + rk0] = tg * 8 + 2 * q; wts[tg * 8 + 2 * q] = w0;
            lists[(size_t)e1 * LCAP + base[e1] + rk1] = tg * 8 + 2 * q + 1; wts[tg * 8 + 2 * q + 1] = w1;
            }
        }
        __syncthreads();
    }
}

constexpr size_t OFF_GL  = 480 * MiB + 128 * 1024;
constexpr size_t OFF_KDT = 960 * MiB;
constexpr size_t OFF_QKF = 992 * MiB;
constexpr int DN_HALF = 73728;
constexpr int DQS = 0, DKS = 18432, DLS = 36864, DWL = 53248, DMISC = 71680;

__device__ __forceinline__ bf16x8 pack_b(const f32x4 a, const f32x4 b) {
    const uint4 u = make_uint4(pk2(a[0], a[1]), pk2(a[2], a[3]), pk2(b[0], b[1]), pk2(b[2], b[3]));
    return __builtin_bit_cast(bf16x8, u);
}

__device__ void st_dnprep_fast(const P& p, char* lds) {
    const int tid0 = tidx();
    const bf16_t* qkv = (const bf16_t*)(p.ws + OFF_QKV);
    const float* gb = (const float*)(p.ws + OFF_G); const float* bb = (const float*)(p.ws + OFF_BETA);
    float* GL = (float*)(p.ws + OFF_GL);
    bf16_t* KDT = (bf16_t*)(p.ws + OFF_KDT); bf16_t* QKF = (bf16_t*)(p.ws + OFF_QKF);
    float* UF = p.out; bf16_t* WC = (bf16_t*)((char*)p.out + 64 * MiB); bf16_t* QD = (bf16_t*)((char*)p.out + 96 * MiB);
    for (int it = blockIdx.x; it < 1024; it += gridDim.x) {
        int tid = tid0; asm volatile("" : "+v"(tid));
        const int lane = tid & 63, wid = tid >> 6, hb = wid >> 2, hw = __builtin_amdgcn_readfirstlane(wid & 3), ht = tid & 255, fr = lane & 15, fg = lane >> 4;
        char* L = lds + hb * DN_HALF;
        bf16_t* Qs = (bf16_t*)(L + DQS); bf16_t* Ks = (bf16_t*)(L + DKS); float* Ls = (float*)(L + DLS); bf16_t* Wl = (bf16_t*)(L + DWL);
        float* gc = (float*)(L + DMISC); float* beta = gc + 64; float* egc = gc + 128; float* ekl = gc + 192; float* rnq = gc + 256;
        const int unit = it * 2 + hb, h = unit & 3, cn = unit >> 2, t0 = cn * 64, s0 = t0 % SEQ;
        __syncthreads();
        if (hw == 0) {
            const float g = gb[(t0 + lane) * 4 + h], be = bb[(t0 + lane) * 4 + h];
            float c = g;
#pragma unroll
            for (int o = 1; o < 64; o <<= 1) { const float t = __shfl_up(c, o); if (lane >= o) c += t; }
            const float gl = __shfl(c, 63);
            gc[lane] = c; beta[lane] = be; egc[lane] = expf(c); ekl[lane] = expf(gl - c);
            if (lane == 0) GL[unit] = expf(gl);
        }
        {
            const int part = ht >> 7, c = ht & 127, col = part * 512 + h * 128 + c;
            bf16_t* dstp = (part ? Ks : Qs) + c;
            float cw[4];
#pragma unroll
            for (int tap = 0; tap < 4; ++tap) cw[tap] = p.conv_w[tap * 1536 + col];
            float w0 = (s0 >= 3) ? bf2f(qkv[(size_t)(t0 - 3) * 1536 + col]) : 0.f;
            float w1 = (s0 >= 2) ? bf2f(qkv[(size_t)(t0 - 2) * 1536 + col]) : 0.f;
            float w2 = (s0 >= 1) ? bf2f(qkv[(size_t)(t0 - 1) * 1536 + col]) : 0.f;
#pragma unroll
            for (int i = 0; i < 64; ++i) {
                const float w3 = bf2f(qkv[(size_t)(t0 + i) * 1536 + col]);
                dstp[i * 144] = f2bf(fsilu_(w0 * cw[0] + w1 * cw[1] + w2 * cw[2] + w3 * cw[3]));
                w0 = w1; w1 = w2; w2 = w3;
            }
        }
        __syncthreads();
        if (ht < 128) {
            const int part = ht >> 6, row = ht & 63;
            const bf16_t* rp_ = (part ? Ks : Qs) + row * 144;
            float ss = 0.f;
#pragma unroll
            for (int q = 0; q < 16; ++q) { float v8[8]; unpack8(*(const uint4*)(rp_ + q * 8), v8);
#pragma unroll
                for (int j = 0; j < 8; ++j) ss += v8[j] * v8[j]; }
            rnq[part * 64 + row] = rsqrtf(ss + 1e-6f) * (part ? 1.f : 0.08838834764831845f);
        }
        __syncthreads();
        {
            f32x4 akk[4], aqk[4];
#pragma unroll
            for (int jt = 0; jt < 4; ++jt) { akk[jt] = (f32x4){0.f, 0.f, 0.f, 0.f}; aqk[jt] = akk[jt]; }
#pragma unroll
            for (int ks = 0; ks < 4; ++ks) {
                const bf16x8 aK = *(const bf16x8*)(Ks + (16 * hw + fr) * 144 + 32 * ks + 8 * fg);
                const bf16x8 aQ = *(const bf16x8*)(Qs + (16 * hw + fr) * 144 + 32 * ks + 8 * fg);
#pragma unroll
                for (int jt = 0; jt < 4; ++jt) {
                    if (jt <= hw) {
                        const bf16x8 bK = *(const bf16x8*)(Ks + (16 * jt + fr) * 144 + 32 * ks + 8 * fg);
                        akk[jt] = __builtin_amdgcn_mfma_f32_16x16x32_bf16(aK, bK, akk[jt], 0, 0, 0);
                        aqk[jt] = __builtin_amdgcn_mfma_f32_16x16x32_bf16(aQ, bK, aqk[jt], 0, 0, 0);
                    }
                }
            }
#pragma unroll
            for (int jt = 0; jt < 4; ++jt) {
                const int j = 16 * jt + fr;
                const float gj = gc[j], rkj = rnq[64 + j];
                float lt[4];
#pragma unroll
                for (int r = 0; r < 4; ++r) {
                    const int i = 16 * hw + 4 * fg + r;
                    const float dec = (i >= j) ? fexp_(gc[i] - gj) * rkj : 0.f;
                    lt[r] = (i > j) ? beta[i] * rnq[64 + i] * akk[jt][r] * dec : 0.f;
                    const int idx = ((hw * 2 + (j >> 5)) * 64 + ((j & 15) >> 2) * 16 + (i & 15)) * 8 + ((j >> 4) & 1) * 4 + (j & 3);
                    QKF[(size_t)unit * 4096 + idx] = f2bf(aqk[jt][r] * rnq[i] * dec);
                }
                *(float4*)(Ls + j * 64 + 16 * hw + 4 * fg) = make_float4(lt[0], lt[1], lt[2], lt[3]);
            }
        }
        __syncthreads();
        {
            float x[64];
            const int c = ht;
            if (c < 128) {
                const int col = 1024 + h * 128 + c;
                float cw[4];
#pragma unroll
                for (int tap = 0; tap < 4; ++tap) cw[tap] = p.conv_w[tap * 1536 + col];
                float w0 = (s0 >= 3) ? bf2f(qkv[(size_t)(t0 - 3) * 1536 + col]) : 0.f;
                float w1 = (s0 >= 2) ? bf2f(qkv[(size_t)(t0 - 2) * 1536 + col]) : 0.f;
                float w2 = (s0 >= 1) ? bf2f(qkv[(size_t)(t0 - 1) * 1536 + col]) : 0.f;
#pragma unroll
                for (int i = 0; i < 64; ++i) {
                    const float w3 = bf2f(qkv[(size_t)(t0 + i) * 1536 + col]);
                    x[i] = fsilu_(w0 * cw[0] + w1 * cw[1] + w2 * cw[2] + w3 * cw[3]) * beta[i];
                    w0 = w1; w1 = w2; w2 = w3;
                }
            } else {
#pragma unroll
                for (int i = 0; i < 64; ++i) x[i] = bf2f(Ks[i * 144 + (c - 128)]) * rnq[64 + i] * beta[i] * egc[i];
            }
#pragma unroll
            for (int j = 0; j < 63; ++j) {
                const float xj = x[j];
#pragma unroll
                for (int i = j + 1; i < 64; ++i) x[i] -= Ls[j * 64 + i] * xj;
                if ((j & 1) == 1) __builtin_amdgcn_sched_barrier(0);
            }
            if (c < 128) {
#pragma unroll
                for (int rt = 0; rt < 4; ++rt)
#pragma unroll
                    for (int g4 = 0; g4 < 4; ++g4)
                        *(float4*)(UF + (size_t)unit * 8192 + ((((c >> 4) * 4 + rt) * 64 + g4 * 16 + (c & 15)) << 2)) =
                            make_float4(x[16 * rt + 4 * g4], x[16 * rt + 4 * g4 + 1], x[16 * rt + 4 * g4 + 2], x[16 * rt + 4 * g4 + 3]);
            } else {
#pragma unroll
                for (int i = 0; i < 64; ++i) Wl[i * 144 + (c - 128)] = f2bf(x[i]);
            }
        }
        __syncthreads();
#pragma unroll
        for (int m = 0; m < 4; ++m) {
            const int q = ht + 256 * m, frag = q >> 6, l = q & 63, lfr = l & 15, lfg = l >> 4;
            {
                const int row = 16 * (frag >> 2) + lfr, k0 = 32 * (frag & 3) + 4 * lfg;
                const uint2 lo = *(const uint2*)(Wl + row * 144 + k0), hi = *(const uint2*)(Wl + row * 144 + k0 + 16);
                *(uint4*)(WC + (size_t)unit * 8192 + q * 8) = make_uint4(lo.x, lo.y, hi.x, hi.y);
                const uint2 ql = *(const uint2*)(Qs + row * 144 + k0), qh = *(const uint2*)(Qs + row * 144 + k0 + 16);
                const float e = egc[row] * rnq[row];
                float v[8]; unpack8(make_uint4(ql.x, ql.y, qh.x, qh.y), v);
#pragma unroll
                for (int j = 0; j < 8; ++j) v[j] *= e;
                *(uint4*)(QD + (size_t)unit * 8192 + q * 8) = pack8(v);
            }
            {
                const int kd = 16 * (frag >> 1) + lfr, c0 = 32 * (frag & 1) + 4 * lfg;
                float v[8];
#pragma unroll
                for (int j = 0; j < 8; ++j) { const int cpos = c0 + 16 * (j >> 2) + (j & 3); v[j] = bf2f(Ks[cpos * 144 + kd]) * ekl[cpos] * rnq[64 + cpos]; }
                *(uint4*)(KDT + (size_t)unit * 8192 + q * 8) = pack8(v);
            }
        }
    }
}

__device__ void st_dnscan_fast(const P& p, char* lds) {
    const int tid = tidx(), lane = tid & 63, wid = tid >> 6, fr = lane & 15, fg = lane >> 4;
    const int sb = blockIdx.x, vq = sb & 3, h = (sb >> 2) & 3, b = sb >> 4;
    const float* GL = (const float*)(p.ws + OFF_GL);
    const char* KDT = p.ws + OFF_KDT; const char* QKF = p.ws + OFF_QKF;
    const char* UF = (const char*)p.out; const char* WC = (const char*)p.out + 64 * MiB; const char* QD = (const char*)p.out + 96 * MiB;
    bf16_t* ob = (bf16_t*)(p.ws + OFF_O);
    auto dma = [&](int n, int buf) {
        const size_t unit = (size_t)((b * 256 + n) * 4 + h);
        const int lw = wid - 2;
#pragma unroll
        for (int j = 0; j < 11; ++j) {
            const int pi = lw + 6 * j;
            if (pi < 64) {
                const char* src;
                if (pi < 16) src = WC + unit * 16384 + pi * 1024;
                else if (pi < 32) src = QD + unit * 16384 + (pi - 16) * 1024;
                else if (pi < 48) src = KDT + unit * 16384 + (pi - 32) * 1024;
                else if (pi < 56) src = QKF + unit * 8192 + (pi - 48) * 1024;
                else src = UF + unit * 32768 + (size_t)(2 * vq + ((pi - 56) >> 2)) * 4096 + ((pi - 56) & 3) * 1024;
                __builtin_amdgcn_global_load_lds((const unsigned*)(src + lane * 16), (LAS3 unsigned*)(lds + buf * 65536 + pi * 1024 + lane * 16), 16, 0, 0);
            }
        }
    };
    f32x4 S[8];
#pragma unroll
    for (int k = 0; k < 8; ++k) S[k] = (f32x4){0.f, 0.f, 0.f, 0.f};
    if (wid >= 2) dma(0, 0);
    asm volatile("s_waitcnt vmcnt(0)" ::: "memory");
    __syncthreads();
    for (int n = 0; n < 256; ++n) {
        if (wid >= 2) {
            if (n + 1 < 256) dma(n + 1, (n + 1) & 1);
        } else {
            const int vs = 2 * vq + wid;
            const char* B = lds + (n & 1) * 65536 + lane * 16;
            const float egl = GL[(b * 256 + n) * 4 + h];
            bf16x8 Sb[4];
#pragma unroll
            for (int s = 0; s < 4; ++s) Sb[s] = pack_b(S[2 * s], S[2 * s + 1]);
            f32x4 vn[4], o[4];
#pragma unroll
            for (int rt = 0; rt < 4; ++rt) {
                f32x4 pm = (f32x4){0.f, 0.f, 0.f, 0.f}, qo = pm;
#pragma unroll
                for (int s = 0; s < 4; ++s) {
                    pm = __builtin_amdgcn_mfma_f32_16x16x32_bf16(*(const bf16x8*)(B + (rt * 4 + s) * 1024), Sb[s], pm, 0, 0, 0);
                    qo = __builtin_amdgcn_mfma_f32_16x16x32_bf16(*(const bf16x8*)(B + (16 + rt * 4 + s) * 1024), Sb[s], qo, 0, 0, 0);
                }
                const float4 u4 = *(const float4*)(B + (56 + 4 * wid + rt) * 1024);
                vn[rt] = (f32x4){u4.x - pm[0], u4.y - pm[1], u4.z - pm[2], u4.w - pm[3]};
                o[rt] = qo;
            }
            bf16x8 Vb[2];
            Vb[0] = pack_b(vn[0], vn[1]); Vb[1] = pack_b(vn[2], vn[3]);
#pragma unroll
            for (int rt = 0; rt < 4; ++rt)
#pragma unroll
                for (int s2 = 0; s2 < 2; ++s2) o[rt] = __builtin_amdgcn_mfma_f32_16x16x32_bf16(*(const bf16x8*)(B + (48 + rt * 2 + s2) * 1024), Vb[s2], o[rt], 0, 0, 0);
#pragma unroll
            for (int kt = 0; kt < 8; ++kt) {
                S[kt] = S[kt] * egl;
#pragma unroll
                for (int s2 = 0; s2 < 2; ++s2) S[kt] = __builtin_amdgcn_mfma_f32_16x16x32_bf16(*(const bf16x8*)(B + (32 + kt * 2 + s2) * 1024), Vb[s2], S[kt], 0, 0, 0);
            }
            const size_t t0 = (size_t)(b * 256 + n) * 64;
#pragma unroll
            for (int rt = 0; rt < 4; ++rt)
#pragma unroll
                for (int r = 0; r < 4; ++r) ob[(t0 + 16 * rt + 4 * fg + r) * 512 + h * 128 + vs * 16 + fr] = f2bf(o[rt][r]);
        }
        if (wid >= 2) asm volatile("s_waitcnt vmcnt(0)" ::: "memory");
        __builtin_amdgcn_s_barrier();
    }
}

constexpr size_t OFF_MG  = 384 * MiB;
constexpr size_t OFF_BG  = 392 * MiB;
constexpr size_t OFF_SGS = 400 * MiB;

__device__ void st_scan_l1(const P& p, char* lds) {
    const int tid = tidx(), lane = tid & 63, wid = __builtin_amdgcn_readfirstlane(tid >> 6), fr = lane & 15, fg = lane >> 4;
    const float* GL = (const float*)(p.ws + OFF_GL);
    const char* KDT = p.ws + OFF_KDT;
    const char* UF = (const char*)p.out; const char* WC = (const char*)p.out + 64 * MiB;
    for (int blk = blockIdx.x; blk < 256; blk += gridDim.x) {
        const int g2 = blk >> 1, half = blk & 1, bh = g2 >> 4, g = g2 & 15, b = bh >> 2, h = bh & 3;
        const int npieces = half ? 64 : 32;
        auto dma = [&](int i, int buf) {
            const size_t unit = (size_t)((b * 256 + g * 16 + i) * 4 + h);
            for (int pi = wid; pi < npieces; pi += 8) {
                const char* src;
                if (pi < 16) src = WC + unit * 16384 + pi * 1024;
                else if (pi < 32) src = KDT + unit * 16384 + (pi - 16) * 1024;
                else src = UF + unit * 32768 + (pi - 32) * 1024;
                __builtin_amdgcn_global_load_lds((const unsigned*)(src + lane * 16), (LAS3 unsigned*)(lds + buf * 65536 + pi * 1024 + lane * 16), 16, 0, 0);
            }
        };
        f32x4 X[8];
#pragma unroll
        for (int t = 0; t < 8; ++t)
#pragma unroll
            for (int r = 0; r < 4; ++r) X[t][r] = (!half && (16 * t + 4 * fg + r == 16 * wid + fr)) ? 1.f : 0.f;
        __syncthreads();
        dma(0, 0);
        asm volatile("s_waitcnt vmcnt(0)" ::: "memory");
        __syncthreads();
        for (int i = 0; i < 16; ++i) {
            if (i + 1 < 16) dma(i + 1, (i + 1) & 1);
            const char* B = lds + (i & 1) * 65536 + lane * 16;
            const float egl = GL[(b * 256 + g * 16 + i) * 4 + h];
            bf16x8 Xb[4];
#pragma unroll
            for (int s = 0; s < 4; ++s) Xb[s] = pack_b(X[2 * s], X[2 * s + 1]);
            f32x4 vn[4];
#pragma unroll
            for (int rt = 0; rt < 4; ++rt) {
                f32x4 pm = (f32x4){0.f, 0.f, 0.f, 0.f};
#pragma unroll
                for (int s = 0; s < 4; ++s) pm = __builtin_amdgcn_mfma_f32_16x16x32_bf16(*(const bf16x8*)(B + (rt * 4 + s) * 1024), Xb[s], pm, 0, 0, 0);
                if (half) { const float4 u4 = *(const float4*)(B + (32 + 4 * wid + rt) * 1024); vn[rt] = (f32x4){u4.x - pm[0], u4.y - pm[1], u4.z - pm[2], u4.w - pm[3]}; }
                else vn[rt] = (f32x4){-pm[0], -pm[1], -pm[2], -pm[3]};
            }
            bf16x8 Vb[2];
            Vb[0] = pack_b(vn[0], vn[1]); Vb[1] = pack_b(vn[2], vn[3]);
#pragma unroll
            for (int kt = 0; kt < 8; ++kt) {
                X[kt] = X[kt] * egl;
#pragma unroll
                for (int s2 = 0; s2 < 2; ++s2) X[kt] = __builtin_amdgcn_mfma_f32_16x16x32_bf16(*(const bf16x8*)(B + (16 + kt * 2 + s2) * 1024), Vb[s2], X[kt], 0, 0, 0);
            }
            asm volatile("s_waitcnt vmcnt(0)" ::: "memory");
            __builtin_amdgcn_s_barrier();
        }
        if (half) {
            float4* bg = (float4*)(p.ws + OFF_BG) + ((size_t)(g2 * 8 + wid) * 8) * 64 + lane;
#pragma unroll
            for (int t = 0; t < 8; ++t) bg[t * 64] = make_float4(X[t][0], X[t][1], X[t][2], X[t][3]);
        } else {
            bf16_t* Ml = (bf16_t*)lds;
#pragma unroll
            for (int t = 0; t < 8; ++t)
#pragma unroll
                for (int r = 0; r < 4; ++r) Ml[(16 * t + 4 * fg + r) * 136 + 16 * wid + fr] = f2bf(X[t][r]);
            __syncthreads();
            bf16_t* mg = (bf16_t*)(p.ws + OFF_MG) + (size_t)g2 * 16384;
#pragma unroll
            for (int m = 0; m < 4; ++m) {
                const int q = tid + 512 * m, frag = q >> 6, l = q & 63, row = 16 * (frag >> 2) + (l & 15), k0 = 32 * (frag & 3) + 4 * (l >> 4);
                const uint2 lo = *(const uint2*)(Ml + row * 136 + k0), hi = *(const uint2*)(Ml + row * 136 + k0 + 16);
                *(uint4*)(mg + q * 8) = make_uint4(lo.x, lo.y, hi.x, hi.y);
            }
        }
    }
}

__device__ void st_scan_l2(const P& p, char* lds) {
    const int tid = tidx(), lane = tid & 63, wid = __builtin_amdgcn_readfirstlane(tid >> 6);
    const int bh = blockIdx.x;
    const char* MG = p.ws + OFF_MG;
    auto dma = [&](int g, int buf) {
#pragma unroll
        for (int j = 0; j < 4; ++j) {
            const int pi = wid + 8 * j;
            __builtin_amdgcn_global_load_lds((const unsigned*)(MG + (size_t)(bh * 16 + g) * 32768 + pi * 1024 + lane * 16), (LAS3 unsigned*)(lds + buf * 32768 + pi * 1024 + lane * 16), 16, 0, 0);
        }
    };
    f32x4 S[8];
#pragma unroll
    for (int t = 0; t < 8; ++t) S[t] = (f32x4){0.f, 0.f, 0.f, 0.f};
    __syncthreads();
    dma(0, 0);
    asm volatile("s_waitcnt vmcnt(0)" ::: "memory");
    __syncthreads();
    for (int g = 0; g < 16; ++g) {
        if (g + 1 < 16) dma(g + 1, (g + 1) & 1);
        float4* sg = (float4*)(p.ws + OFF_SGS) + ((size_t)((bh * 16 + g) * 8 + wid) * 8) * 64 + lane;
        const float4* bg = (const float4*)(p.ws + OFF_BG) + ((size_t)((bh * 16 + g) * 8 + wid) * 8) * 64 + lane;
#pragma unroll
        for (int t = 0; t < 8; ++t) sg[t * 64] = make_float4(S[t][0], S[t][1], S[t][2], S[t][3]);
        const char* B = lds + (g & 1) * 32768 + lane * 16;
        bf16x8 Sb[4];
#pragma unroll
        for (int s = 0; s < 4; ++s) Sb[s] = pack_b(S[2 * s], S[2 * s + 1]);
#pragma unroll
        for (int t = 0; t < 8; ++t) {
            const float4 b4 = bg[t * 64];
            f32x4 a = (f32x4){b4.x, b4.y, b4.z, b4.w};
#pragma unroll
            for (int s = 0; s < 4; ++s) a = __builtin_amdgcn_mfma_f32_16x16x32_bf16(*(const bf16x8*)(B + (t * 4 + s) * 1024), Sb[s], a, 0, 0, 0);
            S[t] = a;
        }
        asm volatile("s_waitcnt vmcnt(0)" ::: "memory");
        __builtin_amdgcn_s_barrier();
    }
}

__device__ void st_scan_l3(const P& p, char* lds) {
    const int tid = tidx(), lane = tid & 63, wid = __builtin_amdgcn_readfirstlane(tid >> 6), fr = lane & 15, fg = lane >> 4;
    const float* GL = (const float*)(p.ws + OFF_GL);
    const char* KDT = p.ws + OFF_KDT; const char* QKF = p.ws + OFF_QKF;
    const char* UF = (const char*)p.out; const char* WC = (const char*)p.out + 64 * MiB; const char* QD = (const char*)p.out + 96 * MiB;
    bf16_t* ob = (bf16_t*)(p.ws + OFF_O);
    for (int blk = blockIdx.x; blk < 256; blk += gridDim.x) {
        const int g2 = blk >> 1, vh = blk & 1, bh = g2 >> 4, g = g2 & 15, b = bh >> 2, h = bh & 3;
        auto dma = [&](int i, int buf) {
            const size_t unit = (size_t)((b * 256 + g * 16 + i) * 4 + h);
            for (int pi = wid - 4; pi < 72; pi += 4) {
                const char* src;
                if (pi < 16) src = WC + unit * 16384 + pi * 1024;
                else if (pi < 32) src = QD + unit * 16384 + (pi - 16) * 1024;
                else if (pi < 48) src = KDT + unit * 16384 + (pi - 32) * 1024;
                else if (pi < 56) src = QKF + unit * 8192 + (pi - 48) * 1024;
                else src = UF + unit * 32768 + (size_t)vh * 16384 + (pi - 56) * 1024;
                __builtin_amdgcn_global_load_lds((const unsigned*)(src + lane * 16), (LAS3 unsigned*)(lds + buf * 73728 + pi * 1024 + lane * 16), 16, 0, 0);
            }
        };
        f32x4 S[8];
        if (wid < 4) {
            const float4* sg = (const float4*)(p.ws + OFF_SGS) + ((size_t)(g2 * 8 + vh * 4 + wid) * 8) * 64 + lane;
#pragma unroll
            for (int t = 0; t < 8; ++t) { const float4 s4 = sg[t * 64]; S[t] = (f32x4){s4.x, s4.y, s4.z, s4.w}; }
        }
        __syncthreads();
        if (wid >= 4) dma(0, 0);
        asm volatile("s_waitcnt vmcnt(0)" ::: "memory");
        __syncthreads();
        for (int i = 0; i < 16; ++i) {
            if (wid >= 4) {
                if (i + 1 < 16) dma(i + 1, (i + 1) & 1);
            } else {
                const int vs = vh * 4 + wid, n = g * 16 + i;
                const char* B = lds + (i & 1) * 73728 + lane * 16;
                const float egl = GL[(b * 256 + n) * 4 + h];
                bf16x8 Sb[4];
#pragma unroll
                for (int s = 0; s < 4; ++s) Sb[s] = pack_b(S[2 * s], S[2 * s + 1]);
                f32x4 vn[4], o[4];
#pragma unroll
                for (int rt = 0; rt < 4; ++rt) {
                    f32x4 pm = (f32x4){0.f, 0.f, 0.f, 0.f}, qo = pm;
#pragma unroll
                    for (int s = 0; s < 4; ++s) {
                        pm = __builtin_amdgcn_mfma_f32_16x16x32_bf16(*(const bf16x8*)(B + (rt * 4 + s) * 1024), Sb[s], pm, 0, 0, 0);
                        qo = __builtin_amdgcn_mfma_f32_16x16x32_bf16(*(const bf16x8*)(B + (16 + rt * 4 + s) * 1024), Sb[s], qo, 0, 0, 0);
                    }
                    const float4 u4 = *(const float4*)(B + (56 + 4 * wid + rt) * 1024);
                    vn[rt] = (f32x4){u4.x - pm[0], u4.y - pm[1], u4.z - pm[2], u4.w - pm[3]};
                    o[rt] = qo;
                }
                bf16x8 Vb[2];
                Vb[0] = pack_b(vn[0], vn[1]); Vb[1] = pack_b(vn[2], vn[3]);
#pragma unroll
                for (int rt = 0; rt < 4; ++rt)
#pragma unroll
                    for (int s2 = 0; s2 < 2; ++s2) o[rt] = __builtin_amdgcn_mfma_f32_16x16x32_bf16(*(const bf16x8*)(B + (48 + rt * 2 + s2) * 1024), Vb[s2], o[rt], 0, 0, 0);
#pragma unroll
                for (int kt = 0; kt < 8; ++kt) {
                    S[kt] = S[kt] * egl;
#pragma unroll
                    for (int s2 = 0; s2 < 2; ++s2) S[kt] = __builtin_amdgcn_mfma_f32_16x16x32_bf16(*(const bf16x8*)(B + (32 + kt * 2 + s2) * 1024), Vb[s2], S[kt], 0, 0, 0);
                }
                const size_t t0 = (size_t)(b * 256 + n) * 64;
#pragma unroll
                for (int rt = 0; rt < 4; ++rt)
#pragma unroll
                    for (int r = 0; r < 4; ++r) ob[(t0 + 16 * rt + 4 * fg + r) * 512 + h * 128 + vs * 16 + fr] = f2bf(o[rt][r]);
            }
            if (wid >= 4) asm volatile("s_waitcnt vmcnt(0)" ::: "memory");
            __builtin_amdgcn_s_barrier();
        }
    }
}

__device__ void st_sg_fast(const P& p, char* lds, int first, int stride) {
    const int tid = tidx(), lane = tid & 63, wid = tid >> 6, fr = lane & 15, fg = lane >> 4;
    const bf16_t* vgg = (const bf16_t*)(p.ws + OFF_VGG); const bf16_t* ug = (const bf16_t*)(p.ws + OFF_UG);
    const bf16_t* tw = (const bf16_t*)(p.ws + OFF_TRILW);
    bf16_t* ysg = (bf16_t*)(p.ws + OFF_YSG);
    bf16_t* XT = (bf16_t*)lds;
    float* mean = (float*)(lds + 147456); float* rstd = mean + 128;
    for (int unit = first; unit < T / 128; unit += stride) {
        const size_t t0 = (size_t)unit * 128;
        __syncthreads();
        for (int rr = 0; rr < 16; ++rr) {
            const int s = wid * 16 + rr;
            float v[8]; unpack8(*(const uint4*)(vgg + (t0 + s) * 512 + lane * 8), v);
            float sm = 0.f;
#pragma unroll
            for (int j = 0; j < 8; ++j) sm += v[j];
            const float mu = wave_sum(sm) * (1.f / 512.f);
            float q = 0.f;
#pragma unroll
            for (int j = 0; j < 8; ++j) { const float d = v[j] - mu; q += d * d; }
            const float rs = rsqrtf(wave_sum(q) * (1.f / 512.f) + 1e-6f);
            if (lane == 0) { mean[s] = mu; rstd[s] = rs; }
        }
        __syncthreads();
        {
            const int s = tid & 127, cq = tid >> 7;
            const float mu = mean[s], rs = rstd[s];
            for (int cc = 0; cc < 16; ++cc) {
                const int c = cq * 128 + cc * 8;
                float v[8]; unpack8(*(const uint4*)(vgg + (t0 + s) * 512 + c), v);
#pragma unroll
                for (int j = 0; j < 8; ++j) XT[(c + j) * 144 + s] = f2bf((v[j] - mu) * rs * p.sg_ln_w[c + j] + p.sg_ln_b[c + j]);
            }
        }
        __syncthreads();
        const int g = wid >> 1;
        const bf16_t* W = tw + (size_t)g * 128 * 128;
#pragma unroll
        for (int th = 0; th < 2; ++th) {
            f32x4 acc[4][4];
#pragma unroll
            for (int ci = 0; ci < 4; ++ci)
#pragma unroll
                for (int tt = 0; tt < 4; ++tt) acc[ci][tt] = (f32x4){0.f, 0.f, 0.f, 0.f};
#pragma unroll
            for (int ks = 0; ks < 4; ++ks) {
                if (ks <= 2 * th + 1) {
                    bf16x8 a[4], bw[4];
#pragma unroll
                    for (int ci = 0; ci < 4; ++ci) a[ci] = *(const bf16x8*)(XT + (64 * wid + (ci >> 1) * 32 + 8 * (fr >> 2) + (fr & 3) + 4 * (ci & 1)) * 144 + 32 * ks + 8 * fg);
#pragma unroll
                    for (int tt = 0; tt < 4; ++tt) bw[tt] = *(const bf16x8*)(W + (64 * th + 16 * tt + fr) * 128 + 32 * ks + 8 * fg);
#pragma unroll
                    for (int ci = 0; ci < 4; ++ci)
#pragma unroll
                        for (int tt = 0; tt < 4; ++tt)
                            if (2 * ks <= 4 * th + tt) acc[ci][tt] = __builtin_amdgcn_mfma_f32_16x16x32_bf16(a[ci], bw[tt], acc[ci][tt], 0, 0, 0);
                }
            }
#pragma unroll
            for (int pp = 0; pp < 2; ++pp)
#pragma unroll
                for (int tt = 0; tt < 4; ++tt) {
                    const int tl = 64 * th + 16 * tt + fr, c0 = 64 * wid + pp * 32 + 8 * fg;
                    const float bsv = p.sg_b[g * 128 + tl];
                    float u[8], o[8]; unpack8(*(const uint4*)(ug + (t0 + tl) * 512 + c0), u);
#pragma unroll
                    for (int j = 0; j < 4; ++j) { o[j] = u[j] * (acc[2 * pp][tt][j] + bsv); o[4 + j] = u[4 + j] * (acc[2 * pp + 1][tt][j] + bsv); }
                    *(uint4*)(ysg + (t0 + tl) * 512 + c0) = pack8(o);
                }
        }
    }
}

#define XB_TMO      128
#define XB_XCNT(j)  (256  + 64 * (j))
#define XB_XSUB(j)  (1280 + 64 * (j))
#define XB_XGEN(j)  (2304 + 64 * (j))
#define XB_TOP      3328
#define XB_TOPGEN   3392
#define XCD_BAR_WORDS 3456
#define XB_SPIN_CAP (1u << 18)
#define LAS __attribute__((address_space(3)))

__device__ __forceinline__ unsigned xb_ld(unsigned* p)              { return __hip_atomic_load(p, __ATOMIC_RELAXED, __HIP_MEMORY_SCOPE_AGENT); }
__device__ __forceinline__ unsigned xb_add(unsigned* p, unsigned v) { return __hip_atomic_fetch_add(p, v, __ATOMIC_RELAXED, __HIP_MEMORY_SCOPE_AGENT); }
__device__ __forceinline__ unsigned xb_xcc_id() { return (unsigned)__builtin_amdgcn_s_getreg((3 << 11) | 20) & 0xFu; }
#define XB_SPIN(cond, bar) do { unsigned _sp = 0; while (cond) { __builtin_amdgcn_s_sleep(1); \
    if ((++_sp & 255u) == 0u) { if (xb_ld(&(bar)[XB_TMO])) break; if (_sp > XB_SPIN_CAP) { atomicAdd(&(bar)[XB_TMO], 1u); break; } } } } while (0)

struct XcdBarrier {
    unsigned* bar; unsigned x;
    volatile LAS unsigned* st;
};

__device__ __forceinline__ XcdBarrier xcd_barrier_post(unsigned* bar, volatile LAS unsigned* st) {
    XcdBarrier b; b.bar = bar; b.x = xb_xcc_id(); b.st = st;
    if (threadIdx.x == 0) (void)xb_add(&bar[XB_XCNT(b.x)], 1u);
    return b;
}
__device__ __forceinline__ void xcd_barrier_complete(unsigned* bar, unsigned x, unsigned& nloc, unsigned& nx) {
    const unsigned G = gridDim.x * gridDim.y * gridDim.z;
    unsigned sum, cnt, mine, sp = 0u;
    for (;;) {
        sum = 0u; cnt = 0u; mine = 0u;
#pragma unroll
        for (unsigned j = 0; j < 16; ++j) { const unsigned c = xb_ld(&bar[XB_XCNT(j)]); sum += c; cnt += (c > 0u) ? 1u : 0u; mine = (j == x) ? c : mine; }
        if (sum == G) break;
        __builtin_amdgcn_s_sleep(1);
        if ((++sp & 255u) == 0u) { if (xb_ld(&bar[XB_TMO])) break; if (sp > XB_SPIN_CAP) { atomicAdd(&bar[XB_TMO], 1u); break; } }
    }
    nloc = mine > 0u ? mine : 1u; nx = cnt > 0u ? cnt : 1u;
}

__device__ __forceinline__ void xcd_barrier(const XcdBarrier& b) {
    asm volatile("s_waitcnt vmcnt(0)" ::: "memory");
    __syncthreads();
    if (threadIdx.x == 0) {
        unsigned* bar = b.bar;
        __builtin_amdgcn_s_waitcnt(0);
        unsigned nloc = b.st[0], nx = b.st[1];
        if (nloc == 0u) { xcd_barrier_complete(bar, b.x, nloc, nx); b.st[0] = nloc; b.st[1] = nx; }
        const unsigned old = xb_add(&bar[XB_XSUB(b.x)], 1u);
        const unsigned gen = old / nloc;
        if (old + 1u == (gen + 1u) * nloc) {
            __builtin_amdgcn_fence(__ATOMIC_RELEASE, "agent");
            asm volatile("s_waitcnt vmcnt(0)" ::: "memory");
            const unsigned og = xb_add(&bar[XB_TOP], 1u);
            const unsigned tg = og / nx;
            if (og + 1u == (tg + 1u) * nx) xb_add(&bar[XB_TOPGEN], 1u);
            else XB_SPIN(xb_ld(&bar[XB_TOPGEN]) == tg, bar);
            __builtin_amdgcn_fence(__ATOMIC_ACQUIRE, "agent");
            xb_add(&bar[XB_XGEN(b.x)], 1u);
            asm volatile("s_waitcnt vmcnt(0)" ::: "memory");
        } else {
            XB_SPIN(xb_ld(&bar[XB_XGEN(b.x)]) == gen, bar);
            __builtin_amdgcn_fence(__ATOMIC_ACQUIRE, "agent");
            asm volatile("s_waitcnt vmcnt(0)" ::: "memory");
        }
    }
    __syncthreads();
}


constexpr size_t OFF_BAR = 480 * MiB + 256 * 1024;
constexpr int LDS_BARW = 152 * 1024 - 16;

constexpr int NSTAGE = 15;
#ifndef NP7
#define NP7 1
#endif
#ifndef NP9
#define NP9 1
#endif
#ifndef NP10
#define NP10 1
#endif
constexpr int NSTG = 11;
template <int S> __device__ __forceinline__ void run_stage(const P& p, float* lds) {
    if constexpr (S == 0) { st_mod(p, lds); st_convert(p, lds); }
    else if constexpr (S == 1) st_hm(p);
    else if constexpr (S == 2) st_inproj_fast(p, (char*)lds);
    else if constexpr (S == 3) st_dnprep_fast(p, (char*)lds);
    else if constexpr (S == 4) st_scan_l1(p, (char*)lds);
    else if constexpr (S == 5) {
        if (blockIdx.x < 8) st_scan_l2(p, (char*)lds);
        st_sg_fast(p, (char*)lds, blockIdx.x < 8 ? 248 + (int)blockIdx.x : (int)blockIdx.x - 8, 256);
    }
    else if constexpr (S == 6) st_scan_l3(p, (char*)lds);
    else if constexpr (S == 7) {
#pragma nounroll
        for (int ps = 0; ps < NP7; ++ps) st_post_fast(p, (char*)lds, ps == NP7 - 1);
    }
    else if constexpr (S == 8) st_shared_fast(p, (char*)lds);
    else if constexpr (S == 9) {
#pragma nounroll
        for (int ps = 0; ps < NP9; ++ps) st_experts_fast(p, (char*)lds, ps == NP9 - 1);
    }
    else if constexpr (S == 10) {
#pragma nounroll
        for (int ps = 0; ps < NP10; ++ps) st_combine(p, ps == NP10 - 1);
    }
}

constexpr int LDS_BYTES = 152 * 1024;

#if !MEGA
template <int S> __global__ void __launch_bounds__(NT) k_stage(P p) {
    extern __shared__ __attribute__((aligned(16))) float lds[];
    run_stage<S>(p, lds);
}
template <int S> static void launch_all(const P& p, int grid, hipStream_t stream) {
    if constexpr (S < NSTG) {
        (void)hipFuncSetAttribute((const void*)k_stage<S>, hipFuncAttributeMaxDynamicSharedMemorySize, LDS_BYTES);
        k_stage<S><<<grid, NT, LDS_BYTES, stream>>>(p);
        launch_all<S + 1>(p, grid, stream);
    }
}
#else
template <int S> __device__ __forceinline__ void run_from(const P& p, float* lds, const XcdBarrier& bar) {
    if constexpr (S < NSTG) {
        run_stage<S>(p, lds);
#ifdef PROBE_REPEAT
        if constexpr (S == PROBE_REPEAT) { xcd_barrier(bar); run_stage<S>(p, lds); }
#endif
        if constexpr (S < NSTG - 1) xcd_barrier(bar);
        run_from<S + 1>(p, lds, bar);
    }
}
__global__ void __launch_bounds__(NT) k_mega(P p) {
    extern __shared__ __attribute__((aligned(16))) float lds[];
    volatile LAS unsigned* st = (volatile LAS unsigned*)((LAS char*)lds + LDS_BARW);
    if (threadIdx.x == 0) { st[0] = 0u; st[1] = 0u; }
    __syncthreads();
    const XcdBarrier bar = xcd_barrier_post((unsigned*)(p.ws + OFF_BAR), st);
    cg::this_grid().sync();
    run_from<0>(p, lds, bar);
}
#endif

extern "C" void kernel_launch(void* const* d_in, const int* in_sizes, int n_in, void* d_out, int out_size, void* d_ws, size_t ws_size,
                              hipStream_t stream) {
    if (n_in != 30 || out_size != T * D || ws_size < WS_NEED) {
        fprintf(stderr, "kernel_launch: unexpected problem (n_in %d, out %d, ws %zu)\n", n_in, out_size, ws_size);
        return;
    }
    P p{};
    const float** f = (const float**)&p;
    for (int i = 0; i < 30; ++i) f[i] = (const float*)d_in[i];
    p.out = (float*)d_out;
    p.ws = (char*)d_ws;
    static int grid = 0;
    if (!grid) {
        int dev = 0, cus = 0;
        (void)hipGetDevice(&dev);
        (void)hipDeviceGetAttribute(&cus, hipDeviceAttributeMultiprocessorCount, dev);
#if MEGA
        int per_cu = 0;
        (void)hipFuncSetAttribute((const void*)k_mega, hipFuncAttributeMaxDynamicSharedMemorySize, LDS_BYTES);
        (void)hipOccupancyMaxActiveBlocksPerMultiprocessor(&per_cu, (const void*)k_mega, NT, LDS_BYTES);
        if (per_cu < 1) per_cu = 1;
        if (per_cu > 1) per_cu = 1;
        grid = cus * per_cu;
#else
        grid = cus;
#endif
    }
#if MEGA
    (void)hipMemsetAsync((char*)d_ws + OFF_BAR, 0, XCD_BAR_WORDS * sizeof(unsigned), stream);
    void* args[] = {&p};
    hipError_t e = hipLaunchCooperativeKernel((const void*)k_mega, dim3(grid), dim3(NT), args, LDS_BYTES, stream);
    if (e != hipSuccess) fprintf(stderr, "cooperative launch failed: %s (grid %d)\n", hipGetErrorString(e), grid);
#else
    launch_all<0>(p, grid, stream);
#endif
}
```

```cpp
#include <hip/hip_runtime.h>
#include <hip/hip_cooperative_groups.h>
#include <cstdint>
#include <cstdio>
namespace cg = cooperative_groups;

#ifndef MEGA
#define MEGA 1
#endif
#ifndef IN8
#define IN8 0
#endif

constexpr int D = 1024, NBATCH = 2, SEQ = 16384, T = NBATCH * SEQ;
constexpr int INCOLS = 3080;
constexpr int NE = 256, EH = 256;
constexpr int NT = 512;
constexpr int LCAP = 32768;

typedef unsigned short bf16_t;
__device__ __forceinline__ float bf2f(bf16_t v) { return __uint_as_float(((unsigned)v) << 16); }
__device__ __forceinline__ bf16_t f2bf(float f) { unsigned u = __float_as_uint(f); u += 0x7fffu + ((u >> 16) & 1u); return (bf16_t)(u >> 16); }

constexpr size_t MiB = 1024ull * 1024ull;
constexpr size_t OFF_HF     = 384 * MiB;
constexpr size_t OFF_WT_IN8 = 192 * MiB;
constexpr size_t OFF_HM8    = 160 * MiB;
constexpr size_t OFF_SHO    = 320 * MiB;
constexpr size_t OFF_HF8    = 128 * MiB;
constexpr size_t OFF_LISTS  = 448 * MiB;
constexpr size_t OFF_MOD    = 480 * MiB;
constexpr size_t OFF_CNT    = 480 * MiB + 64 * 1024;
constexpr size_t OFF_WAB    = 480 * MiB + 384 * 1024;
constexpr size_t OFF_G      = 481 * MiB;
constexpr size_t OFF_BETA   = 481 * MiB + 512 * 1024;
constexpr size_t OFF_WTS    = 482 * MiB;
constexpr size_t OFF_IDX    = 483 * MiB;
constexpr size_t OFF_CONTRIB= 512 * MiB;
constexpr size_t OFF_GATE   = 512 * MiB;
constexpr size_t OFF_ZS     = 640 * MiB;
constexpr size_t OFF_YSG    = 672 * MiB;
constexpr size_t OFF_O      = 704 * MiB;
constexpr size_t OFF_QKV    = 736 * MiB;
constexpr size_t OFF_UG     = 832 * MiB;
constexpr size_t OFF_VGG    = 864 * MiB;
constexpr size_t OFF_HM     = 896 * MiB;
constexpr size_t OFF_Y      = 800 * MiB;
constexpr size_t OFF_WT_GU  = 0;
constexpr size_t OFF_WT_D   = 256 * MiB;
constexpr size_t OFF_WT_IN  = 484 * MiB;
constexpr size_t OFF_WT_DN  = 494 * MiB;
constexpr size_t OFF_WT_SG  = 495 * MiB;
constexpr size_t OFF_WT_OUT = 496 * MiB;
constexpr size_t OFF_WT_RT  = 498 * MiB;
constexpr size_t OFF_WT_SHGU= 499 * MiB;
constexpr size_t OFF_WT_SHD = 500 * MiB;
constexpr size_t OFF_TRILW  = 501 * MiB;
constexpr size_t OFF_VC     = 960 * MiB;
constexpr size_t OFF_VGN    = 896 * MiB;
constexpr size_t OFF_SCORES = 832 * MiB;
constexpr size_t WS_NEED    = 1024 * MiB;

struct P {
    const float *x, *c, *ada_w, *ada_b, *mix_pre, *mix_post, *w_in, *conv_w, *a_log, *dt_bias, *dn_norm_w, *sg_ln_w, *sg_ln_b,
        *sg_w, *sg_b, *w_bg, *b_bg, *w_pdn, *w_psg, *w_out, *ffn_pre, *ffn_post, *w_router, *router_bias, *w_eg, *w_eu, *w_ed,
        *w_shg, *w_shu, *w_shd;
    float* out;
    char* ws;
};

__device__ __forceinline__ int tidx() { int t = threadIdx.x; asm volatile("" : "+v"(t)); return t; }
__device__ __forceinline__ float wave_sum(float v) {
#pragma unroll
    for (int o = 32; o > 0; o >>= 1) v += __shfl_xor(v, o);
    return v;
}
__device__ __forceinline__ float sigmoid_(float x) { return 1.f / (1.f + expf(-x)); }
__device__ __forceinline__ float silu_(float x) { return x / (1.f + expf(-x)); }
__device__ __forceinline__ float gelu_(float x) { return 0.5f * x * (1.f + erff(x * 0.70710678118654752f)); }
__device__ __forceinline__ float softplus_(float x) { return fmaxf(x, 0.f) + log1pf(expf(-fabsf(x))); }

typedef __bf16 bf2_t __attribute__((ext_vector_type(2)));
typedef float f2_t __attribute__((ext_vector_type(2)));
__device__ __forceinline__ unsigned pk2(float a, float b) { const f2_t v = {a, b}; return __builtin_bit_cast(unsigned, __builtin_convertvector(v, bf2_t)); }
__device__ __forceinline__ uint4 pack8(const float (&v)[8]) { return make_uint4(pk2(v[0], v[1]), pk2(v[2], v[3]), pk2(v[4], v[5]), pk2(v[6], v[7])); }

__device__ __forceinline__ void unpack8(const uint4 u, float (&o)[8]) {
    o[0] = __uint_as_float(u.x << 16); o[1] = __uint_as_float(u.x & 0xffff0000u); o[2] = __uint_as_float(u.y << 16); o[3] = __uint_as_float(u.y & 0xffff0000u);
    o[4] = __uint_as_float(u.z << 16); o[5] = __uint_as_float(u.z & 0xffff0000u); o[6] = __uint_as_float(u.w << 16); o[7] = __uint_as_float(u.w & 0xffff0000u);
}

template <int TOK, class Epi>
__device__ __forceinline__ void ngemm(const float* As, int K, const float* __restrict__ W, int ldw, int ncols, Epi epi) {
    for (int n = tidx(); n < ncols; n += NT) {
        float acc[TOK];
#pragma unroll
        for (int i = 0; i < TOK; ++i) acc[i] = 0.f;
        const float* wp = W + n;
        for (int k = 0; k < K; k += 4) {
            const float w0 = wp[(size_t)k * ldw], w1 = wp[(size_t)(k + 1) * ldw], w2 = wp[(size_t)(k + 2) * ldw], w3 = wp[(size_t)(k + 3) * ldw];
#pragma unroll
            for (int i = 0; i < TOK; ++i) {
                const float4 a = *(const float4*)(As + i * K + k);
                acc[i] += a.x * w0 + a.y * w1 + a.z * w2 + a.w * w3;
            }
        }
#pragma unroll
        for (int i = 0; i < TOK; ++i) epi(i, n, acc[i]);
    }
}

__device__ void st_mod(const P& p, float* lds) {
    const int tid = tidx(), lane = tid & 63, wid = tid >> 6;
    const int gtid = blockIdx.x * NT + tid, gsz = gridDim.x * NT;
    float* mod = (float*)(p.ws + OFF_MOD);
    for (int task = blockIdx.x; task < 192; task += gridDim.x) {
        const int b = task / 96, j = (task % 96) * 64 + lane;
        float acc = 0.f;
        for (int k = wid * 128; k < wid * 128 + 128; ++k) acc += silu_(p.c[b * 1024 + k]) * p.ada_w[(size_t)k * 6144 + j];
        __syncthreads();
        lds[wid * 64 + lane] = acc;
        __syncthreads();
        if (wid == 0) {
            float s = p.ada_b[j];
#pragma unroll
            for (int w = 0; w < 8; ++w) s += lds[w * 64 + lane];
            mod[b * 6144 + j] = s;
        }
    }
    __syncthreads();
    unsigned* cnt = (unsigned*)(p.ws + OFF_CNT);
    for (int i = gtid; i < NE; i += gsz) cnt[i] = 0u;
    unsigned* zr = (unsigned*)(p.ws + 480 * MiB + 320 * 1024);
    for (int i = gtid; i < 1024; i += gsz) zr[i] = 0u;
    float* wab = (float*)(p.ws + OFF_WAB);
    for (int i = gtid; i < 8192; i += gsz) wab[i] = p.w_in[(size_t)(i & 1023) * INCOLS + 2048 + (i >> 10)];
}

__device__ void st_hm(const P& p) {
    const int lane = tidx() & 63, gw = (blockIdx.x * NT + tidx()) >> 6, nw = (gridDim.x * NT) >> 6;
    const float* mod = (const float*)(p.ws + OFF_MOD);
    bf16_t* hm = (bf16_t*)(p.ws + OFF_HM);
    float* gb = (float*)(p.ws + OFF_G);
    float* bb = (float*)(p.ws + OFF_BETA);
    const float* wab = (const float*)(p.ws + OFF_WAB);
    const int lane0 = lane;
    for (int t = gw; t < T; t += nw) {
        int lane = lane0; asm volatile("" : "+v"(lane));
        const int b = t / SEQ;
        const float* xr = p.x + (size_t)t * D;
        float4 v[4];
        float ss = 0.f;
#pragma unroll
        for (int i = 0; i < 4; ++i) { v[i] = *(const float4*)(xr + i * 256 + lane * 4); ss += v[i].x * v[i].x + v[i].y * v[i].y + v[i].z * v[i].z + v[i].w * v[i].w; }
        ss = wave_sum(ss);
        const float rstd = rsqrtf(ss * (1.f / 1024.f) + 1e-6f);
        float ab[8];
#pragma unroll
        for (int q = 0; q < 8; ++q) ab[q] = 0.f;
#pragma unroll
        for (int i = 0; i < 4; ++i) {
            const int k0 = i * 256 + lane * 4;
            const float xv[4] = {v[i].x, v[i].y, v[i].z, v[i].w};
            const float4 mw = *(const float4*)(p.mix_pre + k0), sc = *(const float4*)(mod + b * 6144 + 1024 + k0), sh = *(const float4*)(mod + b * 6144 + k0);
            const float mwa[4] = {mw.x, mw.y, mw.z, mw.w}, sca[4] = {sc.x, sc.y, sc.z, sc.w}, sha[4] = {sh.x, sh.y, sh.z, sh.w};
            float h[4];
#pragma unroll
            for (int j = 0; j < 4; ++j) h[j] = xv[j] * rstd * mwa[j] * (1.f + sca[j]) + sha[j];
#pragma unroll
            for (int q = 0; q < 8; ++q) {
                const float4 w4 = *(const float4*)(wab + q * 1024 + k0);
                ab[q] += h[0] * w4.x + h[1] * w4.y + h[2] * w4.z + h[3] * w4.w;
            }
            if (IN8) {
                int w8 = __builtin_amdgcn_cvt_pk_fp8_f32(h[0], h[1], 0, false); w8 = __builtin_amdgcn_cvt_pk_fp8_f32(h[2], h[3], w8, true);
                *(int*)(p.ws + OFF_HM8 + (size_t)t * D + k0) = w8;
            }
            { ushort4 o; o.x = f2bf(h[0]); o.y = f2bf(h[1]); o.z = f2bf(h[2]); o.w = f2bf(h[3]);
              *(ushort4*)(hm + (size_t)t * D + k0) = o; }
        }
#pragma unroll
        for (int q = 0; q < 8; ++q) ab[q] = wave_sum(ab[q]);
#pragma unroll
        for (int q = 0; q < 4; ++q) {
            if (lane == q) gb[t * 4 + q] = -expf(p.a_log[q]) * softplus_(ab[q] + p.dt_bias[q]);
            if (lane == 4 + q) bb[t * 4 + q] = sigmoid_(ab[4 + q]);
        }
    }
}

__device__ void st_inproj_naive(const P& p, float* lds) {
    const bf16_t* hm = (const bf16_t*)(p.ws + OFF_HM);
    bf16_t* qkv = (bf16_t*)(p.ws + OFF_QKV); bf16_t* zs = (bf16_t*)(p.ws + OFF_ZS); bf16_t* ug = (bf16_t*)(p.ws + OFF_UG);
    bf16_t* vgg = (bf16_t*)(p.ws + OFF_VGG); bf16_t* gate = (bf16_t*)(p.ws + OFF_GATE);
    for (int tile = blockIdx.x; tile < T / 16; tile += gridDim.x) {
        const int t0 = tile * 16;
        __syncthreads();
        for (int i = tidx(); i < 16 * D; i += NT) lds[i] = bf2f(hm[(size_t)t0 * D + i]);
        __syncthreads();
        ngemm<16>(lds, D, p.w_in, INCOLS, INCOLS, [&](int i, int n, float acc) {
            const size_t t = t0 + i;
            if (n < 1536) qkv[t * 1536 + n] = f2bf(acc);
            else if (n < 2048) zs[t * 512 + (n - 1536)] = f2bf(silu_(acc));
            else if (n < 2056) {}
            else if (n < 2568) ug[t * 512 + (n - 2056)] = f2bf(gelu_(acc));
            else vgg[t * 512 + (n - 2568)] = f2bf(gelu_(acc));
        });
        ngemm<16>(lds, D, p.w_bg, 2048, 2048, [&](int i, int n, float acc) {
            gate[(size_t)(t0 + i) * 2048 + n] = f2bf(sigmoid_(acc + p.b_bg[n]));
        });
    }
}

__device__ void st_dnprep_naive(const P& p) {
    const int lane = tidx() & 63, gw = (blockIdx.x * NT + tidx()) >> 6, nw = (gridDim.x * NT) >> 6;
    const bf16_t* qkv = (const bf16_t*)(p.ws + OFF_QKV);
    float* qn = (p.out); float* kn = (p.out + (size_t)T * 512); float* vc = (float*)(p.ws + OFF_VC);
    for (int u = gw; u < T * 4; u += nw) {
        const int t = u >> 2, h = u & 3, s = t % SEQ;
        float r[3][2];
#pragma unroll
        for (int part = 0; part < 3; ++part)
#pragma unroll
            for (int j = 0; j < 2; ++j) {
                const int col = part * 512 + h * 128 + lane * 2 + j;
                float y = 0.f;
#pragma unroll
                for (int i = 0; i < 4; ++i) {
                    const int sp = s - 3 + i;
                    if (sp >= 0) y += bf2f(qkv[(size_t)(t - 3 + i) * 1536 + col]) * p.conv_w[i * 1536 + col];
                }
                r[part][j] = silu_(y);
            }
        const float qs = wave_sum(r[0][0] * r[0][0] + r[0][1] * r[0][1]);
        const float ks = wave_sum(r[1][0] * r[1][0] + r[1][1] * r[1][1]);
        const float qsc = rsqrtf(qs + 1e-6f) * 0.08838834764831845f, ksc = rsqrtf(ks + 1e-6f);
        const size_t o = (size_t)t * 512 + h * 128 + lane * 2;
        *(float2*)(qn + o) = make_float2(r[0][0] * qsc, r[0][1] * qsc);
        *(float2*)(kn + o) = make_float2(r[1][0] * ksc, r[1][1] * ksc);
        *(float2*)(vc + o) = make_float2(r[2][0], r[2][1]);
    }
}

__device__ void st_dnrec_naive(const P& p) {
    const int lane = tidx() & 63, gw = (blockIdx.x * NT + tidx()) >> 6, nw = (gridDim.x * NT) >> 6;
    const float* qn = (p.out); const float* kn = (p.out + (size_t)T * 512); const float* vc = (const float*)(p.ws + OFF_VC);
    const float* gb = (const float*)(p.ws + OFF_G); const float* bb = (const float*)(p.ws + OFF_BETA);
    bf16_t* ob = (bf16_t*)(p.ws + OFF_O);
    for (int u = gw; u < NBATCH * 4 * 128; u += nw) {
        const int b = u >> 9, h = (u >> 7) & 3, vcol = u & 127;
        float S0 = 0.f, S1 = 0.f;
        size_t t = (size_t)b * SEQ;
        float2 kk = *(const float2*)(kn + t * 512 + h * 128 + 2 * lane);
        float2 qq = *(const float2*)(qn + t * 512 + h * 128 + 2 * lane);
        float vv = vc[t * 512 + h * 128 + vcol], g = gb[t * 4 + h], be = bb[t * 4 + h];
        for (int s = 0; s < SEQ; ++s, ++t) {
            float2 kk2 = kk, qq2 = qq; float vv2 = vv, g2 = g, be2 = be;
            if (s + 1 < SEQ) {
                const size_t tn = t + 1;
                kk2 = *(const float2*)(kn + tn * 512 + h * 128 + 2 * lane);
                qq2 = *(const float2*)(qn + tn * 512 + h * 128 + 2 * lane);
                vv2 = vc[tn * 512 + h * 128 + vcol]; g2 = gb[tn * 4 + h]; be2 = bb[tn * 4 + h];
            }
            const float a = expf(g);
            const float dk = wave_sum(kk.x * S0 + kk.y * S1);
            const float dq = wave_sum(qq.x * S0 + qq.y * S1);
            const float qk = wave_sum(qq.x * kk.x + qq.y * kk.y);
            const float vnew = be * (vv - a * dk);
            const float o = a * dq + qk * vnew;
            S0 = a * S0 + kk.x * vnew; S1 = a * S1 + kk.y * vnew;
            if (lane == 0) ob[t * 512 + h * 128 + vcol] = f2bf(o);
            kk = kk2; qq = qq2; vv = vv2; g = g2; be = be2;
        }
    }
}

__device__ void st_sgln_naive(const P& p) {
    const int lane = tidx() & 63, gw = (blockIdx.x * NT + tidx()) >> 6, nw = (gridDim.x * NT) >> 6;
    const bf16_t* vgg = (const bf16_t*)(p.ws + OFF_VGG);
    float* vgn = (float*)(p.ws + OFF_VGN);
    for (int t = gw; t < T; t += nw) {
        float v[8]; float s = 0.f;
#pragma unroll
        for (int j = 0; j < 8; ++j) { v[j] = bf2f(vgg[(size_t)t * 512 + j * 64 + lane]); s += v[j]; }
        const float mu = wave_sum(s) * (1.f / 512.f);
        float q = 0.f;
#pragma unroll
        for (int j = 0; j < 8; ++j) { const float d = v[j] - mu; q += d * d; }
        const float rstd = rsqrtf(wave_sum(q) * (1.f / 512.f) + 1e-6f);
#pragma unroll
        for (int j = 0; j < 8; ++j) { const int c = j * 64 + lane; vgn[(size_t)t * 512 + c] = (v[j] - mu) * rstd * p.sg_ln_w[c] + p.sg_ln_b[c]; }
    }
}
__device__ void st_sgmix_naive(const P& p) {
    const int gtid = blockIdx.x * NT + tidx(), gsz = gridDim.x * NT;
    const float* vgn = (const float*)(p.ws + OFF_VGN);
    const bf16_t* ug = (const bf16_t*)(p.ws + OFF_UG);
    bf16_t* ysg = (bf16_t*)(p.ws + OFF_YSG);
    for (int i = gtid; i < T * 512; i += gsz) {
        const int t = i >> 9, c = i & 511, g = c >> 7, tt = t & 127, t0 = t - tt;
        const float* w = p.sg_w + ((size_t)g * 128 + tt) * 128;
        float acc = p.sg_b[g * 128 + tt];
        for (int s = 0; s <= tt; ++s) acc += w[s] * vgn[(size_t)(t0 + s) * 512 + c];
        ysg[i] = f2bf(bf2f(ug[i]) * acc);
    }
}

__device__ __forceinline__ void ydn_unit(const P& p, int u, int lane) {
    bf16_t* ob = (bf16_t*)(p.ws + OFF_O); const bf16_t* zs = (const bf16_t*)(p.ws + OFF_ZS);
    const size_t base = (size_t)(u >> 2) * 512 + (u & 3) * 128 + lane * 2;
    const float o0 = bf2f(ob[base]), o1 = bf2f(ob[base + 1]);
    const float rstd = rsqrtf(wave_sum(o0 * o0 + o1 * o1) * (1.f / 128.f) + 1e-6f);
    ob[base] = f2bf(o0 * rstd * p.dn_norm_w[lane * 2] * bf2f(zs[base]));
    ob[base + 1] = f2bf(o1 * rstd * p.dn_norm_w[lane * 2 + 1] * bf2f(zs[base + 1]));
}
__device__ __forceinline__ void ydn_token(const P& p, int t, int lane) {
    bf16_t* ob = (bf16_t*)(p.ws + OFF_O); const bf16_t* zs = (const bf16_t*)(p.ws + OFF_ZS);
    const float2 nw = *(const float2*)(p.dn_norm_w + lane * 2);
    unsigned ov[4], zv[4]; float ss[4];
#pragma unroll
    for (int h = 0; h < 4; ++h) { const size_t base = (size_t)t * 512 + h * 128 + lane * 2; ov[h] = *(const unsigned*)(ob + base); zv[h] = *(const unsigned*)(zs + base); }
#pragma unroll
    for (int h = 0; h < 4; ++h) { const float o0 = __uint_as_float(ov[h] << 16), o1 = __uint_as_float(ov[h] & 0xffff0000u); ss[h] = o0 * o0 + o1 * o1; }
#pragma unroll
    for (int o = 32; o > 0; o >>= 1) {
#pragma unroll
        for (int h = 0; h < 4; ++h) ss[h] += __shfl_xor(ss[h], o);
    }
#pragma unroll
    for (int h = 0; h < 4; ++h) {
        const float rstd = rsqrtf(ss[h] * (1.f / 128.f) + 1e-6f);
        const float o0 = __uint_as_float(ov[h] << 16), o1 = __uint_as_float(ov[h] & 0xffff0000u);
        *(unsigned*)(ob + (size_t)t * 512 + h * 128 + lane * 2) = pk2(o0 * rstd * nw.x * __uint_as_float(zv[h] << 16), o1 * rstd * nw.y * __uint_as_float(zv[h] & 0xffff0000u));
    }
}
__device__ void st_ydn_naive(const P& p) {
    const int lane = tidx() & 63, gw = (blockIdx.x * NT + tidx()) >> 6, nw = (gridDim.x * NT) >> 6;
    for (int u = gw; u < T * 4; u += nw) ydn_unit(p, u, lane);
}
__device__ void st_merged_naive(const P& p, float* lds) {
    const bf16_t* ydn = (const bf16_t*)(p.ws + OFF_O); const bf16_t* ysg = (const bf16_t*)(p.ws + OFF_YSG);
    const bf16_t* gate = (const bf16_t*)(p.ws + OFF_GATE);
    float* mg = (p.out);
    float* A1 = lds; float* A2 = lds + 16 * 512;
    for (int tile = blockIdx.x; tile < T / 16; tile += gridDim.x) {
        const int t0 = tile * 16;
        __syncthreads();
        for (int i = tidx(); i < 16 * 512; i += NT) { A1[i] = bf2f(ydn[(size_t)t0 * 512 + i]); A2[i] = bf2f(ysg[(size_t)t0 * 512 + i]); }
        __syncthreads();
        ngemm<16>(A1, 512, p.w_pdn, D, D, [&](int i, int n, float acc) { const size_t t = t0 + i; mg[t * D + n] = bf2f(gate[t * 2048 + n]) * acc; });
        ngemm<16>(A2, 512, p.w_psg, D, D, [&](int i, int n, float acc) { const size_t t = t0 + i; mg[t * D + n] += bf2f(gate[t * 2048 + 1024 + n]) * acc; });
    }
}
__device__ void st_wout_naive(const P& p, float* lds) {
    const float* mg = (p.out);
    float* y = (float*)(p.ws + OFF_Y);
    for (int tile = blockIdx.x; tile < T / 16; tile += gridDim.x) {
        const int t0 = tile * 16;
        __syncthreads();
        for (int i = tidx(); i < 16 * D; i += NT) lds[i] = mg[(size_t)t0 * D + i];
        __syncthreads();
        ngemm<16>(lds, D, p.w_out, D, D, [&](int i, int n, float acc) { y[(size_t)(t0 + i) * D + n] = acc; });
    }
}
__device__ __forceinline__ void x1hf_row(const P& p, int t, int lane) {
    const float* mod = (const float*)(p.ws + OFF_MOD);
    const float* y = (const float*)(p.ws + OFF_Y);
    bf16_t* hf = (bf16_t*)(p.ws + OFF_HF);
    const int b = t / SEQ;
    float4 yv[4]; float ss = 0.f;
#pragma unroll
    for (int i = 0; i < 4; ++i) { yv[i] = *(const float4*)(y + (size_t)t * D + i * 256 + lane * 4); ss += yv[i].x * yv[i].x + yv[i].y * yv[i].y + yv[i].z * yv[i].z + yv[i].w * yv[i].w; }
    const float rstd = rsqrtf(wave_sum(ss) * (1.f / 1024.f) + 1e-6f);
    float4 x1[4]; float s2 = 0.f;
#pragma unroll
    for (int i = 0; i < 4; ++i) {
        const int k0 = i * 256 + lane * 4;
        const float4 xv = *(const float4*)(p.x + (size_t)t * D + k0), g1 = *(const float4*)(mod + b * 6144 + 2048 + k0), mp = *(const float4*)(p.mix_post + k0);
        float4 v;
        v.x = xv.x + g1.x * (yv[i].x * rstd * mp.x); v.y = xv.y + g1.y * (yv[i].y * rstd * mp.y);
        v.z = xv.z + g1.z * (yv[i].z * rstd * mp.z); v.w = xv.w + g1.w * (yv[i].w * rstd * mp.w);
        x1[i] = v; s2 += v.x * v.x + v.y * v.y + v.z * v.z + v.w * v.w;
        *(float4*)(p.out + (size_t)t * D + k0) = v;
    }
    const float rstd2 = rsqrtf(wave_sum(s2) * (1.f / 1024.f) + 1e-6f);
#pragma unroll
    for (int i = 0; i < 4; ++i) {
        const int k0 = i * 256 + lane * 4;
        const float4 fp = *(const float4*)(p.ffn_pre + k0), sc = *(const float4*)(mod + b * 6144 + 4096 + k0), sh = *(const float4*)(mod + b * 6144 + 3072 + k0);
        const float h0 = x1[i].x * rstd2 * fp.x * (1.f + sc.x) + sh.x, h1 = x1[i].y * rstd2 * fp.y * (1.f + sc.y) + sh.y;
        const float h2 = x1[i].z * rstd2 * fp.z * (1.f + sc.z) + sh.z, h3 = x1[i].w * rstd2 * fp.w * (1.f + sc.w) + sh.w;
        uint2 o;
        o.x = pk2(h0, h1); o.y = pk2(h2, h3);
        *(uint2*)(hf + (size_t)t * D + k0) = o;
        int w8 = __builtin_amdgcn_cvt_pk_fp8_f32(h0, h1, 0, false); w8 = __builtin_amdgcn_cvt_pk_fp8_f32(h2, h3, w8, true);
        *(int*)(p.ws + OFF_HF8 + (size_t)t * D + k0) = w8;
    }
}
__device__ void st_x1hf(const P& p) {
    const int lane = tidx() & 63, gw = (blockIdx.x * NT + tidx()) >> 6, nw = (gridDim.x * NT) >> 6;
    for (int t = gw; t < T; t += nw) x1hf_row(p, t, lane);
}
__device__ void st_router_naive(const P& p, float* lds) {
    const bf16_t* hf = (const bf16_t*)(p.ws + OFF_HF);
    float* sc = (float*)(p.ws + OFF_SCORES);
    for (int tile = blockIdx.x; tile < T / 16; tile += gridDim.x) {
        const int t0 = tile * 16;
        __syncthreads();
        for (int i = tidx(); i < 16 * D; i += NT) lds[i] = bf2f(hf[(size_t)t0 * D + i]);
        __syncthreads();
        ngemm<16>(lds, D, p.w_router, NE, NE, [&](int i, int n, float acc) { sc[(size_t)(t0 + i) * NE + n] = sigmoid_(acc); });
    }
}
__device__ void st_topk_naive(const P& p) {
    const int gtid = blockIdx.x * NT + tidx(), gsz = gridDim.x * NT;
    const float* sc = (const float*)(p.ws + OFF_SCORES);
    unsigned* cnt = (unsigned*)(p.ws + OFF_CNT);
    int* lists = (int*)(p.ws + OFF_LISTS);
    float* wts = (float*)(p.ws + OFF_WTS); int* idxo = (int*)(p.ws + OFF_IDX);
    for (int t = gtid; t < T; t += gsz) {
        const float* s = sc + (size_t)t * NE;
        float gs[8];
#pragma unroll
        for (int g = 0; g < 8; ++g) {
            float m1 = -INFINITY, m2 = -INFINITY;
            for (int j = 0; j < 32; ++j) { const float v = s[g * 32 + j] + p.router_bias[g * 32 + j]; if (v > m1) { m2 = m1; m1 = v; } else if (v > m2) m2 = v; }
            gs[g] = m1 + m2;
        }
        unsigned gmask = 0;
#pragma unroll
        for (int g = 0; g < 8; ++g) {
            int rank = 0;
#pragma unroll
            for (int h = 0; h < 8; ++h) rank += (gs[h] > gs[g] || (gs[h] == gs[g] && h < g)) ? 1 : 0;
            if (rank < 4) gmask |= 1u << g;
        }
        float pv = INFINITY; int pi = -1;
        int sel[8]; float sw[8]; float wsum = 0.f;
#pragma unroll
        for (int k = 0; k < 8; ++k) {
            float bv = -INFINITY; int bi = 0;
            for (int e = 0; e < NE; ++e) {
                if (!((gmask >> (e >> 5)) & 1u)) continue;
                const float v = s[e] + p.router_bias[e];
                const bool elig = (v < pv) || (v == pv && e > pi);
                if (elig && v > bv) { bv = v; bi = e; }
            }
            pv = bv; pi = bi; sel[k] = bi; sw[k] = s[bi]; wsum += sw[k];
        }
        const float inv = 2.5f / wsum;
#pragma unroll
        for (int k = 0; k < 8; ++k) {
            const int e = sel[k];
            const unsigned pos = atomicAdd(&cnt[e], 1u);
            lists[(size_t)e * LCAP + pos] = t * 8 + k;
            wts[t * 8 + k] = sw[k] * inv; idxo[t * 8 + k] = e;
        }
    }
}

__device__ void st_shared_naive(const P& p, float* lds) {
    const bf16_t* hf = (const bf16_t*)(p.ws + OFF_HF);
    bf16_t* contrib = (bf16_t*)(p.ws + OFF_CONTRIB);
    float* A = lds; float* G = lds + 16 * D; float* H = G + 16 * EH;
    for (int tile = blockIdx.x; tile < T / 16; tile += gridDim.x) {
        const int t0 = tile * 16;
        __syncthreads();
        for (int i = tidx(); i < 16 * D; i += NT) A[i] = bf2f(hf[(size_t)t0 * D + i]);
        __syncthreads();
        ngemm<16>(A, D, p.w_shg, EH, EH, [&](int i, int n, float acc) { G[i * EH + n] = acc; });
        ngemm<16>(A, D, p.w_shu, EH, EH, [&](int i, int n, float acc) { H[i * EH + n] = silu_(G[i * EH + n]) * acc; });
        __syncthreads();
        ngemm<16>(H, EH, p.w_shd, D, D, [&](int i, int n, float acc) { contrib[((size_t)(t0 + i) * 8) * D + n] = f2bf(acc); });
    }
}
__device__ void st_experts_naive(const P& p, float* lds) {
    const bf16_t* hf = (const bf16_t*)(p.ws + OFF_HF);
    bf16_t* contrib = (bf16_t*)(p.ws + OFF_CONTRIB);
    const unsigned* cnt = (const unsigned*)(p.ws + OFF_CNT);
    const int* lists = (const int*)(p.ws + OFF_LISTS);
    const float* wts = (const float*)(p.ws + OFF_WTS);
    float* A = lds; float* G = lds + 16 * D; float* H = G + 16 * EH;
    int* ent = (int*)(H + 16 * EH);
    int* tstart = ent + 16;
    __syncthreads();
    if (tidx() == 0) { int acc = 0; for (int e = 0; e < NE; ++e) { tstart[e] = acc; acc += ((int)cnt[e] + 15) >> 4; } tstart[NE] = acc; }
    __syncthreads();
    const int ntiles = tstart[NE];
    int e = 0;
    for (int tile = blockIdx.x; tile < ntiles; tile += gridDim.x) {
        while (tstart[e + 1] <= tile) ++e;
        const int r0 = (tile - tstart[e]) * 16, ce = (int)cnt[e];
        __syncthreads();
        if (tidx() < 16) ent[tidx()] = (r0 + (int)tidx() < ce) ? lists[(size_t)e * LCAP + r0 + tidx()] : -1;
        __syncthreads();
        for (int i = tidx(); i < 16 * D; i += NT) { const int en = ent[i >> 10]; A[i] = en >= 0 ? bf2f(hf[(size_t)(en >> 3) * D + (i & 1023)]) : 0.f; }
        __syncthreads();
        ngemm<16>(A, D, p.w_eg + (size_t)e * D * EH, EH, EH, [&](int i, int n, float acc) { G[i * EH + n] = acc; });
        ngemm<16>(A, D, p.w_eu + (size_t)e * D * EH, EH, EH, [&](int i, int n, float acc) { H[i * EH + n] = silu_(G[i * EH + n]) * acc; });
        __syncthreads();
        ngemm<16>(H, EH, p.w_ed + (size_t)e * EH * D, D, D, [&](int i, int n, float acc) {
            const int en = ent[i];
            if (en >= 0) {
                float v = acc * wts[en];
                bf16_t* dst = contrib + (size_t)en * D + n;
                if ((en & 7) == 0) v += bf2f(*dst);
                *dst = f2bf(v);
            }
        });
    }
}
__device__ void st_combine(const P& p, bool fin) {
    const int lane0 = tidx() & 63, gw = (blockIdx.x * NT + tidx()) >> 6, nw = (gridDim.x * NT) >> 6;
    const float* mod = (const float*)(p.ws + OFF_MOD);
    const bf16_t* contrib = (const bf16_t*)(p.ws + OFF_CONTRIB);
    for (int t = gw; t < T; t += nw) {
        int lane = lane0; asm volatile("" : "+v"(lane));
        const int b = t / SEQ;
        uint4 cv[8][2];
#pragma unroll
        for (int k = 0; k < 8; ++k) {
            const bf16_t* r = contrib + ((size_t)t * 8 + k) * D + lane * 8;
            cv[k][0] = *(const uint4*)r; cv[k][1] = *(const uint4*)(r + 512);
        }
        float4 xv[4];
#pragma unroll
        for (int q = 0; q < 4; ++q) xv[q] = *(const float4*)(p.out + (size_t)t * D + (q >> 1) * 512 + lane * 8 + (q & 1) * 4);
        float y[16];
        {
            const bf16_t* r = (const bf16_t*)(p.ws + OFF_SHO) + (size_t)t * D + lane * 8;
            float v8[8]; unpack8(*(const uint4*)r, v8);
#pragma unroll
            for (int j = 0; j < 8; ++j) y[j] = v8[j];
            unpack8(*(const uint4*)(r + 512), v8);
#pragma unroll
            for (int j = 0; j < 8; ++j) y[8 + j] = v8[j];
        }
#pragma unroll
        for (int k = 0; k < 8; ++k)
#pragma unroll
            for (int hh = 0; hh < 2; ++hh) {
                float v8[8]; unpack8(cv[k][hh], v8);
#pragma unroll
                for (int j = 0; j < 8; ++j) y[hh * 8 + j] += v8[j];
            }
        float ss = 0.f;
#pragma unroll
        for (int i = 0; i < 16; ++i) ss += y[i] * y[i];
        const float rstd = rsqrtf(wave_sum(ss) * (1.f / 1024.f) + 1e-6f);
#pragma unroll
        for (int q = 0; q < 4; ++q) {
            const int k0 = (q >> 1) * 512 + lane * 8 + (q & 1) * 4;
            const float4 g2 = *(const float4*)(mod + b * 6144 + 5120 + k0), fw = *(const float4*)(p.ffn_post + k0);
            float4 o = xv[q];
            o.x += g2.x * (y[q * 4] * rstd * fw.x); o.y += g2.y * (y[q * 4 + 1] * rstd * fw.y);
            o.z += g2.z * (y[q * 4 + 2] * rstd * fw.z); o.w += g2.w * (y[q * 4 + 3] * rstd * fw.w);
            if (fin) *(float4*)(p.out + (size_t)t * D + k0) = o;
            else if (o.x == 12345.678f) *(float4*)(p.out + (size_t)t * D + k0) = o;
        }
    }
}

typedef short bf16x8 __attribute__((ext_vector_type(8)));
typedef float f32x4 __attribute__((ext_vector_type(4)));

__device__ __forceinline__ float fexp_(float x) { return __builtin_amdgcn_exp2f(x * 1.4426950408889634f); }
__device__ __forceinline__ float fsigmoid_(float x) { return __builtin_amdgcn_rcpf(1.f + fexp_(-x)); }
__device__ __forceinline__ float fsilu_(float x) { return x * fsigmoid_(x); }
__device__ __forceinline__ float fgelu_(float v) {
    const float av = fabsf(v), t = __builtin_amdgcn_rcpf(av * 0.2316418882f + 1.0f);
    float q = t * 0.5307027145f + (-0.7265760135f); q = q * t + 0.7107068705f; q = q * t + (-0.142248368f); q = q * t + 0.127414796f; q = q * t;
    const float e = __builtin_amdgcn_exp2f((v * v) * (-0.72134752044f));
    const float m = v * (q * e);
    return v < 0.f ? m : v - m;
}

constexpr float W8_SCALE = 32.f, W8_INV = 1.f / 32.f;
struct CTile { const float* src; char* dst; int ld, ldd, esz; };
__device__ __forceinline__ CTile conv_decode(const P& p, int id) {
    const int NDENSE = 2048;
    const float* src; int ld, K, cb, kt, colbase = 0, esz = 2; char* dst; int drow0;
    if (id < NDENSE) {
        int r = id;
        if (r < 512) { src = p.w_in; ld = INCOLS; K = 1024; cb = r >> 3; kt = r & 7; dst = p.ws + OFF_WT_IN; drow0 = cb * 32; }
        else if ((r -= 512) < 256) { src = p.w_in; ld = INCOLS; K = 1024; cb = r >> 3; kt = r & 7; colbase = 2056; dst = p.ws + (IN8 ? OFF_WT_IN8 : OFF_WT_IN); drow0 = 2048 + cb * 32; esz = IN8 ? 1 : 2; }
        else if ((r -= 256) < 512) { src = p.w_bg; ld = 2048; K = 1024; cb = r >> 3; kt = r & 7; dst = p.ws + (IN8 ? OFF_WT_IN8 : OFF_WT_IN); drow0 = 3072 + cb * 32; esz = IN8 ? 1 : 2; }
        else if ((r -= 512) < 128) { src = p.w_pdn; ld = 1024; K = 512; cb = r >> 2; kt = r & 3; dst = p.ws + OFF_WT_DN; drow0 = cb * 32; }
        else if ((r -= 128) < 128) { src = p.w_psg; ld = 1024; K = 512; cb = r >> 2; kt = r & 3; dst = p.ws + OFF_WT_SG; drow0 = cb * 32; }
        else if ((r -= 128) < 256) { src = p.w_out; ld = 1024; K = 1024; cb = r >> 3; kt = r & 7; dst = p.ws + OFF_WT_OUT; drow0 = cb * 32; }
        else if ((r -= 256) < 64) { src = p.w_router; ld = 256; K = 1024; cb = r >> 3; kt = r & 7; dst = p.ws + OFF_WT_RT; drow0 = cb * 32; }
        else if ((r -= 64) < 128) { const int pp = r >> 6; r &= 63; src = pp ? p.w_shu : p.w_shg; ld = 256; K = 1024; cb = r >> 3; kt = r & 7; dst = p.ws + OFF_WT_SHGU; drow0 = (cb >> 2) * 256 + (cb & 3) * 64 + pp * 32; esz = 1; }
        else { r -= 128; src = p.w_shd; ld = 1024; K = 256; cb = r >> 1; kt = r & 1; dst = p.ws + OFF_WT_SHD; drow0 = cb * 32; esz = 1; }
    } else {
        const int r = id - NDENSE, m = r / (256 * 64), e = (r >> 6) & 255, tl = r & 63;
        esz = 1;
        if (m < 2) { src = (m ? p.w_eu : p.w_eg) + (size_t)e * 1024 * 256; ld = 256; K = 1024; cb = tl >> 3; kt = tl & 7;
                     dst = p.ws + OFF_WT_GU + (size_t)e * 512 * 1024; drow0 = (cb >> 2) * 256 + (cb & 3) * 64 + m * 32; }
        else { src = p.w_ed + (size_t)e * 256 * 1024; ld = 1024; K = 256; cb = tl >> 1; kt = tl & 1; dst = p.ws + OFF_WT_D + (size_t)e * 1024 * 256; drow0 = cb * 32; }
    }
    CTile t; t.src = src + (size_t)(kt * 128) * ld + colbase + cb * 32; t.dst = dst + ((size_t)drow0 * K + kt * 128) * esz; t.ld = ld; t.ldd = K * esz; t.esz = esz;
    return t;
}
__device__ __forceinline__ uint2 pack8_fp8(const float (&v)[8]) {
    int w0 = __builtin_amdgcn_cvt_pk_fp8_f32(v[0], v[1], 0, false); w0 = __builtin_amdgcn_cvt_pk_fp8_f32(v[2], v[3], w0, true);
    int w1 = __builtin_amdgcn_cvt_pk_fp8_f32(v[4], v[5], 0, false); w1 = __builtin_amdgcn_cvt_pk_fp8_f32(v[6], v[7], w1, true);
    return make_uint2((unsigned)w0, (unsigned)w1);
}
__device__ void st_convert(const P& p, float* lds) {
    const int tid = tidx();
    const int NTOT = 2048 + 3 * 256 * 64;
    float4 v[4][2];
    auto issue = [&](int base) {
#pragma unroll
        for (int j = 0; j < 4; ++j) {
            const CTile t = conv_decode(p, base + j);
#pragma unroll
            for (int i = 0; i < 2; ++i) v[j][i] = *(const float4*)(t.src + (size_t)((tid >> 3) + 64 * i) * t.ld + (tid & 7) * 4);
        }
    };
    if (blockIdx.x * 4 < NTOT) issue(blockIdx.x * 4);
    for (int base = blockIdx.x * 4; base < NTOT; base += gridDim.x * 4) {
        __syncthreads();
#pragma unroll
        for (int j = 0; j < 4; ++j)
#pragma unroll
            for (int i = 0; i < 2; ++i) {
                float* d = lds + j * (128 * 33) + ((tid >> 3) + 64 * i) * 33 + (tid & 7) * 4;
                d[0] = v[j][i].x; d[1] = v[j][i].y; d[2] = v[j][i].z; d[3] = v[j][i].w;
            }
        __syncthreads();
        if (base + (int)gridDim.x * 4 < NTOT) issue(base + gridDim.x * 4);
#pragma unroll
        for (int j = 0; j < 4; ++j) {
            const CTile t = conv_decode(p, base + j);
            const int n = tid >> 4, kc = tid & 15;
            float o[8];
#pragma unroll
            for (int q = 0; q < 8; ++q) o[q] = lds[j * (128 * 33) + (kc * 8 + q) * 33 + n];
            if (t.esz == 2) *(uint4*)(t.dst + (size_t)n * t.ldd + kc * 16) = pack8(o);
            else {
#pragma unroll
                for (int q = 0; q < 8; ++q) o[q] *= W8_SCALE;
                *(uint2*)(t.dst + (size_t)n * t.ldd + kc * 8) = pack8_fp8(o);
            }
        }
    }
    __syncthreads();
    bf16_t* tw = (bf16_t*)(p.ws + OFF_TRILW);
    for (int i = blockIdx.x * NT + tidx(); i < 4 * 128 * 128; i += gridDim.x * NT) { const int t = (i >> 7) & 127, s = i & 127; tw[i] = s <= t ? f2bf(p.sg_w[i]) : (bf16_t)0; }
}

constexpr int XT_BYTES = 128 * 128, WT_BYTES = 256 * 128, STG_BYTES = XT_BYTES + WT_BYTES;
constexpr size_t OFF_ZERO = 480 * MiB + 320 * 1024;
#define LAS3 __attribute__((address_space(3)))

template <class F> __device__ __forceinline__ void epi_each(const f32x4 (&acc)[4][4], F f) {
    const int lane = tidx() & 63, wid = tidx() >> 6, wr = wid >> 2, wc = wid & 3, fr = lane & 15, fg = lane >> 4;
#pragma unroll
    for (int mi = 0; mi < 4; ++mi)
#pragma unroll
        for (int pp = 0; pp < 2; ++pp) {
            const float v[8] = {acc[mi][2 * pp][0], acc[mi][2 * pp][1], acc[mi][2 * pp][2], acc[mi][2 * pp][3],
                                acc[mi][2 * pp + 1][0], acc[mi][2 * pp + 1][1], acc[mi][2 * pp + 1][2], acc[mi][2 * pp + 1][3]};
            f(wr * 64 + mi * 16 + fr, wc * 64 + pp * 32 + 8 * fg, v);
        }
}

__device__ __forceinline__ uint4 dpp_ror8(const uint4 v) {
    uint4 r;
    r.x = (unsigned)__builtin_amdgcn_update_dpp(0, (int)v.x, 0x128, 0xf, 0xf, false); r.y = (unsigned)__builtin_amdgcn_update_dpp(0, (int)v.y, 0x128, 0xf, 0xf, false);
    r.z = (unsigned)__builtin_amdgcn_update_dpp(0, (int)v.z, 0x128, 0xf, 0xf, false); r.w = (unsigned)__builtin_amdgcn_update_dpp(0, (int)v.w, 0x128, 0xf, 0xf, false);
    return r;
}
template <class F, class G> __device__ __forceinline__ void epi_rows(const f32x4 (&acc)[4][4], F f, G st) {
    const int lane = tidx() & 63, wid = tidx() >> 6, wr = wid >> 2, wc = wid & 3, fr = lane & 15, fg = lane >> 4;
    const bool lo = fr < 8;
#pragma unroll
    for (int mi = 0; mi < 4; ++mi) {
        const float a0[8] = {acc[mi][0][0], acc[mi][0][1], acc[mi][0][2], acc[mi][0][3], acc[mi][1][0], acc[mi][1][1], acc[mi][1][2], acc[mi][1][3]};
        const float a1[8] = {acc[mi][2][0], acc[mi][2][1], acc[mi][2][2], acc[mi][2][3], acc[mi][3][0], acc[mi][3][1], acc[mi][3][2], acc[mi][3][3]};
        const int r = wr * 64 + mi * 16 + fr, c0 = wc * 64 + 8 * fg;
        const uint4 A = f(r, c0, a0), B = f(r, c0 + 32, a1);
        const uint4 Bs = dpp_ror8(B);
        const int rb = wr * 64 + mi * 16 + (fr & 7);
        st(rb, lo ? c0 : c0 + 32, lo ? A : Bs);
        st(rb + 8, lo ? c0 + 32 : c0, lo ? Bs : A);
    }
}

template <bool A_LDS, int ESTORES, class RowPtr, class WPtr, class Epi>
__device__ __forceinline__ void gemm_panel(RowPtr rp, const char* Hs, int hstride, WPtr wp, int ldw, int nk, int nv, char* stage, Epi epi) {
    const int tid = tidx(), lane = tid & 63, wid = tid >> 6, wr = wid >> 2, wc = wid & 3, fr = lane & 15, fg = lane >> 4;
    constexpr int XOFF = A_LDS ? 0 : XT_BYTES, BUFB = A_LDS ? WT_BYTES : STG_BYTES;
    const int l8 = lane >> 3, kcl = ((lane & 7) ^ l8) * 8;
    auto gload = [&](int v, int kt, int buf) {
        char* b = stage + buf * BUFB + lane * 16;
        const int k0 = kt * 64 + kcl;
        if constexpr (!A_LDS) {
#pragma unroll
            for (int i = 0; i < 2; ++i) {
                const int q = wid + 8 * i;
                __builtin_amdgcn_global_load_lds((const unsigned*)(rp(v, q * 8 + l8) + k0), (LAS3 unsigned*)(b + q * 1024), 16, 0, 0);
            }
        }
        const bf16_t* wb = wp(v) + k0;
#pragma unroll
        for (int i = 0; i < 4; ++i) {
            const int q = wid + 8 * i, rho = q * 8 + l8, ii = rho & 15;
            const int n = (rho & ~31) + 8 * (ii >> 2) + (ii & 3) + ((rho >> 2) & 4);
            __builtin_amdgcn_global_load_lds((const unsigned*)(wb + (size_t)n * ldw), (LAS3 unsigned*)(b + XOFF + q * 1024), 16, 0, 0);
        }
    };
    const int S = nk * nv;
    constexpr int NST = A_LDS ? 2 : 3;
    gload(0, 0, 0);
    if constexpr (NST == 3) { if (S > 1) gload(nk > 1 ? 0 : 1, nk > 1 ? 1 : 0, 1); }
    f32x4 acc[4][4];
    int v = 0, kt = 0;
    int vp = 0, ktp = 0;
#pragma unroll
    for (int i = 0; i < NST - 1; ++i) { if (++ktp == nk) { ktp = 0; ++vp; } }
    int bufc = 0, bufp = NST - 1;
    const int xc0 = (fg ^ (fr & 7)) * 16;
    const int wrow_off = (wc * 64 + fr) * 128;
    const int xrow_off = (wr * 64 + fr) * 128;
    bool pend = false; int vpend = 0;
    int since = 2;
    for (int s = 0; s < S; ++s) {
        if (NST == 3 && s + 1 < S) {
            if constexpr (A_LDS) asm volatile("s_waitcnt vmcnt(4)" ::: "memory");
            else if (ESTORES > 0 && since < 2) asm volatile("s_waitcnt vmcnt(%0)" :: "n"(6 + ESTORES) : "memory");
            else asm volatile("s_waitcnt vmcnt(6)" ::: "memory");
        }
        else asm volatile("s_waitcnt vmcnt(0)" ::: "memory");
        __builtin_amdgcn_s_barrier();
        if (pend) { epi(vpend, acc); pend = false; }
        if (s + NST - 1 < S) gload(vp, ktp, bufp);
        if (kt == 0) {
#pragma unroll
            for (int mi = 0; mi < 4; ++mi)
#pragma unroll
                for (int ni = 0; ni < 4; ++ni) acc[mi][ni] = (f32x4){0.f, 0.f, 0.f, 0.f};
        }
        const char* b = stage + bufc * BUFB;
#pragma unroll
        for (int ks = 0; ks < 2; ++ks) {
            bf16x8 xf[4], wf[4];
#pragma unroll
            for (int mi = 0; mi < 4; ++mi) {
                if constexpr (A_LDS) xf[mi] = *(const bf16x8*)(Hs + (wr * 64 + mi * 16 + fr) * hstride + (kt * 64 + ks * 32 + fg * 8) * 2);
                else xf[mi] = *(const bf16x8*)(b + xrow_off + mi * 2048 + (xc0 ^ (ks * 64)));
            }
#pragma unroll
            for (int ni = 0; ni < 4; ++ni) wf[ni] = *(const bf16x8*)(b + XOFF + wrow_off + ni * 2048 + (xc0 ^ (ks * 64)));
#pragma unroll
            for (int mi = 0; mi < 4; ++mi)
#pragma unroll
                for (int ni = 0; ni < 4; ++ni) acc[mi][ni] = __builtin_amdgcn_mfma_f32_16x16x32_bf16(wf[ni], xf[mi], acc[mi][ni], 0, 0, 0);
        }
        if (ESTORES > 0) { if (kt == nk - 1) { epi(v, acc); since = 0; } else if (since < 2) ++since; }
        else if (kt == nk - 1) { pend = true; vpend = v; }
        if (++kt == nk) { kt = 0; ++v; }
        if (++ktp == nk) { ktp = 0; ++vp; }
        if (++bufc == NST) bufc = 0;
        if (++bufp == NST) bufp = 0;
    }
    if (pend) epi(vpend, acc);
    __syncthreads();
}

typedef unsigned char u8_t;
template <bool A_LDS, int ESTORES, class RowPtr, class WPtr, class Epi>
__device__ __forceinline__ void gemm_panel8(RowPtr rp, const char* Hs, int hstride, WPtr wp, int ldw, int nk, int nv, char* stage, Epi epi) {
    const int tid = tidx(), lane = tid & 63, wid = __builtin_amdgcn_readfirstlane(tid >> 6), wr = wid >> 2, wc = wid & 3, fr = lane & 15, fg = lane >> 4;
    constexpr int XOFF = A_LDS ? 0 : XT_BYTES, BUFB = A_LDS ? WT_BYTES : STG_BYTES;
    const int l8 = lane >> 3;
    auto gload = [&](int v, int kt, int buf) {
        char* b = stage + buf * BUFB + lane * 16;
        if constexpr (!A_LDS) {
#pragma unroll
            for (int i = 0; i < 2; ++i) {
                const int q = wid + 8 * i, k0 = kt * 128 + (((lane & 7) ^ l8 ^ (q & 1)) << 4);
                __builtin_amdgcn_global_load_lds((const unsigned*)(rp(v, q * 8 + l8) + k0), (LAS3 unsigned*)(b + q * 1024), 16, 0, 0);
            }
        }
        const u8_t* wb = wp(v) + kt * 128;
#pragma unroll
        for (int i = 0; i < 4; ++i) {
            const int q = wid + 8 * i, rho = q * 8 + l8, ii = rho & 15;
            const int n = (rho & ~31) + 8 * (ii >> 2) + (ii & 3) + ((rho >> 2) & 4);
            __builtin_amdgcn_global_load_lds((const unsigned*)(wb + (size_t)n * ldw + (((lane & 7) ^ l8 ^ (q & 1)) << 4)), (LAS3 unsigned*)(b + XOFF + q * 1024), 16, 0, 0);
        }
    };
    const int S = nk * nv;
    gload(0, 0, 0);
    if (S > 1) gload(nk > 1 ? 0 : 1, nk > 1 ? 1 : 0, 1);
    f32x4 acc[4][4];
    int v = 0, kt = 0, vp = 0, ktp = 0;
#pragma unroll
    for (int i = 0; i < 2; ++i) { if (++ktp == nk) { ktp = 0; ++vp; } }
    int bufc = 0, bufp = 2;
    const int sw = (fr & 7) ^ (fr >> 3);
    const int wrow_off = XOFF + (wc * 64 + fr) * 128 + (fg & 1) * 8;
    const int xrow_off = (wr * 64 + fr) * 128 + (fg & 1) * 8;
    bool pend = false; int vpend = 0;
    int since = 2;
    constexpr int PER = A_LDS ? 4 : 6;
    for (int s = 0; s < S; ++s) {
        if (s + 1 < S) {
            if (ESTORES > 0 && since < 2) asm volatile("s_waitcnt vmcnt(%0)" :: "n"(PER + ESTORES) : "memory");
            else asm volatile("s_waitcnt vmcnt(%0)" :: "n"(PER) : "memory");
        }
        else asm volatile("s_waitcnt vmcnt(0)" ::: "memory");
        __builtin_amdgcn_s_barrier();
        if (pend) { epi(vpend, acc); pend = false; }
        if (s + 2 < S) gload(vp, ktp, bufp);
        if (kt == 0) {
#pragma unroll
            for (int mi = 0; mi < 4; ++mi)
#pragma unroll
                for (int ni = 0; ni < 4; ++ni) acc[mi][ni] = (f32x4){0.f, 0.f, 0.f, 0.f};
        }
        const char* b = stage + bufc * BUFB;
#pragma unroll
        for (int ks = 0; ks < 4; ++ks) {
            long xf[4], wf[4];
            const int co = ((ks * 2 + (fg >> 1)) ^ sw) << 4;
#pragma unroll
            for (int mi = 0; mi < 4; ++mi) {
                if constexpr (A_LDS) xf[mi] = *(const long*)(Hs + (wr * 64 + mi * 16 + fr) * hstride + kt * 128 + ks * 32 + fg * 8);
                else xf[mi] = *(const long*)(b + xrow_off + mi * 2048 + co);
            }
#pragma unroll
            for (int ni = 0; ni < 4; ++ni) wf[ni] = *(const long*)(b + wrow_off + ni * 2048 + co);
#pragma unroll
            for (int mi = 0; mi < 4; ++mi)
#pragma unroll
                for (int ni = 0; ni < 4; ++ni) acc[mi][ni] = __builtin_amdgcn_mfma_f32_16x16x32_fp8_fp8(wf[ni], xf[mi], acc[mi][ni], 0, 0, 0);
        }
        if (ESTORES > 0) { if (kt == nk - 1) { epi(v, acc); since = 0; } else if (since < 2) ++since; }
        else if (kt == nk - 1) { pend = true; vpend = v; }
        if (++kt == nk) { kt = 0; ++v; }
        if (++ktp == nk) { ktp = 0; ++vp; }
        if (++bufc == 3) bufc = 0;
        if (++bufp == 3) bufp = 0;
    }
    if (pend) epi(vpend, acc);
    __syncthreads();
}

__device__ void st_inproj_fast(const P& p, char* lds, int abl) {
    const bf16_t* hm = (const bf16_t*)(p.ws + OFF_HM);
    const bf16_t* wt = (const bf16_t*)(p.ws + OFF_WT_IN);
    bf16_t* qkv = (bf16_t*)(p.ws + OFF_QKV); bf16_t* zs = (bf16_t*)(p.ws + OFF_ZS); bf16_t* ug = (bf16_t*)(p.ws + OFF_UG);
    bf16_t* vgg = (bf16_t*)(p.ws + OFF_VGG); bf16_t* gate = (bf16_t*)(p.ws + OFF_GATE);
    bf16_t* lbias = (bf16_t*)(lds + 3 * STG_BYTES);
    for (int i = tidx(); i < 2048; i += NT) lbias[i] = f2bf(p.b_bg[i]);
    __syncthreads();
    for (int panel = blockIdx.x; panel < T / 128; panel += gridDim.x) {
        const size_t t0 = (size_t)panel * 128;
        auto epi = [&](int v, const f32x4 (&acc)[4][4]) {
            if (abl == 1) { if (acc[0][0][0] == 12345.678f) qkv[0] = 1; return; }
            epi_rows(acc,
                [&](int r, int c, const float (&a_)[8]) {
                    const int col = v * 256 + c;
                    float a[8], o[8];
#pragma unroll
                    for (int j = 0; j < 8; ++j) a[j] = (IN8 && v >= 8) ? a_[j] * W8_INV : a_[j];
                    if (v < 6 || abl == 2) {
#pragma unroll
                        for (int j = 0; j < 8; ++j) o[j] = a[j];
                    } else if (v < 8) {
#pragma unroll
                        for (int j = 0; j < 8; ++j) o[j] = fsilu_(a[j]);
                    } else if (v < 12) {
#pragma unroll
                        for (int j = 0; j < 8; ++j) o[j] = fgelu_(a[j]);
                    } else {
                        float bs[8]; unpack8(*(const uint4*)(lbias + (col - 3072)), bs);
#pragma unroll
                        for (int j = 0; j < 8; ++j) o[j] = fsigmoid_(a[j] + bs[j]);
                    }
                    return pack8(o);
                },
                [&](int r, int c, const uint4 d) {
                    const size_t t = t0 + r; const int col = v * 256 + c;
                    if (v < 6) *(uint4*)(qkv + t * 1536 + col) = d;
                    else if (v < 8) *(uint4*)(zs + t * 512 + (col - 1536)) = d;
                    else if (v < 10) *(uint4*)(ug + t * 512 + (col - 2048)) = d;
                    else if (v < 12) *(uint4*)(vgg + t * 512 + (col - 2560)) = d;
                    else *(uint4*)(gate + t * 2048 + (col - 3072)) = d;
                });
        };
        if (IN8) {
            gemm_panel<false, 8>([&](int, int r) { return hm + (t0 + r) * D; }, nullptr, 0, [&](int v) { return wt + (size_t)v * 256 * D; }, D, 16, 8, lds, epi);
            gemm_panel8<false, 0>([&](int, int r) { return (const u8_t*)(p.ws + OFF_HM8) + (t0 + r) * D; }, nullptr, 0,
                               [&](int v) { return (const u8_t*)(p.ws + OFF_WT_IN8) + (size_t)(v + 8) * 256 * D; }, D, 8, 12, lds,
                               [&](int v, const f32x4 (&acc)[4][4]) { epi(v + 8, acc); });
        } else gemm_panel<false, 8>([&](int, int r) { return hm + (t0 + r) * D; }, nullptr, 0, [&](int v) { return wt + (size_t)v * 256 * D; }, D, 16, 20, lds, epi);
    }
}

constexpr int HSTRIDE = 272;
constexpr int HS_BYTES = 35 * 1024;
constexpr int LDS_ENT = 148 * 1024;

template <class RowSrc, class Store>
__device__ __forceinline__ void moe_tile(RowSrc rowsrc, const u8_t* wgu, const u8_t* wd, char* lds, Store store) {
    const int lane = tidx() & 63, wid = tidx() >> 6, wr = wid >> 2, wc = wid & 3, fr = lane & 15, fg = lane >> 4;
    uint2 h0[4], h1[4];
    gemm_panel8<false, 0>([&](int, int r) { return rowsrc(r); }, nullptr, 0, [&](int v) { return wgu + (size_t)v * 256 * D; }, D, 8, 2, lds,
                       [&](int v, const f32x4 (&acc)[4][4]) {
#pragma unroll
                           for (int mi = 0; mi < 4; ++mi) {
                               float h[8];
#pragma unroll
                               for (int j = 0; j < 4; ++j) {
                                   h[j] = fsilu_(acc[mi][0][j] * W8_INV) * (acc[mi][2][j] * W8_INV);
                                   h[4 + j] = fsilu_(acc[mi][1][j] * W8_INV) * (acc[mi][3][j] * W8_INV);
                               }
                               if (v == 0) h0[mi] = pack8_fp8(h); else h1[mi] = pack8_fp8(h);
                           }
                       });
#pragma unroll
    for (int mi = 0; mi < 4; ++mi) {
        char* hp = lds + (wr * 64 + mi * 16 + fr) * HSTRIDE + wc * 32 + 8 * fg;
        *(uint2*)(hp) = h0[mi]; *(uint2*)(hp + 128) = h1[mi];
    }
    __syncthreads();
    gemm_panel8<true, 8>([&](int, int) { return (const u8_t*)nullptr; }, lds, HSTRIDE, [&](int v) { return wd + (size_t)v * 256 * EH; }, EH, 2, 4, lds + HS_BYTES,
                      [&](int v, const f32x4 (&acc)[4][4]) { epi_each(acc, [&](int r, int c, const float (&a)[8]) { store(r, v * 256 + c, a); }); });
}

constexpr size_t OFF_TRASH = 505 * MiB;
__device__ __forceinline__ void st_moe_fast(const P& p, char* lds, bool fin, int which) {
    const u8_t* hf8 = (const u8_t*)(p.ws + OFF_HF8);
    bf16_t* contrib = (bf16_t*)(p.ws + OFF_CONTRIB);
    bf16_t* sho = (bf16_t*)(p.ws + OFF_SHO);
    bf16_t* trash = (bf16_t*)(p.ws + OFF_TRASH) + (size_t)blockIdx.x * D;
    const unsigned* cnt = (const unsigned*)(p.ws + OFF_CNT);
    const int* lists = (const int*)(p.ws + OFF_LISTS);
    const float* wts = (const float*)(p.ws + OFF_WTS);
    int* ent = (int*)(lds + LDS_ENT);
    int* tstart = ent + 128;
    float* wrow = (float*)(tstart + 260);
    __syncthreads();
    if (tidx() == 0) { int acc = 0; for (int e = 0; e < NE; ++e) { tstart[e] = acc; acc += ((int)cnt[e] + 127) >> 7; } tstart[NE] = acc; }
    __syncthreads();
    const int ntiles = which ? 0 : tstart[NE];
    int e = 0;
    for (int tile = blockIdx.x; tile < (which ? T / 128 : ntiles); tile += gridDim.x) {
        if (tile < ntiles) {
            while (tstart[e + 1] <= tile) ++e;
            const int r0 = (tile - tstart[e]) * 128, ce = (int)cnt[e];
            __syncthreads();
            if (tidx() < 128) { const int en = (r0 + (int)tidx() < ce) ? lists[(size_t)e * LCAP + r0 + tidx()] : -1; ent[tidx()] = en; wrow[tidx()] = en >= 0 ? wts[en] * W8_INV : 0.f; }
            __syncthreads();
            moe_tile([&](int r) { const int en = ent[r]; return en >= 0 ? hf8 + (size_t)(en >> 3) * D : (const u8_t*)(p.ws + OFF_ZERO); },
                     (const u8_t*)(p.ws + OFF_WT_GU) + (size_t)e * 512 * D, (const u8_t*)(p.ws + OFF_WT_D) + (size_t)e * D * EH, lds,
                     [&](int r, int col, const float (&a)[8]) {
                         const int en = ent[r];
                         const float w = wrow[r];
                         float o[8];
#pragma unroll
                         for (int j = 0; j < 8; ++j) o[j] = a[j] * w;
                         bf16_t* dst = (en >= 0 && fin) ? contrib + (size_t)en * D + col : trash + col;
                         *(uint4*)dst = pack8(o);
                     });
        } else {
            const size_t t0 = (size_t)(tile - ntiles) * 128;
            __syncthreads();
            moe_tile([&](int r) { return hf8 + (t0 + r) * D; }, (const u8_t*)(p.ws + OFF_WT_SHGU), (const u8_t*)(p.ws + OFF_WT_SHD), lds,
                     [&](int r, int col, const float (&a)[8]) {
                         float o[8];
#pragma unroll
                         for (int j = 0; j < 8; ++j) o[j] = a[j] * W8_INV;
                         *(uint4*)(sho + (t0 + r) * D + col) = pack8(o);
                     });
        }
    }
}

constexpr size_t OFF_MERGEDB = 736 * MiB;
__device__ __forceinline__ void wg_sync() { asm volatile("s_waitcnt vmcnt(0)" ::: "memory"); __syncthreads(); }
struct TopE { float v; int e; };
__device__ __forceinline__ bool better(const TopE& a, const TopE& b) { return a.v > b.v || (a.v == b.v && a.e < b.e); }

__device__ void st_post_fast(const P& p, char* lds, bool fin) {
    const int tid = tidx(), lane = tid & 63, wid = tid >> 6, wr = wid >> 2, wc = wid & 3, fr = lane & 15, fg = lane >> 4;
    const bf16_t* ydn = (const bf16_t*)(p.ws + OFF_O); const bf16_t* ysg = (const bf16_t*)(p.ws + OFF_YSG);
    const bf16_t* gate = (const bf16_t*)(p.ws + OFF_GATE);
    bf16_t* mg = (bf16_t*)(p.ws + OFF_MERGEDB);
    float* y = (float*)(p.ws + OFF_Y);
    const bf16_t* hf = (const bf16_t*)(p.ws + OFF_HF);
    unsigned* cnt = (unsigned*)(p.ws + OFF_CNT);
    int* lists = (int*)(p.ws + OFF_LISTS);
    float* wts = (float*)(p.ws + OFF_WTS);
    float* sc = (float*)lds;
    float* bias = (float*)(lds + 131584);
    int* hist = (int*)(lds + 132608);
    int* base = (int*)(lds + 133632);
    for (int panel = blockIdx.x; panel < T / 128; panel += gridDim.x) {
        const size_t t0 = (size_t)panel * 128;
        if (fin) for (int r = wid; r < 128; r += 8) ydn_token(p, (int)t0 + r, lane);
        wg_sync();
        {
            gemm_panel<false, 8>([&](int v, int r) { return ((v & 1) ? ysg : ydn) + (t0 + r) * 512; }, nullptr, 0,
                              [&](int v) { return (const bf16_t*)(p.ws + ((v & 1) ? OFF_WT_SG : OFF_WT_DN)) + (size_t)(v >> 1) * 256 * 512; }, 512, 8, 8, lds,
                              [&](int v, const f32x4 (&acc)[4][4]) {
                                  uint4 gv[4][2], mv[4][2];
#pragma unroll
                                  for (int mi = 0; mi < 4; ++mi)
#pragma unroll
                                      for (int pp = 0; pp < 2; ++pp) {
                                          const size_t t = t0 + wr * 64 + mi * 16 + fr; const int col = (v >> 1) * 256 + wc * 64 + pp * 32 + 8 * fg;
                                          gv[mi][pp] = *(const uint4*)(gate + t * 2048 + (v & 1) * 1024 + col);
                                          if (v & 1) mv[mi][pp] = *(const uint4*)(mg + t * D + col);
                                      }
#pragma unroll
                                  for (int mi = 0; mi < 4; ++mi)
#pragma unroll
                                      for (int pp = 0; pp < 2; ++pp) {
                                          const size_t t = t0 + wr * 64 + mi * 16 + fr; const int col = (v >> 1) * 256 + wc * 64 + pp * 32 + 8 * fg;
                                          float g[8], o[8]; unpack8(gv[mi][pp], g);
                                          const float a[8] = {acc[mi][2 * pp][0], acc[mi][2 * pp][1], acc[mi][2 * pp][2], acc[mi][2 * pp][3],
                                                              acc[mi][2 * pp + 1][0], acc[mi][2 * pp + 1][1], acc[mi][2 * pp + 1][2], acc[mi][2 * pp + 1][3]};
                                          if (v & 1) {
                                              float m[8]; unpack8(mv[mi][pp], m);
#pragma unroll
                                              for (int j = 0; j < 8; ++j) o[j] = m[j] + g[j] * a[j];
                                          } else {
#pragma unroll
                                              for (int j = 0; j < 8; ++j) o[j] = g[j] * a[j];
                                          }
                                          *(uint4*)(mg + t * D + col) = pack8(o);
                                      }
                              });
        }
        wg_sync();
        gemm_panel<false, 16>([&](int, int r) { return mg + (t0 + r) * D; }, nullptr, 0, [&](int v) { return (const bf16_t*)(p.ws + OFF_WT_OUT) + (size_t)v * 256 * D; }, D, 16, 4, lds,
                          [&](int v, const f32x4 (&acc)[4][4]) {
                              epi_each(acc, [&](int r, int c, const float (&a)[8]) {
                                  float* dst = y + (t0 + r) * D + v * 256 + c;
                                  *(float4*)dst = make_float4(a[0], a[1], a[2], a[3]); *(float4*)(dst + 4) = make_float4(a[4], a[5], a[6], a[7]);
                              });
                          });
        wg_sync();
        for (int r = wid; r < 128; r += 8) x1hf_row(p, (int)t0 + r, lane);
        wg_sync();
        {
            f32x4 racc[4][4];
            gemm_panel<false, 0>([&](int, int r) { return hf + (t0 + r) * D; }, nullptr, 0, [&](int) { return (const bf16_t*)(p.ws + OFF_WT_RT); }, D, 16, 1, lds,
                              [&](int, const f32x4 (&acc)[4][4]) {
#pragma unroll
                                  for (int mi = 0; mi < 4; ++mi)
#pragma unroll
                                      for (int ni = 0; ni < 4; ++ni) racc[mi][ni] = acc[mi][ni];
                              });
            epi_each(racc, [&](int r, int c, const float (&a)[8]) {
#pragma unroll
                for (int j = 0; j < 8; ++j) sc[r * 257 + c + j] = fsigmoid_(a[j]);
            });
        }
        { int tt = tid; asm volatile("" : "+v"(tt)); if (tt < 256) { bias[tt] = p.router_bias[tt]; hist[tt] = 0; } }
        __syncthreads();
        {
            const int tok = tid >> 2, q = tid & 3;
            const float* srow = sc + tok * 257;
            TopE l[8];
#pragma unroll
            for (int k = 0; k < 8; ++k) { l[k].v = -INFINITY; l[k].e = 1 << 30; }
            float a1 = -INFINITY, a2 = -INFINITY, b1 = -INFINITY, b2 = -INFINITY;
            for (int i = 0; i < 64; ++i) {
                const int idx = (i + 8 * q) & 63, e = 64 * q + idx;
                const float v = srow[e] + bias[e];
                if (idx < 32) { if (v > a1) { a2 = a1; a1 = v; } else if (v > a2) a2 = v; }
                else { if (v > b1) { b2 = b1; b1 = v; } else if (v > b2) b2 = v; }
            }
            const float gs0 = a1 + a2, gs1 = b1 + b2;
            int r0 = 0, r1 = 0;
#pragma unroll
            for (int h = 0; h < 8; ++h) {
                const float gh = __shfl((h & 1) ? gs1 : gs0, (lane & ~3) | (h >> 1));
                r0 += (gh > gs0 || (gh == gs0 && h < 2 * q)) ? 1 : 0;
                r1 += (gh > gs1 || (gh == gs1 && h < 2 * q + 1)) ? 1 : 0;
            }
            const bool sel0 = r0 < 4, sel1 = r1 < 4;
            for (int i = 0; i < 64; ++i) {
                const int idx = (i + 8 * q) & 63, e = 64 * q + idx;
                if (idx < 32 ? sel0 : sel1) {
                    TopE cur; cur.v = srow[e] + bias[e]; cur.e = e;
                    if (better(cur, l[7])) {
#pragma unroll
                        for (int k = 0; k < 8; ++k) if (better(cur, l[k])) { const TopE tmp = l[k]; l[k] = cur; cur = tmp; }
                    }
                }
            }
            int we[8]; float wv[8]; float wsum = 0.f;
#pragma unroll
            for (int k = 0; k < 8; ++k) {
                TopE h = l[0];
#pragma unroll
                for (int o = 1; o < 4; o <<= 1) { TopE t2; t2.v = __shfl_xor(h.v, o); t2.e = __shfl_xor(h.e, o); if (better(t2, h)) h = t2; }
                if (l[0].e == h.e) {
#pragma unroll
                    for (int j = 0; j < 7; ++j) l[j] = l[j + 1];
                    l[7].v = -INFINITY; l[7].e = 1 << 30;
                }
                we[k] = h.e; wv[k] = srow[h.e]; wsum += wv[k];
            }
            const float inv = 2.5f / wsum;
            int rk0 = 0, rk1 = 0, e0 = 0, e1 = 0; float w0 = 0.f, w1 = 0.f;
#pragma unroll
            for (int k = 0; k < 8; ++k) if ((k >> 1) == q) { if (k & 1) { e1 = we[k]; w1 = wv[k] * inv; } else { e0 = we[k]; w0 = wv[k] * inv; } }
            rk0 = atomicAdd(&hist[e0], 1); rk1 = atomicAdd(&hist[e1], 1);
            __syncthreads();
            { int tt = tid; asm volatile("" : "+v"(tt)); if (tt < 256) { const int c = hist[tt]; base[tt] = (c > 0 && fin) ? (int)atomicAdd(&cnt[tt], (unsigned)c) : 0; } }
            __syncthreads();
            const int tg = (int)t0 + tok;
            if (fin) {
            lists[(size_t)e0 * LCAP + base[e0] + rk0] = tg * 8 + 2 * q; wts[tg * 8 + 2 * q] = w0;
            lists[(size_t)e1 * LCAP + base[e1] + rk1] = tg * 8 + 2 * q + 1; wts[tg * 8 + 2 * q + 1] = w1;
            }
        }
        __syncthreads();
    }
}

constexpr size_t OFF_GL  = 480 * MiB + 128 * 1024;
constexpr size_t OFF_KDT = 960 * MiB;
constexpr size_t OFF_QKF = 992 * MiB;
constexpr int DN_HALF = 73728;
constexpr int DQS = 0, DKS = 18432, DLS = 36864, DWL = 53248, DMISC = 71680;

__device__ __forceinline__ bf16x8 pack_b(const f32x4 a, const f32x4 b) {
    const uint4 u = make_uint4(pk2(a[0], a[1]), pk2(a[2], a[3]), pk2(b[0], b[1]), pk2(b[2], b[3]));
    return __builtin_bit_cast(bf16x8, u);
}

__device__ void st_dnprep_fast(const P& p, char* lds, int abl) {
    const int tid0 = tidx();
    const bf16_t* qkv = (const bf16_t*)(p.ws + OFF_QKV);
    const float* gb = (const float*)(p.ws + OFF_G); const float* bb = (const float*)(p.ws + OFF_BETA);
    float* GL = (float*)(p.ws + OFF_GL);
    bf16_t* KDT = (bf16_t*)(p.ws + OFF_KDT); bf16_t* QKF = (bf16_t*)(p.ws + OFF_QKF);
    float* UF = p.out; bf16_t* WC = (bf16_t*)((char*)p.out + 64 * MiB); bf16_t* QD = (bf16_t*)((char*)p.out + 96 * MiB);
    for (int it = blockIdx.x; it < 1024; it += gridDim.x) {
        int tid = tid0; asm volatile("" : "+v"(tid));
        const int lane = tid & 63, wid = tid >> 6, hb = wid >> 2, hw = __builtin_amdgcn_readfirstlane(wid & 3), ht = tid & 255, fr = lane & 15, fg = lane >> 4;
        char* L = lds + hb * DN_HALF;
        bf16_t* Qs = (bf16_t*)(L + DQS); bf16_t* Ks = (bf16_t*)(L + DKS); float* Ls = (float*)(L + DLS); bf16_t* Wl = (bf16_t*)(L + DWL);
        float* gc = (float*)(L + DMISC); float* beta = gc + 64; float* egc = gc + 128; float* ekl = gc + 192; float* rnq = gc + 256;
        const int unit = it * 2 + hb, h = unit & 3, cn = unit >> 2, t0 = cn * 64, s0 = t0 % SEQ;
        __syncthreads();
        if (hw == 0) {
            const float g = gb[(t0 + lane) * 4 + h], be = bb[(t0 + lane) * 4 + h];
            float c = g;
#pragma unroll
            for (int o = 1; o < 64; o <<= 1) { const float t = __shfl_up(c, o); if (lane >= o) c += t; }
            const float gl = __shfl(c, 63);
            gc[lane] = c; beta[lane] = be; egc[lane] = expf(c); ekl[lane] = expf(gl - c);
            if (lane == 0) GL[unit] = expf(gl);
        }
        {
            const int part = ht >> 7, c = ht & 127, col = part * 512 + h * 128 + c;
            bf16_t* dstp = (part ? Ks : Qs) + c;
            float cw[4];
#pragma unroll
            for (int tap = 0; tap < 4; ++tap) cw[tap] = p.conv_w[tap * 1536 + col];
            float w0 = (s0 >= 3) ? bf2f(qkv[(size_t)(t0 - 3) * 1536 + col]) : 0.f;
            float w1 = (s0 >= 2) ? bf2f(qkv[(size_t)(t0 - 2) * 1536 + col]) : 0.f;
            float w2 = (s0 >= 1) ? bf2f(qkv[(size_t)(t0 - 1) * 1536 + col]) : 0.f;
            if (!(abl & 1)) {
#pragma unroll
            for (int i = 0; i < 64; ++i) {
                const float w3 = bf2f(qkv[(size_t)(t0 + i) * 1536 + col]);
                dstp[i * 144] = f2bf(fsilu_(w0 * cw[0] + w1 * cw[1] + w2 * cw[2] + w3 * cw[3]));
                w0 = w1; w1 = w2; w2 = w3;
            }
            }
        }
        __syncthreads();
        if (ht < 128) {
            const int part = ht >> 6, row = ht & 63;
            const bf16_t* rp_ = (part ? Ks : Qs) + row * 144;
            float ss = 0.f;
#pragma unroll
            for (int q = 0; q < 16; ++q) { float v8[8]; unpack8(*(const uint4*)(rp_ + q * 8), v8);
#pragma unroll
                for (int j = 0; j < 8; ++j) ss += v8[j] * v8[j]; }
            rnq[part * 64 + row] = rsqrtf(ss + 1e-6f) * (part ? 1.f : 0.08838834764831845f);
        }
        __syncthreads();
        {
            f32x4 akk[4], aqk[4];
#pragma unroll
            for (int jt = 0; jt < 4; ++jt) { akk[jt] = (f32x4){0.f, 0.f, 0.f, 0.f}; aqk[jt] = akk[jt]; }
#pragma unroll
            for (int ks = 0; ks < 4; ++ks) {
                const bf16x8 aK = *(const bf16x8*)(Ks + (16 * hw + fr) * 144 + 32 * ks + 8 * fg);
                const bf16x8 aQ = *(const bf16x8*)(Qs + (16 * hw + fr) * 144 + 32 * ks + 8 * fg);
#pragma unroll
                for (int jt = 0; jt < 4; ++jt) {
                    if (jt <= hw) {
                        const bf16x8 bK = *(const bf16x8*)(Ks + (16 * jt + fr) * 144 + 32 * ks + 8 * fg);
                        akk[jt] = __builtin_amdgcn_mfma_f32_16x16x32_bf16(aK, bK, akk[jt], 0, 0, 0);
                        aqk[jt] = __builtin_amdgcn_mfma_f32_16x16x32_bf16(aQ, bK, aqk[jt], 0, 0, 0);
                    }
                }
            }
#pragma unroll
            for (int jt = 0; jt < 4; ++jt) {
                const int j = 16 * jt + fr;
                const float gj = gc[j], rkj = rnq[64 + j];
                float lt[4];
#pragma unroll
                for (int r = 0; r < 4; ++r) {
                    const int i = 16 * hw + 4 * fg + r;
                    const float dec = (i >= j) ? fexp_(gc[i] - gj) * rkj : 0.f;
                    lt[r] = (i > j) ? beta[i] * rnq[64 + i] * akk[jt][r] * dec : 0.f;
                    const int idx = ((hw * 2 + (j >> 5)) * 64 + ((j & 15) >> 2) * 16 + (i & 15)) * 8 + ((j >> 4) & 1) * 4 + (j & 3);
                    QKF[(size_t)unit * 4096 + idx] = f2bf(aqk[jt][r] * rnq[i] * dec);
                }
                *(float4*)(Ls + j * 64 + 16 * hw + 4 * fg) = make_float4(lt[0], lt[1], lt[2], lt[3]);
            }
        }
        __syncthreads();
        {
            float x[64];
            const int c = ht;
            if (c < 128) {
                const int col = 1024 + h * 128 + c;
                float cw[4];
#pragma unroll
                for (int tap = 0; tap < 4; ++tap) cw[tap] = p.conv_w[tap * 1536 + col];
                float w0 = (s0 >= 3) ? bf2f(qkv[(size_t)(t0 - 3) * 1536 + col]) : 0.f;
                float w1 = (s0 >= 2) ? bf2f(qkv[(size_t)(t0 - 2) * 1536 + col]) : 0.f;
                float w2 = (s0 >= 1) ? bf2f(qkv[(size_t)(t0 - 1) * 1536 + col]) : 0.f;
#pragma unroll
                for (int i = 0; i < 64; ++i) {
                    const float w3 = bf2f(qkv[(size_t)(t0 + i) * 1536 + col]);
                    x[i] = fsilu_(w0 * cw[0] + w1 * cw[1] + w2 * cw[2] + w3 * cw[3]) * beta[i];
                    w0 = w1; w1 = w2; w2 = w3;
                }
            } else {
#pragma unroll
                for (int i = 0; i < 64; ++i) x[i] = bf2f(Ks[i * 144 + (c - 128)]) * rnq[64 + i] * beta[i] * egc[i];
            }
            if (!(abl & 2)) {
#pragma unroll
            for (int j = 0; j < 63; ++j) {
                const float xj = x[j];
#pragma unroll
                for (int i = j + 1; i < 64; ++i) x[i] -= Ls[j * 64 + i] * xj;
                if ((j & 1) == 1) __builtin_amdgcn_sched_barrier(0);
            }
            }
            if (c < 128) {
#pragma unroll
                for (int rt = 0; rt < 4; ++rt)
#pragma unroll
                    for (int g4 = 0; g4 < 4; ++g4)
                        *(float4*)(UF + (size_t)unit * 8192 + ((((c >> 4) * 4 + rt) * 64 + g4 * 16 + (c & 15)) << 2)) =
                            make_float4(x[16 * rt + 4 * g4], x[16 * rt + 4 * g4 + 1], x[16 * rt + 4 * g4 + 2], x[16 * rt + 4 * g4 + 3]);
            } else {
#pragma unroll
                for (int i = 0; i < 64; ++i) Wl[i * 144 + (c - 128)] = f2bf(x[i]);
            }
        }
        __syncthreads();
        if (!(abl & 4)) {
#pragma unroll
        for (int m = 0; m < 4; ++m) {
            const int q = ht + 256 * m, frag = q >> 6, l = q & 63, lfr = l & 15, lfg = l >> 4;
            {
                const int row = 16 * (frag >> 2) + lfr, k0 = 32 * (frag & 3) + 4 * lfg;
                const uint2 lo = *(const uint2*)(Wl + row * 144 + k0), hi = *(const uint2*)(Wl + row * 144 + k0 + 16);
                *(uint4*)(WC + (size_t)unit * 8192 + q * 8) = make_uint4(lo.x, lo.y, hi.x, hi.y);
                const uint2 ql = *(const uint2*)(Qs + row * 144 + k0), qh = *(const uint2*)(Qs + row * 144 + k0 + 16);
                const float e = egc[row] * rnq[row];
                float v[8]; unpack8(make_uint4(ql.x, ql.y, qh.x, qh.y), v);
#pragma unroll
                for (int j = 0; j < 8; ++j) v[j] *= e;
                *(uint4*)(QD + (size_t)unit * 8192 + q * 8) = pack8(v);
            }
            {
                const int kd = 16 * (frag >> 1) + lfr, c0 = 32 * (frag & 1) + 4 * lfg;
                float v[8];
#pragma unroll
                for (int j = 0; j < 8; ++j) { const int cpos = c0 + 16 * (j >> 2) + (j & 3); v[j] = bf2f(Ks[cpos * 144 + kd]) * ekl[cpos] * rnq[64 + cpos]; }
                *(uint4*)(KDT + (size_t)unit * 8192 + q * 8) = pack8(v);
            }
        }
        }
    }
}

__device__ void st_dnscan_fast(const P& p, char* lds) {
    const int tid = tidx(), lane = tid & 63, wid = tid >> 6, fr = lane & 15, fg = lane >> 4;
    const int sb = blockIdx.x, vq = sb & 3, h = (sb >> 2) & 3, b = sb >> 4;
    const float* GL = (const float*)(p.ws + OFF_GL);
    const char* KDT = p.ws + OFF_KDT; const char* QKF = p.ws + OFF_QKF;
    const char* UF = (const char*)p.out; const char* WC = (const char*)p.out + 64 * MiB; const char* QD = (const char*)p.out + 96 * MiB;
    bf16_t* ob = (bf16_t*)(p.ws + OFF_O);
    auto dma = [&](int n, int buf) {
        const size_t unit = (size_t)((b * 256 + n) * 4 + h);
        const int lw = wid - 2;
#pragma unroll
        for (int j = 0; j < 11; ++j) {
            const int pi = lw + 6 * j;
            if (pi < 64) {
                const char* src;
                if (pi < 16) src = WC + unit * 16384 + pi * 1024;
                else if (pi < 32) src = QD + unit * 16384 + (pi - 16) * 1024;
                else if (pi < 48) src = KDT + unit * 16384 + (pi - 32) * 1024;
                else if (pi < 56) src = QKF + unit * 8192 + (pi - 48) * 1024;
                else src = UF + unit * 32768 + (size_t)(2 * vq + ((pi - 56) >> 2)) * 4096 + ((pi - 56) & 3) * 1024;
                __builtin_amdgcn_global_load_lds((const unsigned*)(src + lane * 16), (LAS3 unsigned*)(lds + buf * 65536 + pi * 1024 + lane * 16), 16, 0, 0);
            }
        }
    };
    f32x4 S[8];
#pragma unroll
    for (int k = 0; k < 8; ++k) S[k] = (f32x4){0.f, 0.f, 0.f, 0.f};
    if (wid >= 2) dma(0, 0);
    asm volatile("s_waitcnt vmcnt(0)" ::: "memory");
    __syncthreads();
    for (int n = 0; n < 256; ++n) {
        if (wid >= 2) {
            if (n + 1 < 256) dma(n + 1, (n + 1) & 1);
        } else {
            const int vs = 2 * vq + wid;
            const char* B = lds + (n & 1) * 65536 + lane * 16;
            const float egl = GL[(b * 256 + n) * 4 + h];
            bf16x8 Sb[4];
#pragma unroll
            for (int s = 0; s < 4; ++s) Sb[s] = pack_b(S[2 * s], S[2 * s + 1]);
            f32x4 vn[4], o[4];
#pragma unroll
            for (int rt = 0; rt < 4; ++rt) {
                f32x4 pm = (f32x4){0.f, 0.f, 0.f, 0.f}, qo = pm;
#pragma unroll
                for (int s = 0; s < 4; ++s) {
                    pm = __builtin_amdgcn_mfma_f32_16x16x32_bf16(*(const bf16x8*)(B + (rt * 4 + s) * 1024), Sb[s], pm, 0, 0, 0);
                    qo = __builtin_amdgcn_mfma_f32_16x16x32_bf16(*(const bf16x8*)(B + (16 + rt * 4 + s) * 1024), Sb[s], qo, 0, 0, 0);
                }
                const float4 u4 = *(const float4*)(B + (56 + 4 * wid + rt) * 1024);
                vn[rt] = (f32x4){u4.x - pm[0], u4.y - pm[1], u4.z - pm[2], u4.w - pm[3]};
                o[rt] = qo;
            }
            bf16x8 Vb[2];
            Vb[0] = pack_b(vn[0], vn[1]); Vb[1] = pack_b(vn[2], vn[3]);
#pragma unroll
            for (int rt = 0; rt < 4; ++rt)
#pragma unroll
                for (int s2 = 0; s2 < 2; ++s2) o[rt] = __builtin_amdgcn_mfma_f32_16x16x32_bf16(*(const bf16x8*)(B + (48 + rt * 2 + s2) * 1024), Vb[s2], o[rt], 0, 0, 0);
#pragma unroll
            for (int kt = 0; kt < 8; ++kt) {
                S[kt] = S[kt] * egl;
#pragma unroll
                for (int s2 = 0; s2 < 2; ++s2) S[kt] = __builtin_amdgcn_mfma_f32_16x16x32_bf16(*(const bf16x8*)(B + (32 + kt * 2 + s2) * 1024), Vb[s2], S[kt], 0, 0, 0);
            }
            const size_t t0 = (size_t)(b * 256 + n) * 64;
#pragma unroll
            for (int rt = 0; rt < 4; ++rt)
#pragma unroll
                for (int r = 0; r < 4; ++r) ob[(t0 + 16 * rt + 4 * fg + r) * 512 + h * 128 + vs * 16 + fr] = f2bf(o[rt][r]);
        }
        if (wid >= 2) asm volatile("s_waitcnt vmcnt(0)" ::: "memory");
        __builtin_amdgcn_s_barrier();
    }
}

constexpr size_t OFF_MG  = 384 * MiB;
constexpr size_t OFF_BG  = 392 * MiB;
constexpr size_t OFF_SGS = 400 * MiB;

__device__ void st_scan_l1(const P& p, char* lds) {
    const int tid = tidx(), lane = tid & 63, wid = __builtin_amdgcn_readfirstlane(tid >> 6), fr = lane & 15, fg = lane >> 4;
    const float* GL = (const float*)(p.ws + OFF_GL);
    const char* KDT = p.ws + OFF_KDT;
    const char* UF = (const char*)p.out; const char* WC = (const char*)p.out + 64 * MiB;
    for (int blk = blockIdx.x; blk < 256; blk += gridDim.x) {
        const int g2 = blk >> 1, half = blk & 1, bh = g2 >> 4, g = g2 & 15, b = bh >> 2, h = bh & 3;
        const int npieces = half ? 64 : 32;
        auto dma = [&](int i, int buf) {
            const size_t unit = (size_t)((b * 256 + g * 16 + i) * 4 + h);
            for (int pi = wid; pi < npieces; pi += 8) {
                const char* src;
                if (pi < 16) src = WC + unit * 16384 + pi * 1024;
                else if (pi < 32) src = KDT + unit * 16384 + (pi - 16) * 1024;
                else src = UF + unit * 32768 + (pi - 32) * 1024;
                __builtin_amdgcn_global_load_lds((const unsigned*)(src + lane * 16), (LAS3 unsigned*)(lds + buf * 65536 + pi * 1024 + lane * 16), 16, 0, 0);
            }
        };
        f32x4 X[8];
#pragma unroll
        for (int t = 0; t < 8; ++t)
#pragma unroll
            for (int r = 0; r < 4; ++r) X[t][r] = (!half && (16 * t + 4 * fg + r == 16 * wid + fr)) ? 1.f : 0.f;
        __syncthreads();
        dma(0, 0);
        asm volatile("s_waitcnt vmcnt(0)" ::: "memory");
        __syncthreads();
        for (int i = 0; i < 16; ++i) {
            if (i + 1 < 16) dma(i + 1, (i + 1) & 1);
            const char* B = lds + (i & 1) * 65536 + lane * 16;
            const float egl = GL[(b * 256 + g * 16 + i) * 4 + h];
            bf16x8 Xb[4];
#pragma unroll
            for (int s = 0; s < 4; ++s) Xb[s] = pack_b(X[2 * s], X[2 * s + 1]);
            f32x4 vn[4];
#pragma unroll
            for (int rt = 0; rt < 4; ++rt) {
                f32x4 pm = (f32x4){0.f, 0.f, 0.f, 0.f};
#pragma unroll
                for (int s = 0; s < 4; ++s) pm = __builtin_amdgcn_mfma_f32_16x16x32_bf16(*(const bf16x8*)(B + (rt * 4 + s) * 1024), Xb[s], pm, 0, 0, 0);
                if (half) { const float4 u4 = *(const float4*)(B + (32 + 4 * wid + rt) * 1024); vn[rt] = (f32x4){u4.x - pm[0], u4.y - pm[1], u4.z - pm[2], u4.w - pm[3]}; }
                else vn[rt] = (f32x4){-pm[0], -pm[1], -pm[2], -pm[3]};
            }
            bf16x8 Vb[2];
            Vb[0] = pack_b(vn[0], vn[1]); Vb[1] = pack_b(vn[2], vn[3]);
#pragma unroll
            for (int kt = 0; kt < 8; ++kt) {
                X[kt] = X[kt] * egl;
#pragma unroll
                for (int s2 = 0; s2 < 2; ++s2) X[kt] = __builtin_amdgcn_mfma_f32_16x16x32_bf16(*(const bf16x8*)(B + (16 + kt * 2 + s2) * 1024), Vb[s2], X[kt], 0, 0, 0);
            }
            asm volatile("s_waitcnt vmcnt(0)" ::: "memory");
            __builtin_amdgcn_s_barrier();
        }
        if (half) {
            float4* bg = (float4*)(p.ws + OFF_BG) + ((size_t)(g2 * 8 + wid) * 8) * 64 + lane;
#pragma unroll
            for (int t = 0; t < 8; ++t) bg[t * 64] = make_float4(X[t][0], X[t][1], X[t][2], X[t][3]);
        } else {
            bf16_t* Ml = (bf16_t*)lds;
#pragma unroll
            for (int t = 0; t < 8; ++t)
#pragma unroll
                for (int r = 0; r < 4; ++r) Ml[(16 * t + 4 * fg + r) * 136 + 16 * wid + fr] = f2bf(X[t][r]);
            __syncthreads();
            bf16_t* mg = (bf16_t*)(p.ws + OFF_MG) + (size_t)g2 * 16384;
#pragma unroll
            for (int m = 0; m < 4; ++m) {
                const int q = tid + 512 * m, frag = q >> 6, l = q & 63, row = 16 * (frag >> 2) + (l & 15), k0 = 32 * (frag & 3) + 4 * (l >> 4);
                const uint2 lo = *(const uint2*)(Ml + row * 136 + k0), hi = *(const uint2*)(Ml + row * 136 + k0 + 16);
                *(uint4*)(mg + q * 8) = make_uint4(lo.x, lo.y, hi.x, hi.y);
            }
        }
    }
}

__device__ void st_scan_l2(const P& p, char* lds) {
    const int tid = tidx(), lane = tid & 63, wid = __builtin_amdgcn_readfirstlane(tid >> 6);
    const int bh = blockIdx.x;
    const char* MG = p.ws + OFF_MG;
    auto dma = [&](int g, int buf) {
#pragma unroll
        for (int j = 0; j < 4; ++j) {
            const int pi = wid + 8 * j;
            __builtin_amdgcn_global_load_lds((const unsigned*)(MG + (size_t)(bh * 16 + g) * 32768 + pi * 1024 + lane * 16), (LAS3 unsigned*)(lds + buf * 32768 + pi * 1024 + lane * 16), 16, 0, 0);
        }
    };
    f32x4 S[8];
#pragma unroll
    for (int t = 0; t < 8; ++t) S[t] = (f32x4){0.f, 0.f, 0.f, 0.f};
    __syncthreads();
    dma(0, 0);
    asm volatile("s_waitcnt vmcnt(0)" ::: "memory");
    __syncthreads();
    for (int g = 0; g < 16; ++g) {
        if (g + 1 < 16) dma(g + 1, (g + 1) & 1);
        float4* sg = (float4*)(p.ws + OFF_SGS) + ((size_t)((bh * 16 + g) * 8 + wid) * 8) * 64 + lane;
        const float4* bg = (const float4*)(p.ws + OFF_BG) + ((size_t)((bh * 16 + g) * 8 + wid) * 8) * 64 + lane;
#pragma unroll
        for (int t = 0; t < 8; ++t) sg[t * 64] = make_float4(S[t][0], S[t][1], S[t][2], S[t][3]);
        const char* B = lds + (g & 1) * 32768 + lane * 16;
        bf16x8 Sb[4];
#pragma unroll
        for (int s = 0; s < 4; ++s) Sb[s] = pack_b(S[2 * s], S[2 * s + 1]);
#pragma unroll
        for (int t = 0; t < 8; ++t) {
            const float4 b4 = bg[t * 64];
            f32x4 a = (f32x4){b4.x, b4.y, b4.z, b4.w};
#pragma unroll
            for (int s = 0; s < 4; ++s) a = __builtin_amdgcn_mfma_f32_16x16x32_bf16(*(const bf16x8*)(B + (t * 4 + s) * 1024), Sb[s], a, 0, 0, 0);
            S[t] = a;
        }
        asm volatile("s_waitcnt vmcnt(0)" ::: "memory");
        __builtin_amdgcn_s_barrier();
    }
}

__device__ void st_scan_l3(const P& p, char* lds) {
    const int tid = tidx(), lane = tid & 63, wid = __builtin_amdgcn_readfirstlane(tid >> 6), fr = lane & 15, fg = lane >> 4;
    const float* GL = (const float*)(p.ws + OFF_GL);
    const char* KDT = p.ws + OFF_KDT; const char* QKF = p.ws + OFF_QKF;
    const char* UF = (const char*)p.out; const char* WC = (const char*)p.out + 64 * MiB; const char* QD = (const char*)p.out + 96 * MiB;
    bf16_t* ob = (bf16_t*)(p.ws + OFF_O);
    for (int blk = blockIdx.x; blk < 256; blk += gridDim.x) {
        const int g2 = blk >> 1, vh = blk & 1, bh = g2 >> 4, g = g2 & 15, b = bh >> 2, h = bh & 3;
        auto dma = [&](int i, int buf) {
            const size_t unit = (size_t)((b * 256 + g * 16 + i) * 4 + h);
            for (int pi = wid - 4; pi < 72; pi += 4) {
                const char* src;
                if (pi < 16) src = WC + unit * 16384 + pi * 1024;
                else if (pi < 32) src = QD + unit * 16384 + (pi - 16) * 1024;
                else if (pi < 48) src = KDT + unit * 16384 + (pi - 32) * 1024;
                else if (pi < 56) src = QKF + unit * 8192 + (pi - 48) * 1024;
                else src = UF + unit * 32768 + (size_t)vh * 16384 + (pi - 56) * 1024;
                __builtin_amdgcn_global_load_lds((const unsigned*)(src + lane * 16), (LAS3 unsigned*)(lds + buf * 73728 + pi * 1024 + lane * 16), 16, 0, 0);
            }
        };
        f32x4 S[8];
        if (wid < 4) {
            const float4* sg = (const float4*)(p.ws + OFF_SGS) + ((size_t)(g2 * 8 + vh * 4 + wid) * 8) * 64 + lane;
#pragma unroll
            for (int t = 0; t < 8; ++t) { const float4 s4 = sg[t * 64]; S[t] = (f32x4){s4.x, s4.y, s4.z, s4.w}; }
        }
        __syncthreads();
        if (wid >= 4) dma(0, 0);
        asm volatile("s_waitcnt vmcnt(0)" ::: "memory");
        __syncthreads();
        for (int i = 0; i < 16; ++i) {
            if (wid >= 4) {
                if (i + 1 < 16) dma(i + 1, (i + 1) & 1);
            } else {
                const int vs = vh * 4 + wid, n = g * 16 + i;
                const char* B = lds + (i & 1) * 73728 + lane * 16;
                const float egl = GL[(b * 256 + n) * 4 + h];
                bf16x8 Sb[4];
#pragma unroll
                for (int s = 0; s < 4; ++s) Sb[s] = pack_b(S[2 * s], S[2 * s + 1]);
                f32x4 vn[4], o[4];
#pragma unroll
                for (int rt = 0; rt < 4; ++rt) {
                    f32x4 pm = (f32x4){0.f, 0.f, 0.f, 0.f}, qo = pm;
#pragma unroll
                    for (int s = 0; s < 4; ++s) {
                        pm = __builtin_amdgcn_mfma_f32_16x16x32_bf16(*(const bf16x8*)(B + (rt * 4 + s) * 1024), Sb[s], pm, 0, 0, 0);
                        qo = __builtin_amdgcn_mfma_f32_16x16x32_bf16(*(const bf16x8*)(B + (16 + rt * 4 + s) * 1024), Sb[s], qo, 0, 0, 0);
                    }
                    const float4 u4 = *(const float4*)(B + (56 + 4 * wid + rt) * 1024);
                    vn[rt] = (f32x4){u4.x - pm[0], u4.y - pm[1], u4.z - pm[2], u4.w - pm[3]};
                    o[rt] = qo;
                }
                bf16x8 Vb[2];
                Vb[0] = pack_b(vn[0], vn[1]); Vb[1] = pack_b(vn[2], vn[3]);
#pragma unroll
                for (int rt = 0; rt < 4; ++rt)
#pragma unroll
                    for (int s2 = 0; s2 < 2; ++s2) o[rt] = __builtin_amdgcn_mfma_f32_16x16x32_bf16(*(const bf16x8*)(B + (48 + rt * 2 + s2) * 1024), Vb[s2], o[rt], 0, 0, 0);
#pragma unroll
                for (int kt = 0; kt < 8; ++kt) {
                    S[kt] = S[kt] * egl;
#pragma unroll
                    for (int s2 = 0; s2 < 2; ++s2) S[kt] = __builtin_amdgcn_mfma_f32_16x16x32_bf16(*(const bf16x8*)(B + (32 + kt * 2 + s2) * 1024), Vb[s2], S[kt], 0, 0, 0);
                }
                const size_t t0 = (size_t)(b * 256 + n) * 64;
#pragma unroll
                for (int rt = 0; rt < 4; ++rt)
#pragma unroll
                    for (int r = 0; r < 4; ++r) ob[(t0 + 16 * rt + 4 * fg + r) * 512 + h * 128 + vs * 16 + fr] = f2bf(o[rt][r]);
            }
            if (wid >= 4) asm volatile("s_waitcnt vmcnt(0)" ::: "memory");
            __builtin_amdgcn_s_barrier();
        }
    }
}

__device__ void st_sg_fast(const P& p, char* lds, int first, int stride) {
    const int tid = tidx(), lane = tid & 63, wid = tid >> 6, fr = lane & 15, fg = lane >> 4;
    const bf16_t* vgg = (const bf16_t*)(p.ws + OFF_VGG); const bf16_t* ug = (const bf16_t*)(p.ws + OFF_UG);
    const bf16_t* tw = (const bf16_t*)(p.ws + OFF_TRILW);
    bf16_t* ysg = (bf16_t*)(p.ws + OFF_YSG);
    bf16_t* XT = (bf16_t*)lds;
    float* mean = (float*)(lds + 147456); float* rstd = mean + 128;
    for (int unit = first; unit < T / 128; unit += stride) {
        const size_t t0 = (size_t)unit * 128;
        __syncthreads();
        for (int rr = 0; rr < 16; ++rr) {
            const int s = wid * 16 + rr;
            float v[8]; unpack8(*(const uint4*)(vgg + (t0 + s) * 512 + lane * 8), v);
            float sm = 0.f;
#pragma unroll
            for (int j = 0; j < 8; ++j) sm += v[j];
            const float mu = wave_sum(sm) * (1.f / 512.f);
            float q = 0.f;
#pragma unroll
            for (int j = 0; j < 8; ++j) { const float d = v[j] - mu; q += d * d; }
            const float rs = rsqrtf(wave_sum(q) * (1.f / 512.f) + 1e-6f);
            if (lane == 0) { mean[s] = mu; rstd[s] = rs; }
        }
        __syncthreads();
        {
            const int s = tid & 127, cq = tid >> 7;
            const float mu = mean[s], rs = rstd[s];
            for (int cc = 0; cc < 16; ++cc) {
                const int c = cq * 128 + cc * 8;
                float v[8]; unpack8(*(const uint4*)(vgg + (t0 + s) * 512 + c), v);
#pragma unroll
                for (int j = 0; j < 8; ++j) XT[(c + j) * 144 + s] = f2bf((v[j] - mu) * rs * p.sg_ln_w[c + j] + p.sg_ln_b[c + j]);
            }
        }
        __syncthreads();
        const int g = wid >> 1;
        const bf16_t* W = tw + (size_t)g * 128 * 128;
#pragma unroll
        for (int th = 0; th < 2; ++th) {
            f32x4 acc[4][4];
#pragma unroll
            for (int ci = 0; ci < 4; ++ci)
#pragma unroll
                for (int tt = 0; tt < 4; ++tt) acc[ci][tt] = (f32x4){0.f, 0.f, 0.f, 0.f};
#pragma unroll
            for (int ks = 0; ks < 4; ++ks) {
                if (ks <= 2 * th + 1) {
                    bf16x8 a[4], bw[4];
#pragma unroll
                    for (int ci = 0; ci < 4; ++ci) a[ci] = *(const bf16x8*)(XT + (64 * wid + (ci >> 1) * 32 + 8 * (fr >> 2) + (fr & 3) + 4 * (ci & 1)) * 144 + 32 * ks + 8 * fg);
#pragma unroll
                    for (int tt = 0; tt < 4; ++tt) bw[tt] = *(const bf16x8*)(W + (64 * th + 16 * tt + fr) * 128 + 32 * ks + 8 * fg);
#pragma unroll
                    for (int ci = 0; ci < 4; ++ci)
#pragma unroll
                        for (int tt = 0; tt < 4; ++tt)
                            if (2 * ks <= 4 * th + tt) acc[ci][tt] = __builtin_amdgcn_mfma_f32_16x16x32_bf16(a[ci], bw[tt], acc[ci][tt], 0, 0, 0);
                }
            }
#pragma unroll
            for (int pp = 0; pp < 2; ++pp)
#pragma unroll
                for (int tt = 0; tt < 4; ++tt) {
                    const int tl = 64 * th + 16 * tt + fr, c0 = 64 * wid + pp * 32 + 8 * fg;
                    const float bsv = p.sg_b[g * 128 + tl];
                    float u[8], o[8]; unpack8(*(const uint4*)(ug + (t0 + tl) * 512 + c0), u);
#pragma unroll
                    for (int j = 0; j < 4; ++j) { o[j] = u[j] * (acc[2 * pp][tt][j] + bsv); o[4 + j] = u[4 + j] * (acc[2 * pp + 1][tt][j] + bsv); }
                    *(uint4*)(ysg + (t0 + tl) * 512 + c0) = pack8(o);
                }
        }
    }
}

#define XB_TMO      128
#define XB_XCNT(j)  (256  + 64 * (j))
#define XB_XSUB(j)  (1280 + 64 * (j))
#define XB_XGEN(j)  (2304 + 64 * (j))
#define XB_TOP      3328
#define XB_TOPGEN   3392
#define XCD_BAR_WORDS 3456
#define XB_SPIN_CAP (1u << 18)
#define LAS __attribute__((address_space(3)))

__device__ __forceinline__ unsigned xb_ld(unsigned* p)              { return __hip_atomic_load(p, __ATOMIC_RELAXED, __HIP_MEMORY_SCOPE_AGENT); }
__device__ __forceinline__ unsigned xb_add(unsigned* p, unsigned v) { return __hip_atomic_fetch_add(p, v, __ATOMIC_RELAXED, __HIP_MEMORY_SCOPE_AGENT); }
__device__ __forceinline__ unsigned xb_xcc_id() { return (unsigned)__builtin_amdgcn_s_getreg((3 << 11) | 20) & 0xFu; }
#define XB_SPIN(cond, bar) do { unsigned _sp = 0; while (cond) { __builtin_amdgcn_s_sleep(1); \
    if ((++_sp & 255u) == 0u) { if (xb_ld(&(bar)[XB_TMO])) break; if (_sp > XB_SPIN_CAP) { atomicAdd(&(bar)[XB_TMO], 1u); break; } } } } while (0)

struct XcdBarrier {
    unsigned* bar; unsigned x;
    volatile LAS unsigned* st;
};

__device__ __forceinline__ XcdBarrier xcd_barrier_post(unsigned* bar, volatile LAS unsigned* st) {
    XcdBarrier b; b.bar = bar; b.x = xb_xcc_id(); b.st = st;
    if (threadIdx.x == 0) (void)xb_add(&bar[XB_XCNT(b.x)], 1u);
    return b;
}
__device__ __forceinline__ void xcd_barrier_complete(unsigned* bar, unsigned x, unsigned& nloc, unsigned& nx) {
    const unsigned G = gridDim.x * gridDim.y * gridDim.z;
    unsigned sum, cnt, mine, sp = 0u;
    for (;;) {
        sum = 0u; cnt = 0u; mine = 0u;
#pragma unroll
        for (unsigned j = 0; j < 16; ++j) { const unsigned c = xb_ld(&bar[XB_XCNT(j)]); sum += c; cnt += (c > 0u) ? 1u : 0u; mine = (j == x) ? c : mine; }
        if (sum == G) break;
        __builtin_amdgcn_s_sleep(1);
        if ((++sp & 255u) == 0u) { if (xb_ld(&bar[XB_TMO])) break; if (sp > XB_SPIN_CAP) { atomicAdd(&bar[XB_TMO], 1u); break; } }
    }
    nloc = mine > 0u ? mine : 1u; nx = cnt > 0u ? cnt : 1u;
}

__device__ __forceinline__ void xcd_barrier(const XcdBarrier& b) {
    asm volatile("s_waitcnt vmcnt(0)" ::: "memory");
    __syncthreads();
    if (threadIdx.x == 0) {
        unsigned* bar = b.bar;
        __builtin_amdgcn_s_waitcnt(0);
        unsigned nloc = b.st[0], nx = b.st[1];
        if (nloc == 0u) { xcd_barrier_complete(bar, b.x, nloc, nx); b.st[0] = nloc; b.st[1] = nx; }
        const unsigned old = xb_add(&bar[XB_XSUB(b.x)], 1u);
        const unsigned gen = old / nloc;
        if (old + 1u == (gen + 1u) * nloc) {
            __builtin_amdgcn_fence(__ATOMIC_RELEASE, "agent");
            asm volatile("s_waitcnt vmcnt(0)" ::: "memory");
            const unsigned og = xb_add(&bar[XB_TOP], 1u);
            const unsigned tg = og / nx;
            if (og + 1u == (tg + 1u) * nx) xb_add(&bar[XB_TOPGEN], 1u);
            else XB_SPIN(xb_ld(&bar[XB_TOPGEN]) == tg, bar);
            __builtin_amdgcn_fence(__ATOMIC_ACQUIRE, "agent");
            xb_add(&bar[XB_XGEN(b.x)], 1u);
            asm volatile("s_waitcnt vmcnt(0)" ::: "memory");
        } else {
            XB_SPIN(xb_ld(&bar[XB_XGEN(b.x)]) == gen, bar);
            __builtin_amdgcn_fence(__ATOMIC_ACQUIRE, "agent");
            asm volatile("s_waitcnt vmcnt(0)" ::: "memory");
        }
    }
    __syncthreads();
}


constexpr size_t OFF_BAR = 480 * MiB + 256 * 1024;
constexpr int LDS_BARW = 152 * 1024 - 16;

constexpr int NSTAGE = 15;
#ifndef NP2
#define NP2 1
#endif
#ifndef ABL2
#define ABL2 0
#endif
#ifndef NP3
#define NP3 1
#endif
#ifndef ABL3
#define ABL3 0
#endif
#ifndef NP7
#define NP7 1
#endif
#ifndef NP9
#define NP9 1
#endif
#ifndef NP10
#define NP10 1
#endif
constexpr int NSTG = 11;
template <int S> __device__ __forceinline__ void run_stage(const P& p, float* lds) {
    if constexpr (S == 0) { st_mod(p, lds); st_convert(p, lds); }
    else if constexpr (S == 1) st_hm(p);
    else if constexpr (S == 2) {
#pragma nounroll
        for (int ps = 0; ps < NP2; ++ps) st_inproj_fast(p, (char*)lds, ps == NP2 - 1 ? 0 : ABL2);
    }
    else if constexpr (S == 3) {
#pragma nounroll
        for (int ps = 0; ps < NP3; ++ps) st_dnprep_fast(p, (char*)lds, ps == NP3 - 1 ? 0 : ABL3);
    }
    else if constexpr (S == 4) st_scan_l1(p, (char*)lds);
    else if constexpr (S == 5) {
        if (blockIdx.x < 8) st_scan_l2(p, (char*)lds);
        st_sg_fast(p, (char*)lds, blockIdx.x < 8 ? 248 + (int)blockIdx.x : (int)blockIdx.x - 8, 256);
    }
    else if constexpr (S == 6) st_scan_l3(p, (char*)lds);
    else if constexpr (S == 7) {
#pragma nounroll
        for (int ps = 0; ps < NP7; ++ps) st_post_fast(p, (char*)lds, ps == NP7 - 1);
    }
    else if constexpr (S == 8 || S == 9) {
#pragma nounroll
        for (int ps = 0; ps < (S == 9 ? NP9 : 1); ++ps) st_moe_fast(p, (char*)lds, S == 8 || ps == NP9 - 1, S == 8 ? 1 : 0);
    }
    else if constexpr (S == 10) {
#pragma nounroll
        for (int ps = 0; ps < NP10; ++ps) st_combine(p, ps == NP10 - 1);
    }
}

constexpr int LDS_BYTES = 152 * 1024;

#if !MEGA
template <int S> __global__ void __launch_bounds__(NT) k_stage(P p) {
    extern __shared__ __attribute__((aligned(16))) float lds[];
    run_stage<S>(p, lds);
}
template <int S> static void launch_all(const P& p, int grid, hipStream_t stream) {
    if constexpr (S < NSTG) {
        (void)hipFuncSetAttribute((const void*)k_stage<S>, hipFuncAttributeMaxDynamicSharedMemorySize, LDS_BYTES);
        k_stage<S><<<grid, NT, LDS_BYTES, stream>>>(p);
        launch_all<S + 1>(p, grid, stream);
    }
}
#else
template <int S> __device__ __forceinline__ void run_from(const P& p, float* lds, const XcdBarrier& bar) {
    if constexpr (S < NSTG) {
        run_stage<S>(p, lds);
#ifdef PROBE_REPEAT
        if constexpr (S == PROBE_REPEAT) { xcd_barrier(bar); run_stage<S>(p, lds); }
#endif
        if constexpr (S < NSTG - 1) xcd_barrier(bar);
        run_from<S + 1>(p, lds, bar);
    }
}
__global__ void __launch_bounds__(NT) k_mega(P p) {
    extern __shared__ __attribute__((aligned(16))) float lds[];
    volatile LAS unsigned* st = (volatile LAS unsigned*)((LAS char*)lds + LDS_BARW);
    if (threadIdx.x == 0) { st[0] = 0u; st[1] = 0u; }
    __syncthreads();
    const XcdBarrier bar = xcd_barrier_post((unsigned*)(p.ws + OFF_BAR), st);
    cg::this_grid().sync();
    run_from<0>(p, lds, bar);
}
#endif

extern "C" void kernel_launch(void* const* d_in, const int* in_sizes, int n_in, void* d_out, int out_size, void* d_ws, size_t ws_size,
                              hipStream_t stream) {
    if (n_in != 30 || out_size != T * D || ws_size < WS_NEED) {
        fprintf(stderr, "kernel_launch: unexpected problem (n_in %d, out %d, ws %zu)\n", n_in, out_size, ws_size);
        return;
    }
    P p{};
    const float** f = (const float**)&p;
    for (int i = 0; i < 30; ++i) f[i] = (const float*)d_in[i];
    p.out = (float*)d_out;
    p.ws = (char*)d_ws;
    static int grid = 0;
    if (!grid) {
        int dev = 0, cus = 0;
        (void)hipGetDevice(&dev);
        (void)hipDeviceGetAttribute(&cus, hipDeviceAttributeMultiprocessorCount, dev);
#if MEGA
        int per_cu = 0;
        (void)hipFuncSetAttribute((const void*)k_mega, hipFuncAttributeMaxDynamicSharedMemorySize, LDS_BYTES);
        (void)hipOccupancyMaxActiveBlocksPerMultiprocessor(&per_cu, (const void*)k_mega, NT, LDS_BYTES);
        if (per_cu < 1) per_cu = 1;
        if (per_cu > 1) per_cu = 1;
        grid = cus * per_cu;
#else
        grid = cus;
#endif
    }
#if MEGA
    (void)hipMemsetAsync((char*)d_ws + OFF_BAR, 0, XCD_BAR_WORDS * sizeof(unsigned), stream);
    void* args[] = {&p};
    hipError_t e = hipLaunchCooperativeKernel((const void*)k_mega, dim3(grid), dim3(NT), args, LDS_BYTES, stream);
    if (e != hipSuccess) fprintf(stderr, "cooperative launch failed: %s (grid %d)\n", hipGetErrorString(e), grid);
#else
    launch_all<0>(p, grid, stream);
#endif
}
```

```cpp
#include <hip/hip_runtime.h>
#include <hip/hip_cooperative_groups.h>
#include <cstdint>
#include <cstdio>
namespace cg = cooperative_groups;

#ifndef MEGA
#define MEGA 1
#endif
#ifndef USE_CG_SYNC
#define USE_CG_SYNC 1
#endif
#ifndef IN8
#define IN8 0
#endif

constexpr int D = 1024, NBATCH = 2, SEQ = 16384, T = NBATCH * SEQ;
constexpr int INCOLS = 3080;
constexpr int NE = 256, EH = 256;
constexpr int NT = 512;
constexpr int LCAP = 32768;

typedef unsigned short bf16_t;
__device__ __forceinline__ float bf2f(bf16_t v) { return __uint_as_float(((unsigned)v) << 16); }
__device__ __forceinline__ bf16_t f2bf(float f) { unsigned u = __float_as_uint(f); u += 0x7fffu + ((u >> 16) & 1u); return (bf16_t)(u >> 16); }

constexpr size_t MiB = 1024ull * 1024ull;
constexpr size_t OFF_HF     = 384 * MiB;
constexpr size_t OFF_WT_IN8 = 192 * MiB;
constexpr size_t OFF_HM8    = 160 * MiB;
constexpr size_t OFF_SHO    = 320 * MiB;
constexpr size_t OFF_HF8    = 128 * MiB;
constexpr size_t OFF_LISTS  = 448 * MiB;
constexpr size_t OFF_MOD    = 480 * MiB;
constexpr size_t OFF_CNT    = 480 * MiB + 64 * 1024;
constexpr size_t OFF_WAB    = 480 * MiB + 384 * 1024;
constexpr size_t OFF_G      = 481 * MiB;
constexpr size_t OFF_BETA   = 481 * MiB + 512 * 1024;
constexpr size_t OFF_WTS    = 482 * MiB;
constexpr size_t OFF_IDX    = 483 * MiB;
constexpr size_t OFF_CONTRIB= 512 * MiB;
constexpr size_t OFF_GATE   = 512 * MiB;
constexpr size_t OFF_ZS     = 640 * MiB;
constexpr size_t OFF_YSG    = 672 * MiB;
constexpr size_t OFF_O      = 704 * MiB;
constexpr size_t OFF_QKV    = 736 * MiB;
constexpr size_t OFF_UG     = 832 * MiB;
constexpr size_t OFF_VGG    = 864 * MiB;
constexpr size_t OFF_HM     = 896 * MiB;
constexpr size_t OFF_Y      = 800 * MiB;
constexpr size_t OFF_WT_GU  = 0;
constexpr size_t OFF_WT_D   = 256 * MiB;
constexpr size_t OFF_WT_IN  = 484 * MiB;
constexpr size_t OFF_WT_DN  = 494 * MiB;
constexpr size_t OFF_WT_SG  = 495 * MiB;
constexpr size_t OFF_WT_OUT = 496 * MiB;
constexpr size_t OFF_WT_RT  = 498 * MiB;
constexpr size_t OFF_WT_SHGU= 499 * MiB;
constexpr size_t OFF_WT_SHD = 500 * MiB;
constexpr size_t OFF_TRILW  = 501 * MiB;
constexpr size_t OFF_VC     = 960 * MiB;
constexpr size_t OFF_VGN    = 896 * MiB;
constexpr size_t OFF_SCORES = 832 * MiB;
constexpr size_t WS_NEED    = 1024 * MiB;

struct P {
    const float *x, *c, *ada_w, *ada_b, *mix_pre, *mix_post, *w_in, *conv_w, *a_log, *dt_bias, *dn_norm_w, *sg_ln_w, *sg_ln_b,
        *sg_w, *sg_b, *w_bg, *b_bg, *w_pdn, *w_psg, *w_out, *ffn_pre, *ffn_post, *w_router, *router_bias, *w_eg, *w_eu, *w_ed,
        *w_shg, *w_shu, *w_shd;
    float* out;
    char* ws;
};

__device__ __forceinline__ int tidx() { int t = threadIdx.x; asm volatile("" : "+v"(t)); return t; }
__device__ __forceinline__ float wave_sum(float v) {
#pragma unroll
    for (int o = 32; o > 0; o >>= 1) v += __shfl_xor(v, o);
    return v;
}
__device__ __forceinline__ float sigmoid_(float x) { return 1.f / (1.f + expf(-x)); }
__device__ __forceinline__ float silu_(float x) { return x / (1.f + expf(-x)); }
__device__ __forceinline__ float gelu_(float x) { return 0.5f * x * (1.f + erff(x * 0.70710678118654752f)); }
__device__ __forceinline__ float softplus_(float x) { return fmaxf(x, 0.f) + log1pf(expf(-fabsf(x))); }

typedef __bf16 bf2_t __attribute__((ext_vector_type(2)));
typedef float f2_t __attribute__((ext_vector_type(2)));
__device__ __forceinline__ unsigned pk2(float a, float b) { const f2_t v = {a, b}; return __builtin_bit_cast(unsigned, __builtin_convertvector(v, bf2_t)); }
__device__ __forceinline__ uint4 pack8(const float (&v)[8]) { return make_uint4(pk2(v[0], v[1]), pk2(v[2], v[3]), pk2(v[4], v[5]), pk2(v[6], v[7])); }

__device__ __forceinline__ void unpack8(const uint4 u, float (&o)[8]) {
    o[0] = __uint_as_float(u.x << 16); o[1] = __uint_as_float(u.x & 0xffff0000u); o[2] = __uint_as_float(u.y << 16); o[3] = __uint_as_float(u.y & 0xffff0000u);
    o[4] = __uint_as_float(u.z << 16); o[5] = __uint_as_float(u.z & 0xffff0000u); o[6] = __uint_as_float(u.w << 16); o[7] = __uint_as_float(u.w & 0xffff0000u);
}

__device__ __forceinline__ float wave_sum8(const float (&v)[8], int lane) {
    float a[4];
#pragma unroll
    for (int i = 0; i < 4; ++i) { const float keep = (lane & 32) ? v[4 + i] : v[i], send = (lane & 32) ? v[i] : v[4 + i]; a[i] = keep + __shfl_xor(send, 32); }
    float b[2];
#pragma unroll
    for (int i = 0; i < 2; ++i) { const float keep = (lane & 16) ? a[2 + i] : a[i], send = (lane & 16) ? a[i] : a[2 + i]; b[i] = keep + __shfl_xor(send, 16); }
    float c;
    { const float keep = (lane & 8) ? b[1] : b[0], send = (lane & 8) ? b[0] : b[1]; c = keep + __shfl_xor(send, 8); }
    c += __shfl_xor(c, 4); c += __shfl_xor(c, 2); c += __shfl_xor(c, 1);
    return c;
}

template <int TOK, class Epi>
__device__ __forceinline__ void ngemm(const float* As, int K, const float* __restrict__ W, int ldw, int ncols, Epi epi) {
    for (int n = tidx(); n < ncols; n += NT) {
        float acc[TOK];
#pragma unroll
        for (int i = 0; i < TOK; ++i) acc[i] = 0.f;
        const float* wp = W + n;
        for (int k = 0; k < K; k += 4) {
            const float w0 = wp[(size_t)k * ldw], w1 = wp[(size_t)(k + 1) * ldw], w2 = wp[(size_t)(k + 2) * ldw], w3 = wp[(size_t)(k + 3) * ldw];
#pragma unroll
            for (int i = 0; i < TOK; ++i) {
                const float4 a = *(const float4*)(As + i * K + k);
                acc[i] += a.x * w0 + a.y * w1 + a.z * w2 + a.w * w3;
            }
        }
#pragma unroll
        for (int i = 0; i < TOK; ++i) epi(i, n, acc[i]);
    }
}

__device__ void st_mod(const P& p, float* lds) {
    const int tid = tidx(), lane = tid & 63, wid = tid >> 6;
    const int gtid = blockIdx.x * NT + tid, gsz = gridDim.x * NT;
    float* mod = (float*)(p.ws + OFF_MOD);
    for (int task = blockIdx.x; task < 192; task += gridDim.x) {
        const int b = task / 96, j = (task % 96) * 64 + lane;
        float acc = 0.f;
        for (int k = wid * 128; k < wid * 128 + 128; ++k) acc += silu_(p.c[b * 1024 + k]) * p.ada_w[(size_t)k * 6144 + j];
        __syncthreads();
        lds[wid * 64 + lane] = acc;
        __syncthreads();
        if (wid == 0) {
            float s = p.ada_b[j];
#pragma unroll
            for (int w = 0; w < 8; ++w) s += lds[w * 64 + lane];
            mod[b * 6144 + j] = s;
        }
    }
    __syncthreads();
    unsigned* cnt = (unsigned*)(p.ws + OFF_CNT);
    for (int i = gtid; i < NE; i += gsz) cnt[i] = 0u;
    unsigned* zr = (unsigned*)(p.ws + 480 * MiB + 320 * 1024);
    for (int i = gtid; i < 1024; i += gsz) zr[i] = 0u;
    float* wab = (float*)(p.ws + OFF_WAB);
    for (int i = gtid; i < 8192; i += gsz) wab[i] = p.w_in[(size_t)(i & 1023) * INCOLS + 2048 + (i >> 10)];
}

__device__ void st_hm(const P& p, float* lds) {
    const int lane = tidx() & 63, gw = (blockIdx.x * NT + tidx()) >> 6, nw = (gridDim.x * NT) >> 6;
    const float* mod = (const float*)(p.ws + OFF_MOD);
    bf16_t* hm = (bf16_t*)(p.ws + OFF_HM);
    float* gb = (float*)(p.ws + OFF_G);
    float* bb = (float*)(p.ws + OFF_BETA);
    const float* wab = (const float*)(p.ws + OFF_WAB);
    float* lwab = lds;
    float* lA = lds + 8192;
    float* lB = lds + 8192 + 2048;
    __syncthreads();
    for (int i = tidx(); i < 8192; i += NT) lwab[i] = wab[i];
    for (int i = tidx(); i < 2048; i += NT) { const int b = i >> 10, k = i & 1023; lA[i] = p.mix_pre[k] * (1.f + mod[b * 6144 + 1024 + k]); lB[i] = mod[b * 6144 + k]; }
    __syncthreads();
    const int lane0 = lane;
    float4 vnx[4];
#pragma unroll
    for (int i = 0; i < 4; ++i) vnx[i] = (gw < T) ? *(const float4*)(p.x + (size_t)gw * D + i * 256 + lane0 * 4) : make_float4(0.f, 0.f, 0.f, 0.f);
    for (int t = gw; t < T; t += nw) {
        int lane = lane0; asm volatile("" : "+v"(lane));
        const int b = t / SEQ;
        float4 v[4];
        float ss = 0.f;
#pragma unroll
        for (int i = 0; i < 4; ++i) { v[i] = vnx[i]; ss += v[i].x * v[i].x + v[i].y * v[i].y + v[i].z * v[i].z + v[i].w * v[i].w; }
        if (t + nw < T) {
#pragma unroll
            for (int i = 0; i < 4; ++i) vnx[i] = *(const float4*)(p.x + (size_t)(t + nw) * D + i * 256 + lane * 4);
        }
        ss = wave_sum(ss);
        const float rstd = rsqrtf(ss * (1.f / 1024.f) + 1e-6f);
        float ab[8];
#pragma unroll
        for (int q = 0; q < 8; ++q) ab[q] = 0.f;
#pragma unroll
        for (int i = 0; i < 4; ++i) {
            const int k0 = i * 256 + lane * 4;
            const float xv[4] = {v[i].x, v[i].y, v[i].z, v[i].w};
            const float4 mw = *(const float4*)(lA + b * 1024 + k0), sh = *(const float4*)(lB + b * 1024 + k0);
            const float mwa[4] = {mw.x, mw.y, mw.z, mw.w}, sha[4] = {sh.x, sh.y, sh.z, sh.w};
            float h[4];
#pragma unroll
            for (int j = 0; j < 4; ++j) h[j] = xv[j] * rstd * mwa[j] + sha[j];
#pragma unroll
            for (int q = 0; q < 8; ++q) {
                const float4 w4 = *(const float4*)(lwab + q * 1024 + k0);
                ab[q] += h[0] * w4.x + h[1] * w4.y + h[2] * w4.z + h[3] * w4.w;
            }
            if (IN8) {
                int w8 = __builtin_amdgcn_cvt_pk_fp8_f32(h[0], h[1], 0, false); w8 = __builtin_amdgcn_cvt_pk_fp8_f32(h[2], h[3], w8, true);
                *(int*)(p.ws + OFF_HM8 + (size_t)t * D + k0) = w8;
            }
            { ushort4 o; o.x = f2bf(h[0]); o.y = f2bf(h[1]); o.z = f2bf(h[2]); o.w = f2bf(h[3]);
              *(ushort4*)(hm + (size_t)t * D + k0) = o; }
        }
        {
            const float tot = wave_sum8(ab, lane);
            const int q = ((lane >> 5) & 1) * 4 + ((lane >> 4) & 1) * 2 + ((lane >> 3) & 1);
            if ((lane & 7) == 0) {
                if (q < 4) gb[t * 4 + q] = -expf(p.a_log[q]) * softplus_(tot + p.dt_bias[q]);
                else bb[t * 4 + (q - 4)] = sigmoid_(tot);
            }
        }
    }
}

__device__ void st_inproj_naive(const P& p, float* lds) {
    const bf16_t* hm = (const bf16_t*)(p.ws + OFF_HM);
    bf16_t* qkv = (bf16_t*)(p.ws + OFF_QKV); bf16_t* zs = (bf16_t*)(p.ws + OFF_ZS); bf16_t* ug = (bf16_t*)(p.ws + OFF_UG);
    bf16_t* vgg = (bf16_t*)(p.ws + OFF_VGG); bf16_t* gate = (bf16_t*)(p.ws + OFF_GATE);
    for (int tile = blockIdx.x; tile < T / 16; tile += gridDim.x) {
        const int t0 = tile * 16;
        __syncthreads();
        for (int i = tidx(); i < 16 * D; i += NT) lds[i] = bf2f(hm[(size_t)t0 * D + i]);
        __syncthreads();
        ngemm<16>(lds, D, p.w_in, INCOLS, INCOLS, [&](int i, int n, float acc) {
            const size_t t = t0 + i;
            if (n < 1536) qkv[t * 1536 + n] = f2bf(acc);
            else if (n < 2048) zs[t * 512 + (n - 1536)] = f2bf(silu_(acc));
            else if (n < 2056) {}
            else if (n < 2568) ug[t * 512 + (n - 2056)] = f2bf(gelu_(acc));
            else vgg[t * 512 + (n - 2568)] = f2bf(gelu_(acc));
        });
        ngemm<16>(lds, D, p.w_bg, 2048, 2048, [&](int i, int n, float acc) {
            gate[(size_t)(t0 + i) * 2048 + n] = f2bf(sigmoid_(acc + p.b_bg[n]));
        });
    }
}

__device__ void st_dnprep_naive(const P& p) {
    const int lane = tidx() & 63, gw = (blockIdx.x * NT + tidx()) >> 6, nw = (gridDim.x * NT) >> 6;
    const bf16_t* qkv = (const bf16_t*)(p.ws + OFF_QKV);
    float* qn = (p.out); float* kn = (p.out + (size_t)T * 512); float* vc = (float*)(p.ws + OFF_VC);
    for (int u = gw; u < T * 4; u += nw) {
        const int t = u >> 2, h = u & 3, s = t % SEQ;
        float r[3][2];
#pragma unroll
        for (int part = 0; part < 3; ++part)
#pragma unroll
            for (int j = 0; j < 2; ++j) {
                const int col = part * 512 + h * 128 + lane * 2 + j;
                float y = 0.f;
#pragma unroll
                for (int i = 0; i < 4; ++i) {
                    const int sp = s - 3 + i;
                    if (sp >= 0) y += bf2f(qkv[(size_t)(t - 3 + i) * 1536 + col]) * p.conv_w[i * 1536 + col];
                }
                r[part][j] = silu_(y);
            }
        const float qs = wave_sum(r[0][0] * r[0][0] + r[0][1] * r[0][1]);
        const float ks = wave_sum(r[1][0] * r[1][0] + r[1][1] * r[1][1]);
        const float qsc = rsqrtf(qs + 1e-6f) * 0.08838834764831845f, ksc = rsqrtf(ks + 1e-6f);
        const size_t o = (size_t)t * 512 + h * 128 + lane * 2;
        *(float2*)(qn + o) = make_float2(r[0][0] * qsc, r[0][1] * qsc);
        *(float2*)(kn + o) = make_float2(r[1][0] * ksc, r[1][1] * ksc);
        *(float2*)(vc + o) = make_float2(r[2][0], r[2][1]);
    }
}

__device__ void st_dnrec_naive(const P& p) {
    const int lane = tidx() & 63, gw = (blockIdx.x * NT + tidx()) >> 6, nw = (gridDim.x * NT) >> 6;
    const float* qn = (p.out); const float* kn = (p.out + (size_t)T * 512); const float* vc = (const float*)(p.ws + OFF_VC);
    const float* gb = (const float*)(p.ws + OFF_G); const float* bb = (const float*)(p.ws + OFF_BETA);
    bf16_t* ob = (bf16_t*)(p.ws + OFF_O);
    for (int u = gw; u < NBATCH * 4 * 128; u += nw) {
        const int b = u >> 9, h = (u >> 7) & 3, vcol = u & 127;
        float S0 = 0.f, S1 = 0.f;
        size_t t = (size_t)b * SEQ;
        float2 kk = *(const float2*)(kn + t * 512 + h * 128 + 2 * lane);
        float2 qq = *(const float2*)(qn + t * 512 + h * 128 + 2 * lane);
        float vv = vc[t * 512 + h * 128 + vcol], g = gb[t * 4 + h], be = bb[t * 4 + h];
        for (int s = 0; s < SEQ; ++s, ++t) {
            float2 kk2 = kk, qq2 = qq; float vv2 = vv, g2 = g, be2 = be;
            if (s + 1 < SEQ) {
                const size_t tn = t + 1;
                kk2 = *(const float2*)(kn + tn * 512 + h * 128 + 2 * lane);
                qq2 = *(const float2*)(qn + tn * 512 + h * 128 + 2 * lane);
                vv2 = vc[tn * 512 + h * 128 + vcol]; g2 = gb[tn * 4 + h]; be2 = bb[tn * 4 + h];
            }
            const float a = expf(g);
            const float dk = wave_sum(kk.x * S0 + kk.y * S1);
            const float dq = wave_sum(qq.x * S0 + qq.y * S1);
            const float qk = wave_sum(qq.x * kk.x + qq.y * kk.y);
            const float vnew = be * (vv - a * dk);
            const float o = a * dq + qk * vnew;
            S0 = a * S0 + kk.x * vnew; S1 = a * S1 + kk.y * vnew;
            if (lane == 0) ob[t * 512 + h * 128 + vcol] = f2bf(o);
            kk = kk2; qq = qq2; vv = vv2; g = g2; be = be2;
        }
    }
}

__device__ void st_sgln_naive(const P& p) {
    const int lane = tidx() & 63, gw = (blockIdx.x * NT + tidx()) >> 6, nw = (gridDim.x * NT) >> 6;
    const bf16_t* vgg = (const bf16_t*)(p.ws + OFF_VGG);
    float* vgn = (float*)(p.ws + OFF_VGN);
    for (int t = gw; t < T; t += nw) {
        float v[8]; float s = 0.f;
#pragma unroll
        for (int j = 0; j < 8; ++j) { v[j] = bf2f(vgg[(size_t)t * 512 + j * 64 + lane]); s += v[j]; }
        const float mu = wave_sum(s) * (1.f / 512.f);
        float q = 0.f;
#pragma unroll
        for (int j = 0; j < 8; ++j) { const float d = v[j] - mu; q += d * d; }
        const float rstd = rsqrtf(wave_sum(q) * (1.f / 512.f) + 1e-6f);
#pragma unroll
        for (int j = 0; j < 8; ++j) { const int c = j * 64 + lane; vgn[(size_t)t * 512 + c] = (v[j] - mu) * rstd * p.sg_ln_w[c] + p.sg_ln_b[c]; }
    }
}
__device__ void st_sgmix_naive(const P& p) {
    const int gtid = blockIdx.x * NT + tidx(), gsz = gridDim.x * NT;
    const float* vgn = (const float*)(p.ws + OFF_VGN);
    const bf16_t* ug = (const bf16_t*)(p.ws + OFF_UG);
    bf16_t* ysg = (bf16_t*)(p.ws + OFF_YSG);
    for (int i = gtid; i < T * 512; i += gsz) {
        const int t = i >> 9, c = i & 511, g = c >> 7, tt = t & 127, t0 = t - tt;
        const float* w = p.sg_w + ((size_t)g * 128 + tt) * 128;
        float acc = p.sg_b[g * 128 + tt];
        for (int s = 0; s <= tt; ++s) acc += w[s] * vgn[(size_t)(t0 + s) * 512 + c];
        ysg[i] = f2bf(bf2f(ug[i]) * acc);
    }
}

__device__ __forceinline__ void ydn_unit(const P& p, int u, int lane) {
    bf16_t* ob = (bf16_t*)(p.ws + OFF_O); const bf16_t* zs = (const bf16_t*)(p.ws + OFF_ZS);
    const size_t base = (size_t)(u >> 2) * 512 + (u & 3) * 128 + lane * 2;
    const float o0 = bf2f(ob[base]), o1 = bf2f(ob[base + 1]);
    const float rstd = rsqrtf(wave_sum(o0 * o0 + o1 * o1) * (1.f / 128.f) + 1e-6f);
    ob[base] = f2bf(o0 * rstd * p.dn_norm_w[lane * 2] * bf2f(zs[base]));
    ob[base + 1] = f2bf(o1 * rstd * p.dn_norm_w[lane * 2 + 1] * bf2f(zs[base + 1]));
}
__device__ __forceinline__ void ydn_token(const P& p, int t, int lane) {
    bf16_t* ob = (bf16_t*)(p.ws + OFF_O); const bf16_t* zs = (const bf16_t*)(p.ws + OFF_ZS);
    const float2 nw = *(const float2*)(p.dn_norm_w + lane * 2);
    unsigned ov[4], zv[4]; float ss[4];
#pragma unroll
    for (int h = 0; h < 4; ++h) { const size_t base = (size_t)t * 512 + h * 128 + lane * 2; ov[h] = *(const unsigned*)(ob + base); zv[h] = *(const unsigned*)(zs + base); }
#pragma unroll
    for (int h = 0; h < 4; ++h) { const float o0 = __uint_as_float(ov[h] << 16), o1 = __uint_as_float(ov[h] & 0xffff0000u); ss[h] = o0 * o0 + o1 * o1; }
#pragma unroll
    for (int o = 32; o > 0; o >>= 1) {
#pragma unroll
        for (int h = 0; h < 4; ++h) ss[h] += __shfl_xor(ss[h], o);
    }
#pragma unroll
    for (int h = 0; h < 4; ++h) {
        const float rstd = rsqrtf(ss[h] * (1.f / 128.f) + 1e-6f);
        const float o0 = __uint_as_float(ov[h] << 16), o1 = __uint_as_float(ov[h] & 0xffff0000u);
        *(unsigned*)(ob + (size_t)t * 512 + h * 128 + lane * 2) = pk2(o0 * rstd * nw.x * __uint_as_float(zv[h] << 16), o1 * rstd * nw.y * __uint_as_float(zv[h] & 0xffff0000u));
    }
}
__device__ void st_ydn_naive(const P& p) {
    const int lane = tidx() & 63, gw = (blockIdx.x * NT + tidx()) >> 6, nw = (gridDim.x * NT) >> 6;
    for (int u = gw; u < T * 4; u += nw) ydn_unit(p, u, lane);
}
__device__ void st_merged_naive(const P& p, float* lds) {
    const bf16_t* ydn = (const bf16_t*)(p.ws + OFF_O); const bf16_t* ysg = (const bf16_t*)(p.ws + OFF_YSG);
    const bf16_t* gate = (const bf16_t*)(p.ws + OFF_GATE);
    float* mg = (p.out);
    float* A1 = lds; float* A2 = lds + 16 * 512;
    for (int tile = blockIdx.x; tile < T / 16; tile += gridDim.x) {
        const int t0 = tile * 16;
        __syncthreads();
        for (int i = tidx(); i < 16 * 512; i += NT) { A1[i] = bf2f(ydn[(size_t)t0 * 512 + i]); A2[i] = bf2f(ysg[(size_t)t0 * 512 + i]); }
        __syncthreads();
        ngemm<16>(A1, 512, p.w_pdn, D, D, [&](int i, int n, float acc) { const size_t t = t0 + i; mg[t * D + n] = bf2f(gate[t * 2048 + n]) * acc; });
        ngemm<16>(A2, 512, p.w_psg, D, D, [&](int i, int n, float acc) { const size_t t = t0 + i; mg[t * D + n] += bf2f(gate[t * 2048 + 1024 + n]) * acc; });
    }
}
__device__ void st_wout_naive(const P& p, float* lds) {
    const float* mg = (p.out);
    float* y = (float*)(p.ws + OFF_Y);
    for (int tile = blockIdx.x; tile < T / 16; tile += gridDim.x) {
        const int t0 = tile * 16;
        __syncthreads();
        for (int i = tidx(); i < 16 * D; i += NT) lds[i] = mg[(size_t)t0 * D + i];
        __syncthreads();
        ngemm<16>(lds, D, p.w_out, D, D, [&](int i, int n, float acc) { y[(size_t)(t0 + i) * D + n] = acc; });
    }
}
__device__ __forceinline__ void x1hf_row(const P& p, int t, int lane, const float* lv) {
    const float* y = (const float*)(p.ws + OFF_Y);
    bf16_t* hf = (bf16_t*)(p.ws + OFF_HF);
    float4 yv[4]; float ss = 0.f;
#pragma unroll
    for (int i = 0; i < 4; ++i) { yv[i] = *(const float4*)(y + (size_t)t * D + i * 256 + lane * 4); ss += yv[i].x * yv[i].x + yv[i].y * yv[i].y + yv[i].z * yv[i].z + yv[i].w * yv[i].w; }
    float4 xv[4];
#pragma unroll
    for (int i = 0; i < 4; ++i) xv[i] = *(const float4*)(p.x + (size_t)t * D + i * 256 + lane * 4);
    const float rstd = rsqrtf(wave_sum(ss) * (1.f / 1024.f) + 1e-6f);
    float4 x1[4]; float s2 = 0.f;
#pragma unroll
    for (int i = 0; i < 4; ++i) {
        const int k0 = i * 256 + lane * 4;
        const float4 gm = *(const float4*)(lv + k0);
        float4 v;
        v.x = xv[i].x + gm.x * (yv[i].x * rstd); v.y = xv[i].y + gm.y * (yv[i].y * rstd);
        v.z = xv[i].z + gm.z * (yv[i].z * rstd); v.w = xv[i].w + gm.w * (yv[i].w * rstd);
        x1[i] = v; s2 += v.x * v.x + v.y * v.y + v.z * v.z + v.w * v.w;
        *(float4*)(p.out + (size_t)t * D + k0) = v;
    }
    const float rstd2 = rsqrtf(wave_sum(s2) * (1.f / 1024.f) + 1e-6f);
#pragma unroll
    for (int i = 0; i < 4; ++i) {
        const int k0 = i * 256 + lane * 4;
        const float4 fp = *(const float4*)(lv + 1024 + k0), sh = *(const float4*)(lv + 2048 + k0);
        const float h0 = x1[i].x * rstd2 * fp.x + sh.x, h1 = x1[i].y * rstd2 * fp.y + sh.y;
        const float h2 = x1[i].z * rstd2 * fp.z + sh.z, h3 = x1[i].w * rstd2 * fp.w + sh.w;
        uint2 o;
        o.x = pk2(h0, h1); o.y = pk2(h2, h3);
        *(uint2*)(hf + (size_t)t * D + k0) = o;
        int w8 = __builtin_amdgcn_cvt_pk_fp8_f32(h0, h1, 0, false); w8 = __builtin_amdgcn_cvt_pk_fp8_f32(h2, h3, w8, true);
        *(int*)(p.ws + OFF_HF8 + (size_t)t * D + k0) = w8;
    }
}
__device__ void st_router_naive(const P& p, float* lds) {
    const bf16_t* hf = (const bf16_t*)(p.ws + OFF_HF);
    float* sc = (float*)(p.ws + OFF_SCORES);
    for (int tile = blockIdx.x; tile < T / 16; tile += gridDim.x) {
        const int t0 = tile * 16;
        __syncthreads();
        for (int i = tidx(); i < 16 * D; i += NT) lds[i] = bf2f(hf[(size_t)t0 * D + i]);
        __syncthreads();
        ngemm<16>(lds, D, p.w_router, NE, NE, [&](int i, int n, float acc) { sc[(size_t)(t0 + i) * NE + n] = sigmoid_(acc); });
    }
}
__device__ void st_topk_naive(const P& p) {
    const int gtid = blockIdx.x * NT + tidx(), gsz = gridDim.x * NT;
    const float* sc = (const float*)(p.ws + OFF_SCORES);
    unsigned* cnt = (unsigned*)(p.ws + OFF_CNT);
    int* lists = (int*)(p.ws + OFF_LISTS);
    float* wts = (float*)(p.ws + OFF_WTS); int* idxo = (int*)(p.ws + OFF_IDX);
    for (int t = gtid; t < T; t += gsz) {
        const float* s = sc + (size_t)t * NE;
        float gs[8];
#pragma unroll
        for (int g = 0; g < 8; ++g) {
            float m1 = -INFINITY, m2 = -INFINITY;
            for (int j = 0; j < 32; ++j) { const float v = s[g * 32 + j] + p.router_bias[g * 32 + j]; if (v > m1) { m2 = m1; m1 = v; } else if (v > m2) m2 = v; }
            gs[g] = m1 + m2;
        }
        unsigned gmask = 0;
#pragma unroll
        for (int g = 0; g < 8; ++g) {
            int rank = 0;
#pragma unroll
            for (int h = 0; h < 8; ++h) rank += (gs[h] > gs[g] || (gs[h] == gs[g] && h < g)) ? 1 : 0;
            if (rank < 4) gmask |= 1u << g;
        }
        float pv = INFINITY; int pi = -1;
        int sel[8]; float sw[8]; float wsum = 0.f;
#pragma unroll
        for (int k = 0; k < 8; ++k) {
            float bv = -INFINITY; int bi = 0;
            for (int e = 0; e < NE; ++e) {
                if (!((gmask >> (e >> 5)) & 1u)) continue;
                const float v = s[e] + p.router_bias[e];
                const bool elig = (v < pv) || (v == pv && e > pi);
                if (elig && v > bv) { bv = v; bi = e; }
            }
            pv = bv; pi = bi; sel[k] = bi; sw[k] = s[bi]; wsum += sw[k];
        }
        const float inv = 2.5f / wsum;
#pragma unroll
        for (int k = 0; k < 8; ++k) {
            const int e = sel[k];
            const unsigned pos = atomicAdd(&cnt[e], 1u);
            lists[(size_t)e * LCAP + pos] = t * 8 + k;
            wts[t * 8 + k] = sw[k] * inv; idxo[t * 8 + k] = e;
        }
    }
}

__device__ void st_shared_naive(const P& p, float* lds) {
    const bf16_t* hf = (const bf16_t*)(p.ws + OFF_HF);
    bf16_t* contrib = (bf16_t*)(p.ws + OFF_CONTRIB);
    float* A = lds; float* G = lds + 16 * D; float* H = G + 16 * EH;
    for (int tile = blockIdx.x; tile < T / 16; tile += gridDim.x) {
        const int t0 = tile * 16;
        __syncthreads();
        for (int i = tidx(); i < 16 * D; i += NT) A[i] = bf2f(hf[(size_t)t0 * D + i]);
        __syncthreads();
        ngemm<16>(A, D, p.w_shg, EH, EH, [&](int i, int n, float acc) { G[i * EH + n] = acc; });
        ngemm<16>(A, D, p.w_shu, EH, EH, [&](int i, int n, float acc) { H[i * EH + n] = silu_(G[i * EH + n]) * acc; });
        __syncthreads();
        ngemm<16>(H, EH, p.w_shd, D, D, [&](int i, int n, float acc) { contrib[((size_t)(t0 + i) * 8) * D + n] = f2bf(acc); });
    }
}
__device__ void st_experts_naive(const P& p, float* lds) {
    const bf16_t* hf = (const bf16_t*)(p.ws + OFF_HF);
    bf16_t* contrib = (bf16_t*)(p.ws + OFF_CONTRIB);
    const unsigned* cnt = (const unsigned*)(p.ws + OFF_CNT);
    const int* lists = (const int*)(p.ws + OFF_LISTS);
    const float* wts = (const float*)(p.ws + OFF_WTS);
    float* A = lds; float* G = lds + 16 * D; float* H = G + 16 * EH;
    int* ent = (int*)(H + 16 * EH);
    int* tstart = ent + 16;
    __syncthreads();
    if (tidx() == 0) { int acc = 0; for (int e = 0; e < NE; ++e) { tstart[e] = acc; acc += ((int)cnt[e] + 15) >> 4; } tstart[NE] = acc; }
    __syncthreads();
    const int ntiles = tstart[NE];
    int e = 0;
    for (int tile = blockIdx.x; tile < ntiles; tile += gridDim.x) {
        while (tstart[e + 1] <= tile) ++e;
        const int r0 = (tile - tstart[e]) * 16, ce = (int)cnt[e];
        __syncthreads();
        if (tidx() < 16) ent[tidx()] = (r0 + (int)tidx() < ce) ? lists[(size_t)e * LCAP + r0 + tidx()] : -1;
        __syncthreads();
        for (int i = tidx(); i < 16 * D; i += NT) { const int en = ent[i >> 10]; A[i] = en >= 0 ? bf2f(hf[(size_t)(en >> 3) * D + (i & 1023)]) : 0.f; }
        __syncthreads();
        ngemm<16>(A, D, p.w_eg + (size_t)e * D * EH, EH, EH, [&](int i, int n, float acc) { G[i * EH + n] = acc; });
        ngemm<16>(A, D, p.w_eu + (size_t)e * D * EH, EH, EH, [&](int i, int n, float acc) { H[i * EH + n] = silu_(G[i * EH + n]) * acc; });
        __syncthreads();
        ngemm<16>(H, EH, p.w_ed + (size_t)e * EH * D, D, D, [&](int i, int n, float acc) {
            const int en = ent[i];
            if (en >= 0) {
                float v = acc * wts[en];
                bf16_t* dst = contrib + (size_t)en * D + n;
                if ((en & 7) == 0) v += bf2f(*dst);
                *dst = f2bf(v);
            }
        });
    }
}
constexpr float C8_SCALE = 16.f, C8_INV = 1.f / 16.f;
__device__ void st_combine(const P& p, bool fin, float* lds) {
    const int lane0 = tidx() & 63, gw = (blockIdx.x * NT + tidx()) >> 6, nw = (gridDim.x * NT) >> 6;
    const float* mod = (const float*)(p.ws + OFF_MOD);
    const unsigned char* contrib = (const unsigned char*)(p.ws + OFF_CONTRIB);
    __syncthreads();
    for (int i = tidx(); i < 2048; i += NT) lds[i] = mod[(i >> 10) * 6144 + 5120 + (i & 1023)] * p.ffn_post[i & 1023];
    __syncthreads();
    for (int t = gw; t < T; t += nw) {
        int lane = lane0; asm volatile("" : "+v"(lane));
        const int b = t / SEQ;
        uint4 cv[8];
#pragma unroll
        for (int k = 0; k < 8; ++k) cv[k] = *(const uint4*)(contrib + ((size_t)t * 8 + k) * D + lane * 16);
        const bf16_t* sr = (const bf16_t*)(p.ws + OFF_SHO) + (size_t)t * D + lane * 16;
        const uint4 s0 = *(const uint4*)sr, s1 = *(const uint4*)(sr + 8);
        float4 xv[4];
#pragma unroll
        for (int q = 0; q < 4; ++q) xv[q] = *(const float4*)(p.out + (size_t)t * D + lane * 16 + q * 4);
        float y[16], r[16];
#pragma unroll
        for (int i = 0; i < 16; ++i) r[i] = 0.f;
#pragma unroll
        for (int k = 0; k < 8; ++k) {
            const unsigned w[4] = {cv[k].x, cv[k].y, cv[k].z, cv[k].w};
#pragma unroll
            for (int q = 0; q < 4; ++q) {
                const auto lo = __builtin_amdgcn_cvt_pk_f32_fp8((int)w[q], false), hi = __builtin_amdgcn_cvt_pk_f32_fp8((int)w[q], true);
                r[q * 4] += lo[0]; r[q * 4 + 1] += lo[1]; r[q * 4 + 2] += hi[0]; r[q * 4 + 3] += hi[1];
            }
        }
        { float v8[8]; unpack8(s0, v8);
#pragma unroll
          for (int j = 0; j < 8; ++j) y[j] = v8[j] + r[j] * C8_INV;
          unpack8(s1, v8);
#pragma unroll
          for (int j = 0; j < 8; ++j) y[8 + j] = v8[j] + r[8 + j] * C8_INV; }
        float ss = 0.f;
#pragma unroll
        for (int i = 0; i < 16; ++i) ss += y[i] * y[i];
        const float rstd = rsqrtf(wave_sum(ss) * (1.f / 1024.f) + 1e-6f);
#pragma unroll
        for (int q = 0; q < 4; ++q) {
            const int k0 = lane * 16 + q * 4;
            const float4 g2 = *(const float4*)(lds + b * 1024 + k0);
            float4 o = xv[q];
            o.x += g2.x * (y[q * 4] * rstd); o.y += g2.y * (y[q * 4 + 1] * rstd);
            o.z += g2.z * (y[q * 4 + 2] * rstd); o.w += g2.w * (y[q * 4 + 3] * rstd);
            if (fin) *(float4*)(p.out + (size_t)t * D + k0) = o;
            else if (o.x == 12345.678f) *(float4*)(p.out + (size_t)t * D + k0) = o;
        }
    }
}

typedef short bf16x8 __attribute__((ext_vector_type(8)));
typedef float f32x4 __attribute__((ext_vector_type(4)));

__device__ __forceinline__ float fexp_(float x) { return __builtin_amdgcn_exp2f(x * 1.4426950408889634f); }
__device__ __forceinline__ float fsigmoid_(float x) { return __builtin_amdgcn_rcpf(1.f + fexp_(-x)); }
__device__ __forceinline__ float fsilu_(float x) { return x * fsigmoid_(x); }
__device__ __forceinline__ float fgelu_(float v) {
    const float av = fabsf(v), t = __builtin_amdgcn_rcpf(av * 0.2316418882f + 1.0f);
    float q = t * 0.5307027145f + (-0.7265760135f); q = q * t + 0.7107068705f; q = q * t + (-0.142248368f); q = q * t + 0.127414796f; q = q * t;
    const float e = __builtin_amdgcn_exp2f((v * v) * (-0.72134752044f));
    const float m = v * (q * e);
    return v < 0.f ? m : v - m;
}

constexpr float W8_SCALE = 32.f, W8_INV = 1.f / 32.f;
struct CTile { const float* src; char* dst; int ld, ldd, esz; };
__device__ __forceinline__ CTile conv_decode(const P& p, int id) {
    const int NDENSE = 2048;
    const float* src; int ld, K, cb, kt, colbase = 0, esz = 2; char* dst; int drow0;
    if (id < NDENSE) {
        int r = id;
        if (r < 512) { src = p.w_in; ld = INCOLS; K = 1024; cb = r >> 3; kt = r & 7; dst = p.ws + OFF_WT_IN; drow0 = cb * 32; }
        else if ((r -= 512) < 256) { src = p.w_in; ld = INCOLS; K = 1024; cb = r >> 3; kt = r & 7; colbase = 2056; dst = p.ws + (IN8 ? OFF_WT_IN8 : OFF_WT_IN); drow0 = 2048 + cb * 32; esz = IN8 ? 1 : 2; }
        else if ((r -= 256) < 512) { src = p.w_bg; ld = 2048; K = 1024; cb = r >> 3; kt = r & 7; dst = p.ws + (IN8 ? OFF_WT_IN8 : OFF_WT_IN); drow0 = 3072 + cb * 32; esz = IN8 ? 1 : 2; }
        else if ((r -= 512) < 128) { src = p.w_pdn; ld = 1024; K = 512; cb = r >> 2; kt = r & 3; dst = p.ws + OFF_WT_DN; drow0 = cb * 32; }
        else if ((r -= 128) < 128) { src = p.w_psg; ld = 1024; K = 512; cb = r >> 2; kt = r & 3; dst = p.ws + OFF_WT_SG; drow0 = cb * 32; }
        else if ((r -= 128) < 256) { src = p.w_out; ld = 1024; K = 1024; cb = r >> 3; kt = r & 7; dst = p.ws + OFF_WT_OUT; drow0 = cb * 32; }
        else if ((r -= 256) < 64) { src = p.w_router; ld = 256; K = 1024; cb = r >> 3; kt = r & 7; dst = p.ws + OFF_WT_RT; drow0 = cb * 32; }
        else if ((r -= 64) < 128) { const int pp = r >> 6; r &= 63; src = pp ? p.w_shu : p.w_shg; ld = 256; K = 1024; cb = r >> 3; kt = r & 7; dst = p.ws + OFF_WT_SHGU; drow0 = (cb >> 2) * 256 + (cb & 3) * 64 + pp * 32; esz = 1; }
        else { r -= 128; src = p.w_shd; ld = 1024; K = 256; cb = r >> 1; kt = r & 1; dst = p.ws + OFF_WT_SHD; drow0 = cb * 32; esz = 1; }
    } else {
        const int r = id - NDENSE, m = r / (256 * 64), e = (r >> 6) & 255, tl = r & 63;
        esz = 1;
        if (m < 2) { src = (m ? p.w_eu : p.w_eg) + (size_t)e * 1024 * 256; ld = 256; K = 1024; cb = tl >> 3; kt = tl & 7;
                     dst = p.ws + OFF_WT_GU + (size_t)e * 512 * 1024; drow0 = (cb >> 2) * 256 + (cb & 3) * 64 + m * 32; }
        else { src = p.w_ed + (size_t)e * 256 * 1024; ld = 1024; K = 256; cb = tl >> 1; kt = tl & 1; dst = p.ws + OFF_WT_D + (size_t)e * 1024 * 256; drow0 = cb * 32; }
    }
    CTile t; t.src = src + (size_t)(kt * 128) * ld + colbase + cb * 32; t.dst = dst + ((size_t)drow0 * K + kt * 128) * esz; t.ld = ld; t.ldd = K * esz; t.esz = esz;
    return t;
}
__device__ __forceinline__ uint2 pack8_fp8(const float (&v)[8]) {
    int w0 = __builtin_amdgcn_cvt_pk_fp8_f32(v[0], v[1], 0, false); w0 = __builtin_amdgcn_cvt_pk_fp8_f32(v[2], v[3], w0, true);
    int w1 = __builtin_amdgcn_cvt_pk_fp8_f32(v[4], v[5], 0, false); w1 = __builtin_amdgcn_cvt_pk_fp8_f32(v[6], v[7], w1, true);
    return make_uint2((unsigned)w0, (unsigned)w1);
}
__device__ void st_convert(const P& p, float* lds) {
    const int tid = tidx();
    const int NTOT = 2048 + 3 * 256 * 64;
    float4 v[4][2];
    auto issue = [&](int base) {
#pragma unroll
        for (int j = 0; j < 4; ++j) {
            const CTile t = conv_decode(p, base + j);
#pragma unroll
            for (int i = 0; i < 2; ++i) v[j][i] = *(const float4*)(t.src + (size_t)((tid >> 3) + 64 * i) * t.ld + (tid & 7) * 4);
        }
    };
    if (blockIdx.x * 4 < NTOT) issue(blockIdx.x * 4);
    for (int base = blockIdx.x * 4; base < NTOT; base += gridDim.x * 4) {
        __syncthreads();
#pragma unroll
        for (int j = 0; j < 4; ++j)
#pragma unroll
            for (int i = 0; i < 2; ++i) {
                float* d = lds + j * (128 * 33) + ((tid >> 3) + 64 * i) * 33 + (tid & 7) * 4;
                d[0] = v[j][i].x; d[1] = v[j][i].y; d[2] = v[j][i].z; d[3] = v[j][i].w;
            }
        __syncthreads();
        if (base + (int)gridDim.x * 4 < NTOT) issue(base + gridDim.x * 4);
#pragma unroll
        for (int j = 0; j < 4; ++j) {
            const CTile t = conv_decode(p, base + j);
            const int n = tid >> 4, kc = tid & 15;
            float o[8];
#pragma unroll
            for (int q = 0; q < 8; ++q) o[q] = lds[j * (128 * 33) + (kc * 8 + q) * 33 + n];
            if (t.esz == 2) *(uint4*)(t.dst + (size_t)n * t.ldd + kc * 16) = pack8(o);
            else {
#pragma unroll
                for (int q = 0; q < 8; ++q) o[q] *= W8_SCALE;
                *(uint2*)(t.dst + (size_t)n * t.ldd + kc * 8) = pack8_fp8(o);
            }
        }
    }
    __syncthreads();
    bf16_t* tw = (bf16_t*)(p.ws + OFF_TRILW);
    for (int i = blockIdx.x * NT + tidx(); i < 4 * 128 * 128; i += gridDim.x * NT) { const int t = (i >> 7) & 127, s = i & 127; tw[i] = s <= t ? f2bf(p.sg_w[i]) : (bf16_t)0; }
}

constexpr int XT_BYTES = 128 * 128, WT_BYTES = 256 * 128, STG_BYTES = XT_BYTES + WT_BYTES;
constexpr size_t OFF_ZERO = 480 * MiB + 320 * 1024;
#define LAS3 __attribute__((address_space(3)))

template <class F> __device__ __forceinline__ void epi_each(const f32x4 (&acc)[4][4], F f) {
    const int lane = tidx() & 63, wid = tidx() >> 6, wr = wid >> 2, wc = wid & 3, fr = lane & 15, fg = lane >> 4;
#pragma unroll
    for (int mi = 0; mi < 4; ++mi)
#pragma unroll
        for (int pp = 0; pp < 2; ++pp) {
            const float v[8] = {acc[mi][2 * pp][0], acc[mi][2 * pp][1], acc[mi][2 * pp][2], acc[mi][2 * pp][3],
                                acc[mi][2 * pp + 1][0], acc[mi][2 * pp + 1][1], acc[mi][2 * pp + 1][2], acc[mi][2 * pp + 1][3]};
            f(wr * 64 + mi * 16 + fr, wc * 64 + pp * 32 + 8 * fg, v);
        }
}

__device__ __forceinline__ uint4 dpp_ror8(const uint4 v) {
    uint4 r;
    r.x = (unsigned)__builtin_amdgcn_update_dpp(0, (int)v.x, 0x128, 0xf, 0xf, false); r.y = (unsigned)__builtin_amdgcn_update_dpp(0, (int)v.y, 0x128, 0xf, 0xf, false);
    r.z = (unsigned)__builtin_amdgcn_update_dpp(0, (int)v.z, 0x128, 0xf, 0xf, false); r.w = (unsigned)__builtin_amdgcn_update_dpp(0, (int)v.w, 0x128, 0xf, 0xf, false);
    return r;
}
template <class F, class G> __device__ __forceinline__ void epi_rows(const f32x4 (&acc)[4][4], F f, G st) {
    const int lane = tidx() & 63, wid = tidx() >> 6, wr = wid >> 2, wc = wid & 3, fr = lane & 15, fg = lane >> 4;
    const bool lo = fr < 8;
#pragma unroll
    for (int mi = 0; mi < 4; ++mi) {
        const float a0[8] = {acc[mi][0][0], acc[mi][0][1], acc[mi][0][2], acc[mi][0][3], acc[mi][1][0], acc[mi][1][1], acc[mi][1][2], acc[mi][1][3]};
        const float a1[8] = {acc[mi][2][0], acc[mi][2][1], acc[mi][2][2], acc[mi][2][3], acc[mi][3][0], acc[mi][3][1], acc[mi][3][2], acc[mi][3][3]};
        const int r = wr * 64 + mi * 16 + fr, c0 = wc * 64 + 8 * fg;
        const uint4 A = f(r, c0, a0), B = f(r, c0 + 32, a1);
        const uint4 Bs = dpp_ror8(B);
        const int rb = wr * 64 + mi * 16 + (fr & 7);
        st(rb, lo ? c0 : c0 + 32, lo ? A : Bs);
        st(rb + 8, lo ? c0 + 32 : c0, lo ? Bs : A);
    }
}

template <bool A_LDS, int ESTORES, class RowPtr, class WPtr, class Epi>
__device__ __forceinline__ void gemm_panel(RowPtr rp, const char* Hs, int hstride, WPtr wp, int ldw, int nk, int nv, char* stage, Epi epi) {
    const int tid = tidx(), lane = tid & 63, wid = tid >> 6, wr = wid >> 2, wc = wid & 3, fr = lane & 15, fg = lane >> 4;
    constexpr int XOFF = A_LDS ? 0 : XT_BYTES, BUFB = A_LDS ? WT_BYTES : STG_BYTES;
    const int l8 = lane >> 3, kcl = ((lane & 7) ^ l8) * 8;
    auto gload = [&](int v, int kt, int buf) {
        char* b = stage + buf * BUFB + lane * 16;
        const int k0 = kt * 64 + kcl;
        if constexpr (!A_LDS) {
#pragma unroll
            for (int i = 0; i < 2; ++i) {
                const int q = wid + 8 * i;
                __builtin_amdgcn_global_load_lds((const unsigned*)(rp(v, q * 8 + l8) + k0), (LAS3 unsigned*)(b + q * 1024), 16, 0, 0);
            }
        }
        const bf16_t* wb = wp(v) + k0;
#pragma unroll
        for (int i = 0; i < 4; ++i) {
            const int q = wid + 8 * i, rho = q * 8 + l8, ii = rho & 15;
            const int n = (rho & ~31) + 8 * (ii >> 2) + (ii & 3) + ((rho >> 2) & 4);
            __builtin_amdgcn_global_load_lds((const unsigned*)(wb + (size_t)n * ldw), (LAS3 unsigned*)(b + XOFF + q * 1024), 16, 0, 0);
        }
    };
    const int S = nk * nv;
    constexpr int NST = A_LDS ? 2 : 3;
    gload(0, 0, 0);
    if constexpr (NST == 3) { if (S > 1) gload(nk > 1 ? 0 : 1, nk > 1 ? 1 : 0, 1); }
    f32x4 acc[4][4];
    int v = 0, kt = 0;
    int vp = 0, ktp = 0;
#pragma unroll
    for (int i = 0; i < NST - 1; ++i) { if (++ktp == nk) { ktp = 0; ++vp; } }
    int bufc = 0, bufp = NST - 1;
    const int xc0 = (fg ^ (fr & 7)) * 16;
    const int wrow_off = (wc * 64 + fr) * 128;
    const int xrow_off = (wr * 64 + fr) * 128;
    bool pend = false; int vpend = 0;
    int since = 2;
    for (int s = 0; s < S; ++s) {
        if (NST == 3 && s + 1 < S) {
            if constexpr (A_LDS) asm volatile("s_waitcnt vmcnt(4)" ::: "memory");
            else if (ESTORES > 0 && since < 2) asm volatile("s_waitcnt vmcnt(%0)" :: "n"(6 + ESTORES) : "memory");
            else asm volatile("s_waitcnt vmcnt(6)" ::: "memory");
        }
        else asm volatile("s_waitcnt vmcnt(0)" ::: "memory");
        __builtin_amdgcn_s_barrier();
        if (pend) { epi(vpend, acc); pend = false; }
        if (s + NST - 1 < S) gload(vp, ktp, bufp);
        if (kt == 0) {
#pragma unroll
            for (int mi = 0; mi < 4; ++mi)
#pragma unroll
                for (int ni = 0; ni < 4; ++ni) acc[mi][ni] = (f32x4){0.f, 0.f, 0.f, 0.f};
        }
        const char* b = stage + bufc * BUFB;
#pragma unroll
        for (int ks = 0; ks < 2; ++ks) {
            bf16x8 xf[4], wf[4];
#pragma unroll
            for (int mi = 0; mi < 4; ++mi) {
                if constexpr (A_LDS) xf[mi] = *(const bf16x8*)(Hs + (wr * 64 + mi * 16 + fr) * hstride + (kt * 64 + ks * 32 + fg * 8) * 2);
                else xf[mi] = *(const bf16x8*)(b + xrow_off + mi * 2048 + (xc0 ^ (ks * 64)));
            }
#pragma unroll
            for (int ni = 0; ni < 4; ++ni) wf[ni] = *(const bf16x8*)(b + XOFF + wrow_off + ni * 2048 + (xc0 ^ (ks * 64)));
#pragma unroll
            for (int mi = 0; mi < 4; ++mi)
#pragma unroll
                for (int ni = 0; ni < 4; ++ni) acc[mi][ni] = __builtin_amdgcn_mfma_f32_16x16x32_bf16(wf[ni], xf[mi], acc[mi][ni], 0, 0, 0);
        }
        if (ESTORES > 0) { if (kt == nk - 1) { epi(v, acc); since = 0; } else if (since < 2) ++since; }
        else if (kt == nk - 1) { pend = true; vpend = v; }
        if (++kt == nk) { kt = 0; ++v; }
        if (++ktp == nk) { ktp = 0; ++vp; }
        if (++bufc == NST) bufc = 0;
        if (++bufp == NST) bufp = 0;
    }
    if (pend) epi(vpend, acc);
    __syncthreads();
}

typedef unsigned char u8_t;
template <bool A_LDS, int ESTORES, bool P16, class RowPtr, class WPtr, class Epi>
__device__ __forceinline__ void gemm_panel8(RowPtr rp, const char* Hs, int hstride, WPtr wp, int ldw, int nk, int nv, char* stage, Epi epi) {
    const int tid = tidx(), lane = tid & 63, wid = __builtin_amdgcn_readfirstlane(tid >> 6), wr = wid >> 2, wc = wid & 3, fr = lane & 15, fg = lane >> 4;
    constexpr int XOFF = A_LDS ? 0 : XT_BYTES, BUFB = A_LDS ? WT_BYTES : STG_BYTES;
    const int l8 = lane >> 3;
    auto gload = [&](int v, int kt, int buf) {
        char* b = stage + buf * BUFB + lane * 16;
        if constexpr (!A_LDS) {
#pragma unroll
            for (int i = 0; i < 2; ++i) {
                const int q = wid + 8 * i, k0 = kt * 128 + (((lane & 7) ^ l8 ^ (q & 1)) << 4);
                __builtin_amdgcn_global_load_lds((const unsigned*)(rp(v, q * 8 + l8) + k0), (LAS3 unsigned*)(b + q * 1024), 16, 0, 0);
            }
        }
        const u8_t* wb = wp(v) + kt * 128;
#pragma unroll
        for (int i = 0; i < 4; ++i) {
            const int q = wid + 8 * i, rho = q * 8 + l8, ii = rho & 15;
            const int n = P16 ? (rho & ~63) + 16 * (ii >> 2) + 4 * ((rho >> 4) & 3) + (ii & 3) : (rho & ~31) + 8 * (ii >> 2) + (ii & 3) + ((rho >> 2) & 4);
            __builtin_amdgcn_global_load_lds((const unsigned*)(wb + (size_t)n * ldw + (((lane & 7) ^ l8 ^ (q & 1)) << 4)), (LAS3 unsigned*)(b + XOFF + q * 1024), 16, 0, 0);
        }
    };
    const int S = nk * nv;
    gload(0, 0, 0);
    if (S > 1) gload(nk > 1 ? 0 : 1, nk > 1 ? 1 : 0, 1);
    f32x4 acc[4][4];
    int v = 0, kt = 0, vp = 0, ktp = 0;
#pragma unroll
    for (int i = 0; i < 2; ++i) { if (++ktp == nk) { ktp = 0; ++vp; } }
    int bufc = 0, bufp = 2;
    const int sw = (fr & 7) ^ (fr >> 3);
    const int wrow_off = XOFF + (wc * 64 + fr) * 128 + (fg & 1) * 8;
    const int xrow_off = (wr * 64 + fr) * 128 + (fg & 1) * 8;
    bool pend = false; int vpend = 0;
    int since = 2;
    constexpr int PER = A_LDS ? 4 : 6;
    for (int s = 0; s < S; ++s) {
        if (s + 1 < S) {
            if (ESTORES > 0 && since < 2) asm volatile("s_waitcnt vmcnt(%0)" :: "n"(PER + ESTORES) : "memory");
            else asm volatile("s_waitcnt vmcnt(%0)" :: "n"(PER) : "memory");
        }
        else asm volatile("s_waitcnt vmcnt(0)" ::: "memory");
        __builtin_amdgcn_s_barrier();
        if (pend) { epi(vpend, acc); pend = false; }
        if (s + 2 < S) gload(vp, ktp, bufp);
        if (kt == 0) {
#pragma unroll
            for (int mi = 0; mi < 4; ++mi)
#pragma unroll
                for (int ni = 0; ni < 4; ++ni) acc[mi][ni] = (f32x4){0.f, 0.f, 0.f, 0.f};
        }
        const char* b = stage + bufc * BUFB;
#pragma unroll
        for (int ks = 0; ks < 4; ++ks) {
            long xf[4], wf[4];
            const int co = ((ks * 2 + (fg >> 1)) ^ sw) << 4;
#pragma unroll
            for (int mi = 0; mi < 4; ++mi) {
                if constexpr (A_LDS) xf[mi] = *(const long*)(Hs + (wr * 64 + mi * 16 + fr) * hstride + kt * 128 + ks * 32 + fg * 8);
                else xf[mi] = *(const long*)(b + xrow_off + mi * 2048 + co);
            }
#pragma unroll
            for (int ni = 0; ni < 4; ++ni) wf[ni] = *(const long*)(b + wrow_off + ni * 2048 + co);
#pragma unroll
            for (int mi = 0; mi < 4; ++mi)
#pragma unroll
                for (int ni = 0; ni < 4; ++ni) acc[mi][ni] = __builtin_amdgcn_mfma_f32_16x16x32_fp8_fp8(wf[ni], xf[mi], acc[mi][ni], 0, 0, 0);
        }
        if (ESTORES > 0) { if (kt == nk - 1) { epi(v, acc); since = 0; } else if (since < 2) ++since; }
        else if (kt == nk - 1) { pend = true; vpend = v; }
        if (++kt == nk) { kt = 0; ++v; }
        if (++ktp == nk) { ktp = 0; ++vp; }
        if (++bufc == 3) bufc = 0;
        if (++bufp == 3) bufp = 0;
    }
    if (pend) epi(vpend, acc);
    __syncthreads();
}

__device__ void st_inproj_fast(const P& p, char* lds, int abl) {
    const bf16_t* hm = (const bf16_t*)(p.ws + OFF_HM);
    const bf16_t* wt = (const bf16_t*)(p.ws + OFF_WT_IN);
    bf16_t* qkv = (bf16_t*)(p.ws + OFF_QKV); bf16_t* zs = (bf16_t*)(p.ws + OFF_ZS); bf16_t* ug = (bf16_t*)(p.ws + OFF_UG);
    bf16_t* vgg = (bf16_t*)(p.ws + OFF_VGG); bf16_t* gate = (bf16_t*)(p.ws + OFF_GATE);
    bf16_t* lbias = (bf16_t*)(lds + 3 * STG_BYTES);
    for (int i = tidx(); i < 2048; i += NT) lbias[i] = f2bf(p.b_bg[i]);
    __syncthreads();
    for (int panel = blockIdx.x; panel < T / 128; panel += gridDim.x) {
        const size_t t0 = (size_t)panel * 128;
        auto epi = [&](int v, const f32x4 (&acc)[4][4]) {
            if (abl == 1) { if (acc[0][0][0] == 12345.678f) qkv[0] = 1; return; }
            epi_rows(acc,
                [&](int r, int c, const float (&a_)[8]) {
                    const int col = v * 256 + c;
                    float a[8], o[8];
#pragma unroll
                    for (int j = 0; j < 8; ++j) a[j] = (IN8 && v >= 8) ? a_[j] * W8_INV : a_[j];
                    if (v < 6 || abl == 2) {
#pragma unroll
                        for (int j = 0; j < 8; ++j) o[j] = a[j];
                    } else if (v < 8) {
#pragma unroll
                        for (int j = 0; j < 8; ++j) o[j] = fsilu_(a[j]);
                    } else if (v < 12) {
#pragma unroll
                        for (int j = 0; j < 8; ++j) o[j] = fgelu_(a[j]);
                    } else {
                        float bs[8]; unpack8(*(const uint4*)(lbias + (col - 3072)), bs);
#pragma unroll
                        for (int j = 0; j < 8; ++j) o[j] = fsigmoid_(a[j] + bs[j]);
                    }
                    return pack8(o);
                },
                [&](int r, int c, const uint4 d) {
                    const size_t t = t0 + r; const int col = v * 256 + c;
                    if (v < 6) *(uint4*)(qkv + t * 1536 + col) = d;
                    else if (v < 8) *(uint4*)(zs + t * 512 + (col - 1536)) = d;
                    else if (v < 10) *(uint4*)(ug + t * 512 + (col - 2048)) = d;
                    else if (v < 12) *(uint4*)(vgg + t * 512 + (col - 2560)) = d;
                    else *(uint4*)(gate + t * 2048 + (col - 3072)) = d;
                });
        };
        if (IN8) {
            gemm_panel<false, 8>([&](int, int r) { return hm + (t0 + r) * D; }, nullptr, 0, [&](int v) { return wt + (size_t)v * 256 * D; }, D, 16, 8, lds, epi);
            gemm_panel8<false, 0, false>([&](int, int r) { return (const u8_t*)(p.ws + OFF_HM8) + (t0 + r) * D; }, nullptr, 0,
                               [&](int v) { return (const u8_t*)(p.ws + OFF_WT_IN8) + (size_t)(v + 8) * 256 * D; }, D, 8, 12, lds,
                               [&](int v, const f32x4 (&acc)[4][4]) { epi(v + 8, acc); });
        } else gemm_panel<false, 8>([&](int, int r) { return hm + (t0 + r) * D; }, nullptr, 0, [&](int v) { return wt + (size_t)v * 256 * D; }, D, 16, 20, lds, epi);
    }
}

constexpr int HSTRIDE = 272;
constexpr int HS_BYTES = 35 * 1024;
constexpr int LDS_ENT = 148 * 1024;

template <class RowSrc, class Store>
__device__ __forceinline__ void moe_tile(RowSrc rowsrc, const u8_t* wgu, const u8_t* wd, char* lds, Store store) {
    const int lane = tidx() & 63, wid = tidx() >> 6, wr = wid >> 2, wc = wid & 3, fr = lane & 15, fg = lane >> 4;
    uint2 h0[4], h1[4];
    gemm_panel8<false, 0, false>([&](int, int r) { return rowsrc(r); }, nullptr, 0, [&](int v) { return wgu + (size_t)v * 256 * D; }, D, 8, 2, lds,
                       [&](int v, const f32x4 (&acc)[4][4]) {
#pragma unroll
                           for (int mi = 0; mi < 4; ++mi) {
                               float h[8];
#pragma unroll
                               for (int j = 0; j < 4; ++j) {
                                   h[j] = fsilu_(acc[mi][0][j] * W8_INV) * (acc[mi][2][j] * W8_INV);
                                   h[4 + j] = fsilu_(acc[mi][1][j] * W8_INV) * (acc[mi][3][j] * W8_INV);
                               }
                               if (v == 0) h0[mi] = pack8_fp8(h); else h1[mi] = pack8_fp8(h);
                           }
                       });
#pragma unroll
    for (int mi = 0; mi < 4; ++mi) {
        char* hp = lds + (wr * 64 + mi * 16 + fr) * HSTRIDE + wc * 32 + 8 * fg;
        *(uint2*)(hp) = h0[mi]; *(uint2*)(hp + 128) = h1[mi];
    }
    __syncthreads();
    gemm_panel8<true, 4, true>([&](int, int) { return (const u8_t*)nullptr; }, lds, HSTRIDE, [&](int v) { return wd + (size_t)v * 256 * EH; }, EH, 2, 4, lds + HS_BYTES,
                      [&](int v, const f32x4 (&acc)[4][4]) {
#pragma unroll
                          for (int mi = 0; mi < 4; ++mi) {
                              const float a[16] = {acc[mi][0][0], acc[mi][0][1], acc[mi][0][2], acc[mi][0][3], acc[mi][1][0], acc[mi][1][1], acc[mi][1][2], acc[mi][1][3],
                                                   acc[mi][2][0], acc[mi][2][1], acc[mi][2][2], acc[mi][2][3], acc[mi][3][0], acc[mi][3][1], acc[mi][3][2], acc[mi][3][3]};
                              store(wr * 64 + mi * 16 + fr, v * 256 + wc * 64 + 16 * fg, a);
                          }
                      });
}

constexpr size_t OFF_TRASH = 505 * MiB;
__device__ __forceinline__ void st_moe_fast(const P& p, char* lds, bool fin, int which) {
    const u8_t* hf8 = (const u8_t*)(p.ws + OFF_HF8);
    u8_t* contrib = (u8_t*)(p.ws + OFF_CONTRIB);
    bf16_t* sho = (bf16_t*)(p.ws + OFF_SHO);
    u8_t* trash = (u8_t*)(p.ws + OFF_TRASH) + (size_t)blockIdx.x * D;
    const unsigned* cnt = (const unsigned*)(p.ws + OFF_CNT);
    const int* lists = (const int*)(p.ws + OFF_LISTS);
    const float* wts = (const float*)(p.ws + OFF_WTS);
    int* ent = (int*)(lds + LDS_ENT);
    int* tstart = ent + 128;
    float* wrow = (float*)(tstart + 260);
    __syncthreads();
    if (tidx() == 0) { int acc = 0; for (int e = 0; e < NE; ++e) { tstart[e] = acc; acc += ((int)cnt[e] + 127) >> 7; } tstart[NE] = acc; }
    __syncthreads();
    const int ntiles = which ? 0 : tstart[NE];
    int e = 0;
    for (int tile = blockIdx.x; tile < (which ? T / 128 : ntiles); tile += gridDim.x) {
        if (tile < ntiles) {
            while (tstart[e + 1] <= tile) ++e;
            const int r0 = (tile - tstart[e]) * 128, ce = (int)cnt[e];
            __syncthreads();
            if (tidx() < 128) { const int en = (r0 + (int)tidx() < ce) ? lists[(size_t)e * LCAP + r0 + tidx()] : -1; ent[tidx()] = en; wrow[tidx()] = en >= 0 ? wts[en] * W8_INV : 0.f; }
            __syncthreads();
            moe_tile([&](int r) { const int en = ent[r]; return en >= 0 ? hf8 + (size_t)(en >> 3) * D : (const u8_t*)(p.ws + OFF_ZERO); },
                     (const u8_t*)(p.ws + OFF_WT_GU) + (size_t)e * 512 * D, (const u8_t*)(p.ws + OFF_WT_D) + (size_t)e * D * EH, lds,
                     [&](int r, int col, const float (&a)[16]) {
                         const int en = ent[r];
                         const float w = wrow[r] * C8_SCALE;
                         float o0[8], o1[8];
#pragma unroll
                         for (int j = 0; j < 8; ++j) { o0[j] = a[j] * w; o1[j] = a[8 + j] * w; }
                         const uint2 lo = pack8_fp8(o0), hi = pack8_fp8(o1);
                         u8_t* dst = (en >= 0 && fin) ? contrib + (size_t)en * D + col : trash + col;
                         *(uint4*)dst = make_uint4(lo.x, lo.y, hi.x, hi.y);
                     });
        } else {
            const size_t t0 = (size_t)(tile - ntiles) * 128;
            __syncthreads();
            moe_tile([&](int r) { return hf8 + (t0 + r) * D; }, (const u8_t*)(p.ws + OFF_WT_SHGU), (const u8_t*)(p.ws + OFF_WT_SHD), lds,
                     [&](int r, int col, const float (&a)[16]) {
                         float o0[8], o1[8];
#pragma unroll
                         for (int j = 0; j < 8; ++j) { o0[j] = a[j] * W8_INV; o1[j] = a[8 + j] * W8_INV; }
                         *(uint4*)(sho + (t0 + r) * D + col) = pack8(o0); *(uint4*)(sho + (t0 + r) * D + col + 8) = pack8(o1);
                     });
        }
    }
}

constexpr size_t OFF_MERGEDB = 736 * MiB;
__device__ __forceinline__ void wg_sync() { asm volatile("s_waitcnt vmcnt(0)" ::: "memory"); __syncthreads(); }
struct TopE { float v; int e; };
__device__ __forceinline__ bool better(const TopE& a, const TopE& b) { return a.v > b.v || (a.v == b.v && a.e < b.e); }

__device__ void st_post_fast(const P& p, char* lds, bool fin) {
    const int tid = tidx(), lane = tid & 63, wid = tid >> 6, wr = wid >> 2, wc = wid & 3, fr = lane & 15, fg = lane >> 4;
    const bf16_t* ydn = (const bf16_t*)(p.ws + OFF_O); const bf16_t* ysg = (const bf16_t*)(p.ws + OFF_YSG);
    const bf16_t* gate = (const bf16_t*)(p.ws + OFF_GATE);
    bf16_t* mg = (bf16_t*)(p.ws + OFF_MERGEDB);
    float* y = (float*)(p.ws + OFF_Y);
    const bf16_t* hf = (const bf16_t*)(p.ws + OFF_HF);
    unsigned* cnt = (unsigned*)(p.ws + OFF_CNT);
    int* lists = (int*)(p.ws + OFF_LISTS);
    float* wts = (float*)(p.ws + OFF_WTS);
    float* sc = (float*)lds;
    float* bias = (float*)(lds + 131584);
    int* hist = (int*)(lds + 132608);
    int* base = (int*)(lds + 133632);
    for (int panel = blockIdx.x; panel < T / 128; panel += gridDim.x) {
        const size_t t0 = (size_t)panel * 128;
        if (fin) for (int r = wid; r < 128; r += 8) ydn_token(p, (int)t0 + r, lane);
        wg_sync();
        {
            gemm_panel<false, 8>([&](int v, int r) { return ((v & 1) ? ysg : ydn) + (t0 + r) * 512; }, nullptr, 0,
                              [&](int v) { return (const bf16_t*)(p.ws + ((v & 1) ? OFF_WT_SG : OFF_WT_DN)) + (size_t)(v >> 1) * 256 * 512; }, 512, 8, 8, lds,
                              [&](int v, const f32x4 (&acc)[4][4]) {
                                  uint4 gv[4][2], mv[4][2];
#pragma unroll
                                  for (int mi = 0; mi < 4; ++mi)
#pragma unroll
                                      for (int pp = 0; pp < 2; ++pp) {
                                          const size_t t = t0 + wr * 64 + mi * 16 + fr; const int col = (v >> 1) * 256 + wc * 64 + pp * 32 + 8 * fg;
                                          gv[mi][pp] = *(const uint4*)(gate + t * 2048 + (v & 1) * 1024 + col);
                                          if (v & 1) mv[mi][pp] = *(const uint4*)(mg + t * D + col);
                                      }
#pragma unroll
                                  for (int mi = 0; mi < 4; ++mi)
#pragma unroll
                                      for (int pp = 0; pp < 2; ++pp) {
                                          const size_t t = t0 + wr * 64 + mi * 16 + fr; const int col = (v >> 1) * 256 + wc * 64 + pp * 32 + 8 * fg;
                                          float g[8], o[8]; unpack8(gv[mi][pp], g);
                                          const float a[8] = {acc[mi][2 * pp][0], acc[mi][2 * pp][1], acc[mi][2 * pp][2], acc[mi][2 * pp][3],
                                                              acc[mi][2 * pp + 1][0], acc[mi][2 * pp + 1][1], acc[mi][2 * pp + 1][2], acc[mi][2 * pp + 1][3]};
                                          if (v & 1) {
                                              float m[8]; unpack8(mv[mi][pp], m);
#pragma unroll
                                              for (int j = 0; j < 8; ++j) o[j] = m[j] + g[j] * a[j];
                                          } else {
#pragma unroll
                                              for (int j = 0; j < 8; ++j) o[j] = g[j] * a[j];
                                          }
                                          *(uint4*)(mg + t * D + col) = pack8(o);
                                      }
                              });
        }
        wg_sync();
        gemm_panel<false, 16>([&](int, int r) { return mg + (t0 + r) * D; }, nullptr, 0, [&](int v) { return (const bf16_t*)(p.ws + OFF_WT_OUT) + (size_t)v * 256 * D; }, D, 16, 4, lds,
                          [&](int v, const f32x4 (&acc)[4][4]) {
                              epi_each(acc, [&](int r, int c, const float (&a)[8]) {
                                  float* dst = y + (t0 + r) * D + v * 256 + c;
                                  *(float4*)dst = make_float4(a[0], a[1], a[2], a[3]); *(float4*)(dst + 4) = make_float4(a[4], a[5], a[6], a[7]);
                              });
                          });
        wg_sync();
        {
            float* lv = (float*)lds;
            const float* mod = (const float*)(p.ws + OFF_MOD);
            const int b = (int)(t0 / SEQ);
            for (int k = tid; k < 1024; k += NT) {
                lv[k] = mod[b * 6144 + 2048 + k] * p.mix_post[k];
                lv[1024 + k] = p.ffn_pre[k] * (1.f + mod[b * 6144 + 4096 + k]);
                lv[2048 + k] = mod[b * 6144 + 3072 + k];
            }
            __syncthreads();
            for (int r = wid; r < 128; r += 8) x1hf_row(p, (int)t0 + r, lane, lv);
        }
        wg_sync();
        {
            f32x4 racc[4][4];
            gemm_panel<false, 0>([&](int, int r) { return hf + (t0 + r) * D; }, nullptr, 0, [&](int) { return (const bf16_t*)(p.ws + OFF_WT_RT); }, D, 16, 1, lds,
                              [&](int, const f32x4 (&acc)[4][4]) {
#pragma unroll
                                  for (int mi = 0; mi < 4; ++mi)
#pragma unroll
                                      for (int ni = 0; ni < 4; ++ni) racc[mi][ni] = acc[mi][ni];
                              });
            epi_each(racc, [&](int r, int c, const float (&a)[8]) {
#pragma unroll
                for (int j = 0; j < 8; ++j) sc[r * 257 + c + j] = fsigmoid_(a[j]);
            });
        }
        { int tt = tid; asm volatile("" : "+v"(tt)); if (tt < 256) { bias[tt] = p.router_bias[tt]; hist[tt] = 0; } }
        __syncthreads();
        {
            const int tok = tid >> 2, q = tid & 3;
            const float* srow = sc + tok * 257;
            TopE l[8];
#pragma unroll
            for (int k = 0; k < 8; ++k) { l[k].v = -INFINITY; l[k].e = 1 << 30; }
            float a1 = -INFINITY, a2 = -INFINITY, b1 = -INFINITY, b2 = -INFINITY;
            for (int i = 0; i < 64; ++i) {
                const int idx = (i + 8 * q) & 63, e = 64 * q + idx;
                const float v = srow[e] + bias[e];
                if (idx < 32) { if (v > a1) { a2 = a1; a1 = v; } else if (v > a2) a2 = v; }
                else { if (v > b1) { b2 = b1; b1 = v; } else if (v > b2) b2 = v; }
            }
            const float gs0 = a1 + a2, gs1 = b1 + b2;
            int r0 = 0, r1 = 0;
#pragma unroll
            for (int h = 0; h < 8; ++h) {
                const float gh = __shfl((h & 1) ? gs1 : gs0, (lane & ~3) | (h >> 1));
                r0 += (gh > gs0 || (gh == gs0 && h < 2 * q)) ? 1 : 0;
                r1 += (gh > gs1 || (gh == gs1 && h < 2 * q + 1)) ? 1 : 0;
            }
            const bool sel0 = r0 < 4, sel1 = r1 < 4;
            for (int i = 0; i < 64; ++i) {
                const int idx = (i + 8 * q) & 63, e = 64 * q + idx;
                if (idx < 32 ? sel0 : sel1) {
                    TopE cur; cur.v = srow[e] + bias[e]; cur.e = e;
                    if (better(cur, l[7])) {
#pragma unroll
                        for (int k = 0; k < 8; ++k) if (better(cur, l[k])) { const TopE tmp = l[k]; l[k] = cur; cur = tmp; }
                    }
                }
            }
            int we[8]; float wv[8]; float wsum = 0.f;
#pragma unroll
            for (int k = 0; k < 8; ++k) {
                TopE h = l[0];
#pragma unroll
                for (int o = 1; o < 4; o <<= 1) { TopE t2; t2.v = __shfl_xor(h.v, o); t2.e = __shfl_xor(h.e, o); if (better(t2, h)) h = t2; }
                if (l[0].e == h.e) {
#pragma unroll
                    for (int j = 0; j < 7; ++j) l[j] = l[j + 1];
                    l[7].v = -INFINITY; l[7].e = 1 << 30;
                }
                we[k] = h.e; wv[k] = srow[h.e]; wsum += wv[k];
            }
            const float inv = 2.5f / wsum;
            int rk0 = 0, rk1 = 0, e0 = 0, e1 = 0; float w0 = 0.f, w1 = 0.f;
#pragma unroll
            for (int k = 0; k < 8; ++k) if ((k >> 1) == q) { if (k & 1) { e1 = we[k]; w1 = wv[k] * inv; } else { e0 = we[k]; w0 = wv[k] * inv; } }
            rk0 = atomicAdd(&hist[e0], 1); rk1 = atomicAdd(&hist[e1], 1);
            __syncthreads();
            { int tt = tid; asm volatile("" : "+v"(tt)); if (tt < 256) { const int c = hist[tt]; base[tt] = (c > 0 && fin) ? (int)atomicAdd(&cnt[tt], (unsigned)c) : 0; } }
            __syncthreads();
            const int tg = (int)t0 + tok;
            if (fin) {
            lists[(size_t)e0 * LCAP + base[e0] + rk0] = tg * 8 + 2 * q; wts[tg * 8 + 2 * q] = w0;
            lists[(size_t)e1 * LCAP + base[e1] + rk1] = tg * 8 + 2 * q + 1; wts[tg * 8 + 2 * q + 1] = w1;
            }
        }
        __syncthreads();
    }
}

constexpr size_t OFF_GL  = 480 * MiB + 128 * 1024;
constexpr size_t OFF_KDT = 960 * MiB;
constexpr size_t OFF_QKF = 992 * MiB;
constexpr int DN_HALF = 73728;
constexpr int DQS = 0, DKS = 18432, DLS = 36864, DWL = 53248, DMISC = 71680;

__device__ __forceinline__ bf16x8 pack_b(const f32x4 a, const f32x4 b) {
    const uint4 u = make_uint4(pk2(a[0], a[1]), pk2(a[2], a[3]), pk2(b[0], b[1]), pk2(b[2], b[3]));
    return __builtin_bit_cast(bf16x8, u);
}

__device__ void st_dnprep_fast(const P& p, char* lds, int abl) {
    const int tid0 = tidx();
    const bf16_t* qkv = (const bf16_t*)(p.ws + OFF_QKV);
    const float* gb = (const float*)(p.ws + OFF_G); const float* bb = (const float*)(p.ws + OFF_BETA);
    float* GL = (float*)(p.ws + OFF_GL);
    bf16_t* KDT = (bf16_t*)(p.ws + OFF_KDT); bf16_t* QKF = (bf16_t*)(p.ws + OFF_QKF);
    float* UF = p.out; bf16_t* WC = (bf16_t*)((char*)p.out + 64 * MiB); bf16_t* QD = (bf16_t*)((char*)p.out + 96 * MiB);
    for (int it = blockIdx.x; it < 1024; it += gridDim.x) {
        int tid = tid0; asm volatile("" : "+v"(tid));
        const int lane = tid & 63, wid = tid >> 6, hb = wid >> 2, hw = __builtin_amdgcn_readfirstlane(wid & 3), ht = tid & 255, fr = lane & 15, fg = lane >> 4;
        char* L = lds + hb * DN_HALF;
        bf16_t* Qs = (bf16_t*)(L + DQS); bf16_t* Ks = (bf16_t*)(L + DKS); float* Ls = (float*)(L + DLS); bf16_t* Wl = (bf16_t*)(L + DWL);
        float* gc = (float*)(L + DMISC); float* beta = gc + 64; float* egc = gc + 128; float* ekl = gc + 192; float* rnq = gc + 256;
        const int unit = it * 2 + hb, h = unit & 3, cn = unit >> 2, t0 = cn * 64, s0 = t0 % SEQ;
        __syncthreads();
        if (hw == 0) {
            const float g = gb[(t0 + lane) * 4 + h], be = bb[(t0 + lane) * 4 + h];
            float c = g;
#pragma unroll
            for (int o = 1; o < 64; o <<= 1) { const float t = __shfl_up(c, o); if (lane >= o) c += t; }
            const float gl = __shfl(c, 63);
            gc[lane] = c; beta[lane] = be; egc[lane] = expf(c); ekl[lane] = expf(gl - c);
            if (lane == 0) GL[unit] = expf(gl);
        }
        {
            const int cp = ht & 63, part = (ht >> 6) & 1, rh = ht >> 7, col = part * 512 + h * 128 + cp * 2, i0 = rh * 32;
            bf16_t* dstp = (part ? Ks : Qs) + cp * 2;
            float2 cw[4];
#pragma unroll
            for (int tap = 0; tap < 4; ++tap) cw[tap] = *(const float2*)(p.conv_w + tap * 1536 + col);
            float2 w0, w1, w2;
            {
                const unsigned r0 = (s0 + i0 >= 3) ? *(const unsigned*)(qkv + (size_t)(t0 + i0 - 3) * 1536 + col) : 0u;
                const unsigned r1 = (s0 + i0 >= 2) ? *(const unsigned*)(qkv + (size_t)(t0 + i0 - 2) * 1536 + col) : 0u;
                const unsigned r2 = (s0 + i0 >= 1) ? *(const unsigned*)(qkv + (size_t)(t0 + i0 - 1) * 1536 + col) : 0u;
                w0 = make_float2(__uint_as_float(r0 << 16), __uint_as_float(r0 & 0xffff0000u));
                w1 = make_float2(__uint_as_float(r1 << 16), __uint_as_float(r1 & 0xffff0000u));
                w2 = make_float2(__uint_as_float(r2 << 16), __uint_as_float(r2 & 0xffff0000u));
            }
            if (!(abl & 1)) {
#pragma unroll
            for (int i = 0; i < 32; ++i) {
                const unsigned r3 = *(const unsigned*)(qkv + (size_t)(t0 + i0 + i) * 1536 + col);
                const float2 w3 = make_float2(__uint_as_float(r3 << 16), __uint_as_float(r3 & 0xffff0000u));
                *(unsigned*)(dstp + (i0 + i) * 144) = pk2(fsilu_(w0.x * cw[0].x + w1.x * cw[1].x + w2.x * cw[2].x + w3.x * cw[3].x),
                                                          fsilu_(w0.y * cw[0].y + w1.y * cw[1].y + w2.y * cw[2].y + w3.y * cw[3].y));
                w0 = w1; w1 = w2; w2 = w3;
            }
            }
        }
        __syncthreads();
        if (ht < 128) {
            const int part = ht >> 6, row = ht & 63;
            const bf16_t* rp_ = (part ? Ks : Qs) + row * 144;
            float ss = 0.f;
#pragma unroll
            for (int q = 0; q < 16; ++q) { float v8[8]; unpack8(*(const uint4*)(rp_ + q * 8), v8);
#pragma unroll
                for (int j = 0; j < 8; ++j) ss += v8[j] * v8[j]; }
            rnq[part * 64 + row] = rsqrtf(ss + 1e-6f) * (part ? 1.f : 0.08838834764831845f);
        }
        __syncthreads();
        {
            f32x4 akk[4], aqk[4];
#pragma unroll
            for (int jt = 0; jt < 4; ++jt) { akk[jt] = (f32x4){0.f, 0.f, 0.f, 0.f}; aqk[jt] = akk[jt]; }
#pragma unroll
            for (int ks = 0; ks < 4; ++ks) {
                const bf16x8 aK = *(const bf16x8*)(Ks + (16 * hw + fr) * 144 + 32 * ks + 8 * fg);
                const bf16x8 aQ = *(const bf16x8*)(Qs + (16 * hw + fr) * 144 + 32 * ks + 8 * fg);
#pragma unroll
                for (int jt = 0; jt < 4; ++jt) {
                    if (jt <= hw) {
                        const bf16x8 bK = *(const bf16x8*)(Ks + (16 * jt + fr) * 144 + 32 * ks + 8 * fg);
                        akk[jt] = __builtin_amdgcn_mfma_f32_16x16x32_bf16(aK, bK, akk[jt], 0, 0, 0);
                        aqk[jt] = __builtin_amdgcn_mfma_f32_16x16x32_bf16(aQ, bK, aqk[jt], 0, 0, 0);
                    }
                }
            }
#pragma unroll
            for (int jt = 0; jt < 4; ++jt) {
                const int j = 16 * jt + fr;
                const float gj = gc[j], rkj = rnq[64 + j];
                float lt[4];
#pragma unroll
                for (int r = 0; r < 4; ++r) {
                    const int i = 16 * hw + 4 * fg + r;
                    const float dec = (i >= j) ? fexp_(gc[i] - gj) * rkj : 0.f;
                    lt[r] = (i > j) ? beta[i] * rnq[64 + i] * akk[jt][r] * dec : 0.f;
                    const int idx = ((hw * 2 + (j >> 5)) * 64 + ((j & 15) >> 2) * 16 + (i & 15)) * 8 + ((j >> 4) & 1) * 4 + (j & 3);
                    QKF[(size_t)unit * 4096 + idx] = f2bf(aqk[jt][r] * rnq[i] * dec);
                }
                *(float4*)(Ls + j * 64 + 16 * hw + 4 * fg) = make_float4(lt[0], lt[1], lt[2], lt[3]);
            }
        }
        __syncthreads();
        {
            float x[64];
            const int c = ht;
            if (c < 128) {
                const int col = 1024 + h * 128 + c;
                float cw[4];
#pragma unroll
                for (int tap = 0; tap < 4; ++tap) cw[tap] = p.conv_w[tap * 1536 + col];
                float w0 = (s0 >= 3) ? bf2f(qkv[(size_t)(t0 - 3) * 1536 + col]) : 0.f;
                float w1 = (s0 >= 2) ? bf2f(qkv[(size_t)(t0 - 2) * 1536 + col]) : 0.f;
                float w2 = (s0 >= 1) ? bf2f(qkv[(size_t)(t0 - 1) * 1536 + col]) : 0.f;
#pragma unroll
                for (int i = 0; i < 64; ++i) {
                    const float w3 = bf2f(qkv[(size_t)(t0 + i) * 1536 + col]);
                    x[i] = fsilu_(w0 * cw[0] + w1 * cw[1] + w2 * cw[2] + w3 * cw[3]) * beta[i];
                    w0 = w1; w1 = w2; w2 = w3;
                }
            } else {
#pragma unroll
                for (int i = 0; i < 64; ++i) x[i] = bf2f(Ks[i * 144 + (c - 128)]) * rnq[64 + i] * beta[i] * egc[i];
            }
            if (!(abl & 2)) {
#pragma unroll
            for (int j = 0; j < 63; ++j) {
                const float xj = x[j];
#pragma unroll
                for (int i = j + 1; i < 64; ++i) x[i] -= Ls[j * 64 + i] * xj;
                if ((j & 1) == 1) __builtin_amdgcn_sched_barrier(0);
            }
            }
            if (c < 128) {
#pragma unroll
                for (int rt = 0; rt < 4; ++rt)
#pragma unroll
                    for (int g4 = 0; g4 < 4; ++g4)
                        *(float4*)(UF + (size_t)unit * 8192 + ((((c >> 4) * 4 + rt) * 64 + g4 * 16 + (c & 15)) << 2)) =
                            make_float4(x[16 * rt + 4 * g4], x[16 * rt + 4 * g4 + 1], x[16 * rt + 4 * g4 + 2], x[16 * rt + 4 * g4 + 3]);
            } else {
#pragma unroll
                for (int i = 0; i < 64; ++i) Wl[i * 144 + (c - 128)] = f2bf(x[i]);
            }
        }
        __syncthreads();
        if (!(abl & 4)) {
#pragma unroll
        for (int m = 0; m < 4; ++m) {
            const int q = ht + 256 * m, frag = q >> 6, l = q & 63, lfr = l & 15, lfg = l >> 4;
            {
                const int row = 16 * (frag >> 2) + lfr, k0 = 32 * (frag & 3) + 4 * lfg;
                const uint2 lo = *(const uint2*)(Wl + row * 144 + k0), hi = *(const uint2*)(Wl + row * 144 + k0 + 16);
                *(uint4*)(WC + (size_t)unit * 8192 + q * 8) = make_uint4(lo.x, lo.y, hi.x, hi.y);
                const uint2 ql = *(const uint2*)(Qs + row * 144 + k0), qh = *(const uint2*)(Qs + row * 144 + k0 + 16);
                const float e = egc[row] * rnq[row];
                float v[8]; unpack8(make_uint4(ql.x, ql.y, qh.x, qh.y), v);
#pragma unroll
                for (int j = 0; j < 8; ++j) v[j] *= e;
                *(uint4*)(QD + (size_t)unit * 8192 + q * 8) = pack8(v);
            }
            {
                const int kd = 16 * (frag >> 1) + lfr, c0 = 32 * (frag & 1) + 4 * lfg;
                float v[8];
#pragma unroll
                for (int j = 0; j < 8; ++j) { const int cpos = c0 + 16 * (j >> 2) + (j & 3); v[j] = bf2f(Ks[cpos * 144 + kd]) * ekl[cpos] * rnq[64 + cpos]; }
                *(uint4*)(KDT + (size_t)unit * 8192 + q * 8) = pack8(v);
            }
        }
        }
    }
}

__device__ void st_dnscan_fast(const P& p, char* lds) {
    const int tid = tidx(), lane = tid & 63, wid = tid >> 6, fr = lane & 15, fg = lane >> 4;
    const int sb = blockIdx.x, vq = sb & 3, h = (sb >> 2) & 3, b = sb >> 4;
    const float* GL = (const float*)(p.ws + OFF_GL);
    const char* KDT = p.ws + OFF_KDT; const char* QKF = p.ws + OFF_QKF;
    const char* UF = (const char*)p.out; const char* WC = (const char*)p.out + 64 * MiB; const char* QD = (const char*)p.out + 96 * MiB;
    bf16_t* ob = (bf16_t*)(p.ws + OFF_O);
    auto dma = [&](int n, int buf) {
        const size_t unit = (size_t)((b * 256 + n) * 4 + h);
        const int lw = wid - 2;
#pragma unroll
        for (int j = 0; j < 11; ++j) {
            const int pi = lw + 6 * j;
            if (pi < 64) {
                const char* src;
                if (pi < 16) src = WC + unit * 16384 + pi * 1024;
                else if (pi < 32) src = QD + unit * 16384 + (pi - 16) * 1024;
                else if (pi < 48) src = KDT + unit * 16384 + (pi - 32) * 1024;
                else if (pi < 56) src = QKF + unit * 8192 + (pi - 48) * 1024;
                else src = UF + unit * 32768 + (size_t)(2 * vq + ((pi - 56) >> 2)) * 4096 + ((pi - 56) & 3) * 1024;
                __builtin_amdgcn_global_load_lds((const unsigned*)(src + lane * 16), (LAS3 unsigned*)(lds + buf * 65536 + pi * 1024 + lane * 16), 16, 0, 0);
            }
        }
    };
    f32x4 S[8];
#pragma unroll
    for (int k = 0; k < 8; ++k) S[k] = (f32x4){0.f, 0.f, 0.f, 0.f};
    if (wid >= 2) dma(0, 0);
    asm volatile("s_waitcnt vmcnt(0)" ::: "memory");
    __syncthreads();
    for (int n = 0; n < 256; ++n) {
        if (wid >= 2) {
            if (n + 1 < 256) dma(n + 1, (n + 1) & 1);
        } else {
            const int vs = 2 * vq + wid;
            const char* B = lds + (n & 1) * 65536 + lane * 16;
            const float egl = GL[(b * 256 + n) * 4 + h];
            bf16x8 Sb[4];
#pragma unroll
            for (int s = 0; s < 4; ++s) Sb[s] = pack_b(S[2 * s], S[2 * s + 1]);
            f32x4 vn[4], o[4];
#pragma unroll
            for (int rt = 0; rt < 4; ++rt) {
                f32x4 pm = (f32x4){0.f, 0.f, 0.f, 0.f}, qo = pm;
#pragma unroll
                for (int s = 0; s < 4; ++s) {
                    pm = __builtin_amdgcn_mfma_f32_16x16x32_bf16(*(const bf16x8*)(B + (rt * 4 + s) * 1024), Sb[s], pm, 0, 0, 0);
                    qo = __builtin_amdgcn_mfma_f32_16x16x32_bf16(*(const bf16x8*)(B + (16 + rt * 4 + s) * 1024), Sb[s], qo, 0, 0, 0);
                }
                const float4 u4 = *(const float4*)(B + (56 + 4 * wid + rt) * 1024);
                vn[rt] = (f32x4){u4.x - pm[0], u4.y - pm[1], u4.z - pm[2], u4.w - pm[3]};
                o[rt] = qo;
            }
            bf16x8 Vb[2];
            Vb[0] = pack_b(vn[0], vn[1]); Vb[1] = pack_b(vn[2], vn[3]);
#pragma unroll
            for (int rt = 0; rt < 4; ++rt)
#pragma unroll
                for (int s2 = 0; s2 < 2; ++s2) o[rt] = __builtin_amdgcn_mfma_f32_16x16x32_bf16(*(const bf16x8*)(B + (48 + rt * 2 + s2) * 1024), Vb[s2], o[rt], 0, 0, 0);
#pragma unroll
            for (int kt = 0; kt < 8; ++kt) {
                S[kt] = S[kt] * egl;
#pragma unroll
                for (int s2 = 0; s2 < 2; ++s2) S[kt] = __builtin_amdgcn_mfma_f32_16x16x32_bf16(*(const bf16x8*)(B + (32 + kt * 2 + s2) * 1024), Vb[s2], S[kt], 0, 0, 0);
            }
            const size_t t0 = (size_t)(b * 256 + n) * 64;
#pragma unroll
            for (int rt = 0; rt < 4; ++rt)
#pragma unroll
                for (int r = 0; r < 4; ++r) ob[(t0 + 16 * rt + 4 * fg + r) * 512 + h * 128 + vs * 16 + fr] = f2bf(o[rt][r]);
        }
        if (wid >= 2) asm volatile("s_waitcnt vmcnt(0)" ::: "memory");
        __builtin_amdgcn_s_barrier();
    }
}

constexpr size_t OFF_MG  = 384 * MiB;
constexpr size_t OFF_BG  = 392 * MiB;
constexpr size_t OFF_SGS = 400 * MiB;

__device__ void st_scan_l1(const P& p, char* lds) {
    const int tid = tidx(), lane = tid & 63, wid = __builtin_amdgcn_readfirstlane(tid >> 6), fr = lane & 15, fg = lane >> 4;
    const float* GL = (const float*)(p.ws + OFF_GL);
    const char* KDT = p.ws + OFF_KDT;
    const char* UF = (const char*)p.out; const char* WC = (const char*)p.out + 64 * MiB;
    for (int blk = blockIdx.x; blk < 256; blk += gridDim.x) {
        const int g2 = blk >> 1, half = blk & 1, bh = g2 >> 4, g = g2 & 15, b = bh >> 2, h = bh & 3;
        const int npieces = half ? 64 : 32;
        auto dma = [&](int i, int buf) {
            const size_t unit = (size_t)((b * 256 + g * 16 + i) * 4 + h);
            for (int pi = wid; pi < npieces; pi += 8) {
                const char* src;
                if (pi < 16) src = WC + unit * 16384 + pi * 1024;
                else if (pi < 32) src = KDT + unit * 16384 + (pi - 16) * 1024;
                else src = UF + unit * 32768 + (pi - 32) * 1024;
                __builtin_amdgcn_global_load_lds((const unsigned*)(src + lane * 16), (LAS3 unsigned*)(lds + buf * 65536 + pi * 1024 + lane * 16), 16, 0, 0);
            }
        };
        f32x4 X[8];
#pragma unroll
        for (int t = 0; t < 8; ++t)
#pragma unroll
            for (int r = 0; r < 4; ++r) X[t][r] = (!half && (16 * t + 4 * fg + r == 16 * wid + fr)) ? 1.f : 0.f;
        __syncthreads();
        dma(0, 0);
        asm volatile("s_waitcnt vmcnt(0)" ::: "memory");
        __syncthreads();
        for (int i = 0; i < 16; ++i) {
            if (i + 1 < 16) dma(i + 1, (i + 1) & 1);
            const char* B = lds + (i & 1) * 65536 + lane * 16;
            const float egl = GL[(b * 256 + g * 16 + i) * 4 + h];
            bf16x8 Xb[4];
#pragma unroll
            for (int s = 0; s < 4; ++s) Xb[s] = pack_b(X[2 * s], X[2 * s + 1]);
            f32x4 vn[4];
#pragma unroll
            for (int rt = 0; rt < 4; ++rt) {
                f32x4 pm = (f32x4){0.f, 0.f, 0.f, 0.f};
#pragma unroll
                for (int s = 0; s < 4; ++s) pm = __builtin_amdgcn_mfma_f32_16x16x32_bf16(*(const bf16x8*)(B + (rt * 4 + s) * 1024), Xb[s], pm, 0, 0, 0);
                if (half) { const float4 u4 = *(const float4*)(B + (32 + 4 * wid + rt) * 1024); vn[rt] = (f32x4){u4.x - pm[0], u4.y - pm[1], u4.z - pm[2], u4.w - pm[3]}; }
                else vn[rt] = (f32x4){-pm[0], -pm[1], -pm[2], -pm[3]};
            }
            bf16x8 Vb[2];
            Vb[0] = pack_b(vn[0], vn[1]); Vb[1] = pack_b(vn[2], vn[3]);
#pragma unroll
            for (int kt = 0; kt < 8; ++kt) {
                X[kt] = X[kt] * egl;
#pragma unroll
                for (int s2 = 0; s2 < 2; ++s2) X[kt] = __builtin_amdgcn_mfma_f32_16x16x32_bf16(*(const bf16x8*)(B + (16 + kt * 2 + s2) * 1024), Vb[s2], X[kt], 0, 0, 0);
            }
            asm volatile("s_waitcnt vmcnt(0)" ::: "memory");
            __builtin_amdgcn_s_barrier();
        }
        if (half) {
            float4* bg = (float4*)(p.ws + OFF_BG) + ((size_t)(g2 * 8 + wid) * 8) * 64 + lane;
#pragma unroll
            for (int t = 0; t < 8; ++t) bg[t * 64] = make_float4(X[t][0], X[t][1], X[t][2], X[t][3]);
        } else {
            bf16_t* Ml = (bf16_t*)lds;
#pragma unroll
            for (int t = 0; t < 8; ++t)
#pragma unroll
                for (int r = 0; r < 4; ++r) Ml[(16 * t + 4 * fg + r) * 136 + 16 * wid + fr] = f2bf(X[t][r]);
            __syncthreads();
            bf16_t* mg = (bf16_t*)(p.ws + OFF_MG) + (size_t)g2 * 16384;
#pragma unroll
            for (int m = 0; m < 4; ++m) {
                const int q = tid + 512 * m, frag = q >> 6, l = q & 63, row = 16 * (frag >> 2) + (l & 15), k0 = 32 * (frag & 3) + 4 * (l >> 4);
                const uint2 lo = *(const uint2*)(Ml + row * 136 + k0), hi = *(const uint2*)(Ml + row * 136 + k0 + 16);
                *(uint4*)(mg + q * 8) = make_uint4(lo.x, lo.y, hi.x, hi.y);
            }
        }
    }
}

__device__ void st_scan_l2(const P& p, char* lds) {
    const int tid = tidx(), lane = tid & 63, wid = __builtin_amdgcn_readfirstlane(tid >> 6);
    const int bh = blockIdx.x;
    const char* MG = p.ws + OFF_MG;
    auto dma = [&](int g, int buf) {
#pragma unroll
        for (int j = 0; j < 4; ++j) {
            const int pi = wid + 8 * j;
            __builtin_amdgcn_global_load_lds((const unsigned*)(MG + (size_t)(bh * 16 + g) * 32768 + pi * 1024 + lane * 16), (LAS3 unsigned*)(lds + buf * 32768 + pi * 1024 + lane * 16), 16, 0, 0);
        }
    };
    f32x4 S[8];
#pragma unroll
    for (int t = 0; t < 8; ++t) S[t] = (f32x4){0.f, 0.f, 0.f, 0.f};
    __syncthreads();
    dma(0, 0);
    asm volatile("s_waitcnt vmcnt(0)" ::: "memory");
    __syncthreads();
    for (int g = 0; g < 16; ++g) {
        if (g + 1 < 16) dma(g + 1, (g + 1) & 1);
        float4* sg = (float4*)(p.ws + OFF_SGS) + ((size_t)((bh * 16 + g) * 8 + wid) * 8) * 64 + lane;
        const float4* bg = (const float4*)(p.ws + OFF_BG) + ((size_t)((bh * 16 + g) * 8 + wid) * 8) * 64 + lane;
#pragma unroll
        for (int t = 0; t < 8; ++t) sg[t * 64] = make_float4(S[t][0], S[t][1], S[t][2], S[t][3]);
        const char* B = lds + (g & 1) * 32768 + lane * 16;
        bf16x8 Sb[4];
#pragma unroll
        for (int s = 0; s < 4; ++s) Sb[s] = pack_b(S[2 * s], S[2 * s + 1]);
#pragma unroll
        for (int t = 0; t < 8; ++t) {
            const float4 b4 = bg[t * 64];
            f32x4 a = (f32x4){b4.x, b4.y, b4.z, b4.w};
#pragma unroll
            for (int s = 0; s < 4; ++s) a = __builtin_amdgcn_mfma_f32_16x16x32_bf16(*(const bf16x8*)(B + (t * 4 + s) * 1024), Sb[s], a, 0, 0, 0);
            S[t] = a;
        }
        asm volatile("s_waitcnt vmcnt(0)" ::: "memory");
        __builtin_amdgcn_s_barrier();
    }
}

__device__ void st_scan_l3(const P& p, char* lds) {
    const int tid = tidx(), lane = tid & 63, wid = __builtin_amdgcn_readfirstlane(tid >> 6), fr = lane & 15, fg = lane >> 4;
    const float* GL = (const float*)(p.ws + OFF_GL);
    const char* KDT = p.ws + OFF_KDT; const char* QKF = p.ws + OFF_QKF;
    const char* UF = (const char*)p.out; const char* WC = (const char*)p.out + 64 * MiB; const char* QD = (const char*)p.out + 96 * MiB;
    bf16_t* ob = (bf16_t*)(p.ws + OFF_O);
    for (int blk = blockIdx.x; blk < 256; blk += gridDim.x) {
        const int g2 = blk >> 1, vh = blk & 1, bh = g2 >> 4, g = g2 & 15, b = bh >> 2, h = bh & 3;
        auto dma = [&](int i, int buf) {
            const size_t unit = (size_t)((b * 256 + g * 16 + i) * 4 + h);
            for (int pi = wid - 4; pi < 72; pi += 4) {
                const char* src;
                if (pi < 16) src = WC + unit * 16384 + pi * 1024;
                else if (pi < 32) src = QD + unit * 16384 + (pi - 16) * 1024;
                else if (pi < 48) src = KDT + unit * 16384 + (pi - 32) * 1024;
                else if (pi < 56) src = QKF + unit * 8192 + (pi - 48) * 1024;
                else src = UF + unit * 32768 + (size_t)vh * 16384 + (pi - 56) * 1024;
                __builtin_amdgcn_global_load_lds((const unsigned*)(src + lane * 16), (LAS3 unsigned*)(lds + buf * 73728 + pi * 1024 + lane * 16), 16, 0, 0);
            }
        };
        f32x4 S[8];
        if (wid < 4) {
            const float4* sg = (const float4*)(p.ws + OFF_SGS) + ((size_t)(g2 * 8 + vh * 4 + wid) * 8) * 64 + lane;
#pragma unroll
            for (int t = 0; t < 8; ++t) { const float4 s4 = sg[t * 64]; S[t] = (f32x4){s4.x, s4.y, s4.z, s4.w}; }
        }
        __syncthreads();
        if (wid >= 4) dma(0, 0);
        asm volatile("s_waitcnt vmcnt(0)" ::: "memory");
        __syncthreads();
        for (int i = 0; i < 16; ++i) {
            if (wid >= 4) {
                if (i + 1 < 16) dma(i + 1, (i + 1) & 1);
            } else {
                const int vs = vh * 4 + wid, n = g * 16 + i;
                const char* B = lds + (i & 1) * 73728 + lane * 16;
                const float egl = GL[(b * 256 + n) * 4 + h];
                bf16x8 Sb[4];
#pragma unroll
                for (int s = 0; s < 4; ++s) Sb[s] = pack_b(S[2 * s], S[2 * s + 1]);
                f32x4 vn[4], o[4];
#pragma unroll
                for (int rt = 0; rt < 4; ++rt) {
                    f32x4 pm = (f32x4){0.f, 0.f, 0.f, 0.f}, qo = pm;
#pragma unroll
                    for (int s = 0; s < 4; ++s) {
                        pm = __builtin_amdgcn_mfma_f32_16x16x32_bf16(*(const bf16x8*)(B + (rt * 4 + s) * 1024), Sb[s], pm, 0, 0, 0);
                        qo = __builtin_amdgcn_mfma_f32_16x16x32_bf16(*(const bf16x8*)(B + (16 + rt * 4 + s) * 1024), Sb[s], qo, 0, 0, 0);
                    }
                    const float4 u4 = *(const float4*)(B + (56 + 4 * wid + rt) * 1024);
                    vn[rt] = (f32x4){u4.x - pm[0], u4.y - pm[1], u4.z - pm[2], u4.w - pm[3]};
                    o[rt] = qo;
                }
                bf16x8 Vb[2];
                Vb[0] = pack_b(vn[0], vn[1]); Vb[1] = pack_b(vn[2], vn[3]);
#pragma unroll
                for (int rt = 0; rt < 4; ++rt)
#pragma unroll
                    for (int s2 = 0; s2 < 2; ++s2) o[rt] = __builtin_amdgcn_mfma_f32_16x16x32_bf16(*(const bf16x8*)(B + (48 + rt * 2 + s2) * 1024), Vb[s2], o[rt], 0, 0, 0);
#pragma unroll
                for (int kt = 0; kt < 8; ++kt) {
                    S[kt] = S[kt] * egl;
#pragma unroll
                    for (int s2 = 0; s2 < 2; ++s2) S[kt] = __builtin_amdgcn_mfma_f32_16x16x32_bf16(*(const bf16x8*)(B + (32 + kt * 2 + s2) * 1024), Vb[s2], S[kt], 0, 0, 0);
                }
                const size_t t0 = (size_t)(b * 256 + n) * 64;
#pragma unroll
                for (int rt = 0; rt < 4; ++rt)
#pragma unroll
                    for (int r = 0; r < 4; ++r) ob[(t0 + 16 * rt + 4 * fg + r) * 512 + h * 128 + vs * 16 + fr] = f2bf(o[rt][r]);
            }
            if (wid >= 4) asm volatile("s_waitcnt vmcnt(0)" ::: "memory");
            __builtin_amdgcn_s_barrier();
        }
    }
}

__device__ void st_sg_fast(const P& p, char* lds, int first, int stride) {
    const int tid = tidx(), lane = tid & 63, wid = tid >> 6, fr = lane & 15, fg = lane >> 4;
    const bf16_t* vgg = (const bf16_t*)(p.ws + OFF_VGG); const bf16_t* ug = (const bf16_t*)(p.ws + OFF_UG);
    const bf16_t* tw = (const bf16_t*)(p.ws + OFF_TRILW);
    bf16_t* ysg = (bf16_t*)(p.ws + OFF_YSG);
    bf16_t* XT = (bf16_t*)lds;
    float* mean = (float*)(lds + 147456); float* rstd = mean + 128;
    for (int unit = first; unit < T / 128; unit += stride) {
        const size_t t0 = (size_t)unit * 128;
        __syncthreads();
        for (int rr = 0; rr < 16; ++rr) {
            const int s = wid * 16 + rr;
            float v[8]; unpack8(*(const uint4*)(vgg + (t0 + s) * 512 + lane * 8), v);
            float sm = 0.f;
#pragma unroll
            for (int j = 0; j < 8; ++j) sm += v[j];
            const float mu = wave_sum(sm) * (1.f / 512.f);
            float q = 0.f;
#pragma unroll
            for (int j = 0; j < 8; ++j) { const float d = v[j] - mu; q += d * d; }
            const float rs = rsqrtf(wave_sum(q) * (1.f / 512.f) + 1e-6f);
            if (lane == 0) { mean[s] = mu; rstd[s] = rs; }
        }
        __syncthreads();
        {
            const int s = tid & 127, cq = tid >> 7;
            const float mu = mean[s], rs = rstd[s];
            for (int cc = 0; cc < 16; ++cc) {
                const int c = cq * 128 + cc * 8;
                float v[8]; unpack8(*(const uint4*)(vgg + (t0 + s) * 512 + c), v);
#pragma unroll
                for (int j = 0; j < 8; ++j) XT[(c + j) * 144 + s] = f2bf((v[j] - mu) * rs * p.sg_ln_w[c + j] + p.sg_ln_b[c + j]);
            }
        }
        __syncthreads();
        const int g = wid >> 1;
        const bf16_t* W = tw + (size_t)g * 128 * 128;
#pragma unroll
        for (int th = 0; th < 2; ++th) {
            f32x4 acc[4][4];
#pragma unroll
            for (int ci = 0; ci < 4; ++ci)
#pragma unroll
                for (int tt = 0; tt < 4; ++tt) acc[ci][tt] = (f32x4){0.f, 0.f, 0.f, 0.f};
#pragma unroll
            for (int ks = 0; ks < 4; ++ks) {
                if (ks <= 2 * th + 1) {
                    bf16x8 a[4], bw[4];
#pragma unroll
                    for (int ci = 0; ci < 4; ++ci) a[ci] = *(const bf16x8*)(XT + (64 * wid + (ci >> 1) * 32 + 8 * (fr >> 2) + (fr & 3) + 4 * (ci & 1)) * 144 + 32 * ks + 8 * fg);
#pragma unroll
                    for (int tt = 0; tt < 4; ++tt) bw[tt] = *(const bf16x8*)(W + (64 * th + 16 * tt + fr) * 128 + 32 * ks + 8 * fg);
#pragma unroll
                    for (int ci = 0; ci < 4; ++ci)
#pragma unroll
                        for (int tt = 0; tt < 4; ++tt)
                            if (2 * ks <= 4 * th + tt) acc[ci][tt] = __builtin_amdgcn_mfma_f32_16x16x32_bf16(a[ci], bw[tt], acc[ci][tt], 0, 0, 0);
                }
            }
#pragma unroll
            for (int pp = 0; pp < 2; ++pp)
#pragma unroll
                for (int tt = 0; tt < 4; ++tt) {
                    const int tl = 64 * th + 16 * tt + fr, c0 = 64 * wid + pp * 32 + 8 * fg;
                    const float bsv = p.sg_b[g * 128 + tl];
                    float u[8], o[8]; unpack8(*(const uint4*)(ug + (t0 + tl) * 512 + c0), u);
#pragma unroll
                    for (int j = 0; j < 4; ++j) { o[j] = u[j] * (acc[2 * pp][tt][j] + bsv); o[4 + j] = u[4 + j] * (acc[2 * pp + 1][tt][j] + bsv); }
                    *(uint4*)(ysg + (t0 + tl) * 512 + c0) = pack8(o);
                }
        }
    }
}

#define XB_TMO      128
#define XB_XCNT(j)  (256  + 64 * (j))
#define XB_XSUB(j)  (1280 + 64 * (j))
#define XB_XGEN(j)  (2304 + 64 * (j))
#define XB_TOP      3328
#define XB_TOPGEN   3392
#define XCD_BAR_WORDS 3456
#define XB_SPIN_CAP (1u << 18)
#define LAS __attribute__((address_space(3)))

__device__ __forceinline__ unsigned xb_ld(unsigned* p)              { return __hip_atomic_load(p, __ATOMIC_RELAXED, __HIP_MEMORY_SCOPE_AGENT); }
__device__ __forceinline__ unsigned xb_add(unsigned* p, unsigned v) { return __hip_atomic_fetch_add(p, v, __ATOMIC_RELAXED, __HIP_MEMORY_SCOPE_AGENT); }
__device__ __forceinline__ unsigned xb_xcc_id() { return (unsigned)__builtin_amdgcn_s_getreg((3 << 11) | 20) & 0xFu; }
#define XB_SPIN(cond, bar) do { unsigned _sp = 0; while (cond) { __builtin_amdgcn_s_sleep(1); \
    if ((++_sp & 255u) == 0u) { if (xb_ld(&(bar)[XB_TMO])) break; if (_sp > XB_SPIN_CAP) { atomicAdd(&(bar)[XB_TMO], 1u); break; } } } } while (0)

struct XcdBarrier {
    unsigned* bar; unsigned x;
    volatile LAS unsigned* st;
};

__device__ __forceinline__ XcdBarrier xcd_barrier_post(unsigned* bar, volatile LAS unsigned* st) {
    XcdBarrier b; b.bar = bar; b.x = xb_xcc_id(); b.st = st;
    if (threadIdx.x == 0) (void)xb_add(&bar[XB_XCNT(b.x)], 1u);
    return b;
}
__device__ __forceinline__ void xcd_barrier_complete(unsigned* bar, unsigned x, unsigned& nloc, unsigned& nx) {
    const unsigned G = gridDim.x * gridDim.y * gridDim.z;
    unsigned sum, cnt, mine, sp = 0u;
    for (;;) {
        sum = 0u; cnt = 0u; mine = 0u;
#pragma unroll
        for (unsigned j = 0; j < 16; ++j) { const unsigned c = xb_ld(&bar[XB_XCNT(j)]); sum += c; cnt += (c > 0u) ? 1u : 0u; mine = (j == x) ? c : mine; }
        if (sum == G) break;
        __builtin_amdgcn_s_sleep(1);
        if ((++sp & 255u) == 0u) { if (xb_ld(&bar[XB_TMO])) break; if (sp > XB_SPIN_CAP) { atomicAdd(&bar[XB_TMO], 1u); break; } }
    }
    nloc = mine > 0u ? mine : 1u; nx = cnt > 0u ? cnt : 1u;
}

__device__ __forceinline__ void xcd_barrier(const XcdBarrier& b) {
    asm volatile("s_waitcnt vmcnt(0)" ::: "memory");
    __syncthreads();
    if (threadIdx.x == 0) {
        unsigned* bar = b.bar;
        __builtin_amdgcn_s_waitcnt(0);
        unsigned nloc = b.st[0], nx = b.st[1];
        if (nloc == 0u) { xcd_barrier_complete(bar, b.x, nloc, nx); b.st[0] = nloc; b.st[1] = nx; }
        const unsigned old = xb_add(&bar[XB_XSUB(b.x)], 1u);
        const unsigned gen = old / nloc;
        if (old + 1u == (gen + 1u) * nloc) {
            __builtin_amdgcn_fence(__ATOMIC_RELEASE, "agent");
            asm volatile("s_waitcnt vmcnt(0)" ::: "memory");
            const unsigned og = xb_add(&bar[XB_TOP], 1u);
            const unsigned tg = og / nx;
            if (og + 1u == (tg + 1u) * nx) xb_add(&bar[XB_TOPGEN], 1u);
            else XB_SPIN(xb_ld(&bar[XB_TOPGEN]) == tg, bar);
            __builtin_amdgcn_fence(__ATOMIC_ACQUIRE, "agent");
            xb_add(&bar[XB_XGEN(b.x)], 1u);
            asm volatile("s_waitcnt vmcnt(0)" ::: "memory");
        } else {
            XB_SPIN(xb_ld(&bar[XB_XGEN(b.x)]) == gen, bar);
            __builtin_amdgcn_fence(__ATOMIC_ACQUIRE, "agent");
            asm volatile("s_waitcnt vmcnt(0)" ::: "memory");
        }
    }
    __syncthreads();
}


constexpr size_t OFF_BAR = 480 * MiB + 256 * 1024;
constexpr int LDS_BARW = 152 * 1024 - 16;

constexpr int NSTAGE = 15;
#ifndef NP2
#define NP2 1
#endif
#ifndef ABL2
#define ABL2 0
#endif
#ifndef NP3
#define NP3 1
#endif
#ifndef ABL3
#define ABL3 0
#endif
#ifndef NP7
#define NP7 1
#endif
#ifndef NP9
#define NP9 1
#endif
#ifndef NP10
#define NP10 1
#endif
constexpr int NSTG = 11;
template <int S> __device__ __forceinline__ void run_stage(const P& p, float* lds) {
    if constexpr (S == 0) { st_mod(p, lds); st_convert(p, lds); }
    else if constexpr (S == 1) st_hm(p, lds);
    else if constexpr (S == 2) {
#pragma nounroll
        for (int ps = 0; ps < NP2; ++ps) st_inproj_fast(p, (char*)lds, ps == NP2 - 1 ? 0 : ABL2);
    }
    else if constexpr (S == 3) {
#pragma nounroll
        for (int ps = 0; ps < NP3; ++ps) st_dnprep_fast(p, (char*)lds, ps == NP3 - 1 ? 0 : ABL3);
    }
    else if constexpr (S == 4) st_scan_l1(p, (char*)lds);
    else if constexpr (S == 5) {
        if (blockIdx.x < 8) st_scan_l2(p, (char*)lds);
        st_sg_fast(p, (char*)lds, blockIdx.x < 8 ? 248 + (int)blockIdx.x : (int)blockIdx.x - 8, 256);
    }
    else if constexpr (S == 6) st_scan_l3(p, (char*)lds);
    else if constexpr (S == 7) {
#pragma nounroll
        for (int ps = 0; ps < NP7; ++ps) st_post_fast(p, (char*)lds, ps == NP7 - 1);
    }
    else if constexpr (S == 8 || S == 9) {
#pragma nounroll
        for (int ps = 0; ps < (S == 9 ? NP9 : 1); ++ps) st_moe_fast(p, (char*)lds, S == 8 || ps == NP9 - 1, S == 8 ? 1 : 0);
    }
    else if constexpr (S == 10) {
#pragma nounroll
        for (int ps = 0; ps < NP10; ++ps) st_combine(p, ps == NP10 - 1, lds);
    }
}

constexpr int LDS_BYTES = 152 * 1024;

#if !MEGA
template <int S> __global__ void __launch_bounds__(NT) k_stage(P p) {
    extern __shared__ __attribute__((aligned(16))) float lds[];
    run_stage<S>(p, lds);
}
template <int S> static void launch_all(const P& p, int grid, hipStream_t stream) {
    if constexpr (S < NSTG) {
        (void)hipFuncSetAttribute((const void*)k_stage<S>, hipFuncAttributeMaxDynamicSharedMemorySize, LDS_BYTES);
        k_stage<S><<<grid, NT, LDS_BYTES, stream>>>(p);
        launch_all<S + 1>(p, grid, stream);
    }
}
#else
template <int S> __device__ __forceinline__ void run_from(const P& p, float* lds, const XcdBarrier& bar) {
    if constexpr (S < NSTG) {
        run_stage<S>(p, lds);
#ifdef PROBE_REPEAT
        if constexpr (S == PROBE_REPEAT) { xcd_barrier(bar); run_stage<S>(p, lds); }
#endif
        if constexpr (S < NSTG - 1) xcd_barrier(bar);
        run_from<S + 1>(p, lds, bar);
    }
}
__global__ void __launch_bounds__(NT) k_mega(P p) {
    extern __shared__ __attribute__((aligned(16))) float lds[];
    volatile LAS unsigned* st = (volatile LAS unsigned*)((LAS char*)lds + LDS_BARW);
    if (threadIdx.x == 0) { st[0] = 0u; st[1] = 0u; }
    __syncthreads();
    const XcdBarrier bar = xcd_barrier_post((unsigned*)(p.ws + OFF_BAR), st);
#if USE_CG_SYNC
    cg::this_grid().sync();
#endif
    run_from<0>(p, lds, bar);
}
#endif

extern "C" void kernel_launch(void* const* d_in, const int* in_sizes, int n_in, void* d_out, int out_size, void* d_ws, size_t ws_size,
                              hipStream_t stream) {
    if (n_in != 30 || out_size != T * D || ws_size < WS_NEED) {
        fprintf(stderr, "kernel_launch: unexpected problem (n_in %d, out %d, ws %zu)\n", n_in, out_size, ws_size);
        return;
    }
    P p{};
    const float** f = (const float**)&p;
    for (int i = 0; i < 30; ++i) f[i] = (const float*)d_in[i];
    p.out = (float*)d_out;
    p.ws = (char*)d_ws;
    static int grid = 0;
    if (!grid) {
        int dev = 0, cus = 0;
        (void)hipGetDevice(&dev);
        (void)hipDeviceGetAttribute(&cus, hipDeviceAttributeMultiprocessorCount, dev);
#if MEGA
        int per_cu = 0;
        (void)hipFuncSetAttribute((const void*)k_mega, hipFuncAttributeMaxDynamicSharedMemorySize, LDS_BYTES);
        (void)hipOccupancyMaxActiveBlocksPerMultiprocessor(&per_cu, (const void*)k_mega, NT, LDS_BYTES);
        if (per_cu < 1) per_cu = 1;
        if (per_cu > 1) per_cu = 1;
        grid = cus * per_cu;
#else
        grid = cus;
#endif
    }
#if MEGA
    (void)hipMemsetAsync((char*)d_ws + OFF_BAR, 0, XCD_BAR_WORDS * sizeof(unsigned), stream);
    void* args[] = {&p};
    hipError_t e = hipLaunchCooperativeKernel((const void*)k_mega, dim3(grid), dim3(NT), args, LDS_BYTES, stream);
    if (e != hipSuccess) fprintf(stderr, "cooperative launch failed: %s (grid %d)\n", hipGetErrorString(e), grid);
#else
    launch_all<0>(p, grid, stream);
#endif
}
```

```cpp
#include <hip/hip_runtime.h>
#include <hip/hip_cooperative_groups.h>
#include <cstdint>
#include <cstdio>
namespace cg = cooperative_groups;

#ifndef MEGA
#define MEGA 1
#endif
#ifndef USE_CG_SYNC
#define USE_CG_SYNC 1
#endif
#ifndef IN8
#define IN8 2
#endif

constexpr int D = 1024, NBATCH = 2, SEQ = 16384, T = NBATCH * SEQ;
constexpr int INCOLS = 3080;
constexpr int NE = 256, EH = 256;
constexpr int NT = 512;
constexpr int LCAP = 32768;

typedef unsigned short bf16_t;
__device__ __forceinline__ float bf2f(bf16_t v) { return __uint_as_float(((unsigned)v) << 16); }
__device__ __forceinline__ bf16_t f2bf(float f) { unsigned u = __float_as_uint(f); u += 0x7fffu + ((u >> 16) & 1u); return (bf16_t)(u >> 16); }

constexpr size_t MiB = 1024ull * 1024ull;
constexpr size_t OFF_HF     = 384 * MiB;
constexpr size_t OFF_WT_IN8 = 192 * MiB;
constexpr size_t OFF_HM8    = 160 * MiB;
constexpr size_t OFF_SHO    = 320 * MiB;
constexpr size_t OFF_HF8    = 128 * MiB;
constexpr size_t OFF_LISTS  = 448 * MiB;
constexpr size_t OFF_MOD    = 480 * MiB;
constexpr size_t OFF_CNT    = 480 * MiB + 64 * 1024;
constexpr size_t OFF_WAB    = 480 * MiB + 384 * 1024;
constexpr size_t OFF_G      = 481 * MiB;
constexpr size_t OFF_BETA   = 481 * MiB + 512 * 1024;
constexpr size_t OFF_WTS    = 482 * MiB;
constexpr size_t OFF_IDX    = 483 * MiB;
constexpr size_t OFF_CONTRIB= 512 * MiB;
constexpr size_t OFF_GATE   = 512 * MiB;
constexpr size_t OFF_ZS     = 640 * MiB;
constexpr size_t OFF_YSG    = 672 * MiB;
constexpr size_t OFF_O      = 704 * MiB;
constexpr size_t OFF_QKV    = 736 * MiB;
constexpr size_t OFF_UG     = 832 * MiB;
constexpr size_t OFF_VGG    = 864 * MiB;
constexpr size_t OFF_HM     = 896 * MiB;
constexpr size_t OFF_Y      = 800 * MiB;
constexpr size_t OFF_WT_GU  = 0;
constexpr size_t OFF_WT_D   = 256 * MiB;
constexpr size_t OFF_WT_IN  = 484 * MiB;
constexpr size_t OFF_WT_DN  = 494 * MiB;
constexpr size_t OFF_WT_SG  = 495 * MiB;
constexpr size_t OFF_WT_OUT = 496 * MiB;
constexpr size_t OFF_WT_RT  = 498 * MiB;
constexpr size_t OFF_WT_SHGU= 499 * MiB;
constexpr size_t OFF_WT_SHD = 500 * MiB;
constexpr size_t OFF_TRILW  = 501 * MiB;
constexpr size_t OFF_VC     = 960 * MiB;
constexpr size_t OFF_VGN    = 896 * MiB;
constexpr size_t OFF_SCORES = 832 * MiB;
constexpr size_t WS_NEED    = 1024 * MiB;

struct P {
    const float *x, *c, *ada_w, *ada_b, *mix_pre, *mix_post, *w_in, *conv_w, *a_log, *dt_bias, *dn_norm_w, *sg_ln_w, *sg_ln_b,
        *sg_w, *sg_b, *w_bg, *b_bg, *w_pdn, *w_psg, *w_out, *ffn_pre, *ffn_post, *w_router, *router_bias, *w_eg, *w_eu, *w_ed,
        *w_shg, *w_shu, *w_shd;
    float* out;
    char* ws;
};

__device__ __forceinline__ int tidx() { int t = threadIdx.x; asm volatile("" : "+v"(t)); return t; }
__device__ __forceinline__ float wave_sum(float v) {
#pragma unroll
    for (int o = 32; o > 0; o >>= 1) v += __shfl_xor(v, o);
    return v;
}
__device__ __forceinline__ float sigmoid_(float x) { return 1.f / (1.f + expf(-x)); }
__device__ __forceinline__ float silu_(float x) { return x / (1.f + expf(-x)); }
__device__ __forceinline__ float gelu_(float x) { return 0.5f * x * (1.f + erff(x * 0.70710678118654752f)); }
__device__ __forceinline__ float softplus_(float x) { return fmaxf(x, 0.f) + log1pf(expf(-fabsf(x))); }

typedef __bf16 bf2_t __attribute__((ext_vector_type(2)));
typedef float f2_t __attribute__((ext_vector_type(2)));
__device__ __forceinline__ unsigned pk2(float a, float b) { const f2_t v = {a, b}; return __builtin_bit_cast(unsigned, __builtin_convertvector(v, bf2_t)); }
__device__ __forceinline__ uint4 pack8(const float (&v)[8]) { return make_uint4(pk2(v[0], v[1]), pk2(v[2], v[3]), pk2(v[4], v[5]), pk2(v[6], v[7])); }

__device__ __forceinline__ void unpack8(const uint4 u, float (&o)[8]) {
    o[0] = __uint_as_float(u.x << 16); o[1] = __uint_as_float(u.x & 0xffff0000u); o[2] = __uint_as_float(u.y << 16); o[3] = __uint_as_float(u.y & 0xffff0000u);
    o[4] = __uint_as_float(u.z << 16); o[5] = __uint_as_float(u.z & 0xffff0000u); o[6] = __uint_as_float(u.w << 16); o[7] = __uint_as_float(u.w & 0xffff0000u);
}

__device__ __forceinline__ float wave_sum8(const float (&v)[8], int lane) {
    float a[4];
#pragma unroll
    for (int i = 0; i < 4; ++i) { const float keep = (lane & 32) ? v[4 + i] : v[i], send = (lane & 32) ? v[i] : v[4 + i]; a[i] = keep + __shfl_xor(send, 32); }
    float b[2];
#pragma unroll
    for (int i = 0; i < 2; ++i) { const float keep = (lane & 16) ? a[2 + i] : a[i], send = (lane & 16) ? a[i] : a[2 + i]; b[i] = keep + __shfl_xor(send, 16); }
    float c;
    { const float keep = (lane & 8) ? b[1] : b[0], send = (lane & 8) ? b[0] : b[1]; c = keep + __shfl_xor(send, 8); }
    c += __shfl_xor(c, 4); c += __shfl_xor(c, 2); c += __shfl_xor(c, 1);
    return c;
}

template <int TOK, class Epi>
__device__ __forceinline__ void ngemm(const float* As, int K, const float* __restrict__ W, int ldw, int ncols, Epi epi) {
    for (int n = tidx(); n < ncols; n += NT) {
        float acc[TOK];
#pragma unroll
        for (int i = 0; i < TOK; ++i) acc[i] = 0.f;
        const float* wp = W + n;
        for (int k = 0; k < K; k += 4) {
            const float w0 = wp[(size_t)k * ldw], w1 = wp[(size_t)(k + 1) * ldw], w2 = wp[(size_t)(k + 2) * ldw], w3 = wp[(size_t)(k + 3) * ldw];
#pragma unroll
            for (int i = 0; i < TOK; ++i) {
                const float4 a = *(const float4*)(As + i * K + k);
                acc[i] += a.x * w0 + a.y * w1 + a.z * w2 + a.w * w3;
            }
        }
#pragma unroll
        for (int i = 0; i < TOK; ++i) epi(i, n, acc[i]);
    }
}

__device__ void st_mod(const P& p, float* lds) {
    const int tid = tidx(), lane = tid & 63, wid = tid >> 6;
    const int gtid = blockIdx.x * NT + tid, gsz = gridDim.x * NT;
    float* mod = (float*)(p.ws + OFF_MOD);
    for (int task = blockIdx.x; task < 192; task += gridDim.x) {
        const int b = task / 96, j = (task % 96) * 64 + lane;
        float acc = 0.f;
        for (int k = wid * 128; k < wid * 128 + 128; ++k) acc += silu_(p.c[b * 1024 + k]) * p.ada_w[(size_t)k * 6144 + j];
        __syncthreads();
        lds[wid * 64 + lane] = acc;
        __syncthreads();
        if (wid == 0) {
            float s = p.ada_b[j];
#pragma unroll
            for (int w = 0; w < 8; ++w) s += lds[w * 64 + lane];
            mod[b * 6144 + j] = s;
        }
    }
    __syncthreads();
    unsigned* cnt = (unsigned*)(p.ws + OFF_CNT);
    for (int i = gtid; i < NE; i += gsz) cnt[i] = 0u;
    unsigned* zr = (unsigned*)(p.ws + 480 * MiB + 320 * 1024);
    for (int i = gtid; i < 1024; i += gsz) zr[i] = 0u;
    float* wab = (float*)(p.ws + OFF_WAB);
    for (int i = gtid; i < 8192; i += gsz) wab[i] = p.w_in[(size_t)(i & 1023) * INCOLS + 2048 + (i >> 10)];
}

__device__ void st_hm(const P& p, float* lds) {
    const int lane = tidx() & 63, gw = (blockIdx.x * NT + tidx()) >> 6, nw = (gridDim.x * NT) >> 6;
    const float* mod = (const float*)(p.ws + OFF_MOD);
    bf16_t* hm = (bf16_t*)(p.ws + OFF_HM);
    float* gb = (float*)(p.ws + OFF_G);
    float* bb = (float*)(p.ws + OFF_BETA);
    const float* wab = (const float*)(p.ws + OFF_WAB);
    float* lwab = lds;
    float* lA = lds + 8192;
    float* lB = lds + 8192 + 2048;
    __syncthreads();
    for (int i = tidx(); i < 8192; i += NT) lwab[i] = wab[i];
    for (int i = tidx(); i < 2048; i += NT) { const int b = i >> 10, k = i & 1023; lA[i] = p.mix_pre[k] * (1.f + mod[b * 6144 + 1024 + k]); lB[i] = mod[b * 6144 + k]; }
    __syncthreads();
    const int lane0 = lane;
    float4 vnx[4];
#pragma unroll
    for (int i = 0; i < 4; ++i) vnx[i] = (gw < T) ? *(const float4*)(p.x + (size_t)gw * D + i * 256 + lane0 * 4) : make_float4(0.f, 0.f, 0.f, 0.f);
    for (int t = gw; t < T; t += nw) {
        int lane = lane0; asm volatile("" : "+v"(lane));
        const int b = t / SEQ;
        float4 v[4];
        float ss = 0.f;
#pragma unroll
        for (int i = 0; i < 4; ++i) { v[i] = vnx[i]; ss += v[i].x * v[i].x + v[i].y * v[i].y + v[i].z * v[i].z + v[i].w * v[i].w; }
        if (t + nw < T) {
#pragma unroll
            for (int i = 0; i < 4; ++i) vnx[i] = *(const float4*)(p.x + (size_t)(t + nw) * D + i * 256 + lane * 4);
        }
        ss = wave_sum(ss);
        const float rstd = rsqrtf(ss * (1.f / 1024.f) + 1e-6f);
        float ab[8];
#pragma unroll
        for (int q = 0; q < 8; ++q) ab[q] = 0.f;
#pragma unroll
        for (int i = 0; i < 4; ++i) {
            const int k0 = i * 256 + lane * 4;
            const float xv[4] = {v[i].x, v[i].y, v[i].z, v[i].w};
            const float4 mw = *(const float4*)(lA + b * 1024 + k0), sh = *(const float4*)(lB + b * 1024 + k0);
            const float mwa[4] = {mw.x, mw.y, mw.z, mw.w}, sha[4] = {sh.x, sh.y, sh.z, sh.w};
            float h[4];
#pragma unroll
            for (int j = 0; j < 4; ++j) h[j] = xv[j] * rstd * mwa[j] + sha[j];
#pragma unroll
            for (int q = 0; q < 8; ++q) {
                const float4 w4 = *(const float4*)(lwab + q * 1024 + k0);
                ab[q] += h[0] * w4.x + h[1] * w4.y + h[2] * w4.z + h[3] * w4.w;
            }
            if (IN8) {
                int w8 = __builtin_amdgcn_cvt_pk_fp8_f32(h[0], h[1], 0, false); w8 = __builtin_amdgcn_cvt_pk_fp8_f32(h[2], h[3], w8, true);
                *(int*)(p.ws + OFF_HM8 + (size_t)t * D + k0) = w8;
            }
            { ushort4 o; o.x = f2bf(h[0]); o.y = f2bf(h[1]); o.z = f2bf(h[2]); o.w = f2bf(h[3]);
              *(ushort4*)(hm + (size_t)t * D + k0) = o; }
        }
        {
            const float tot = wave_sum8(ab, lane);
            const int q = ((lane >> 5) & 1) * 4 + ((lane >> 4) & 1) * 2 + ((lane >> 3) & 1);
            if ((lane & 7) == 0) {
                if (q < 4) gb[t * 4 + q] = -expf(p.a_log[q]) * softplus_(tot + p.dt_bias[q]);
                else bb[t * 4 + (q - 4)] = sigmoid_(tot);
            }
        }
    }
}

__device__ void st_inproj_naive(const P& p, float* lds) {
    const bf16_t* hm = (const bf16_t*)(p.ws + OFF_HM);
    bf16_t* qkv = (bf16_t*)(p.ws + OFF_QKV); bf16_t* zs = (bf16_t*)(p.ws + OFF_ZS); bf16_t* ug = (bf16_t*)(p.ws + OFF_UG);
    bf16_t* vgg = (bf16_t*)(p.ws + OFF_VGG); bf16_t* gate = (bf16_t*)(p.ws + OFF_GATE);
    for (int tile = blockIdx.x; tile < T / 16; tile += gridDim.x) {
        const int t0 = tile * 16;
        __syncthreads();
        for (int i = tidx(); i < 16 * D; i += NT) lds[i] = bf2f(hm[(size_t)t0 * D + i]);
        __syncthreads();
        ngemm<16>(lds, D, p.w_in, INCOLS, INCOLS, [&](int i, int n, float acc) {
            const size_t t = t0 + i;
            if (n < 1536) qkv[t * 1536 + n] = f2bf(acc);
            else if (n < 2048) zs[t * 512 + (n - 1536)] = f2bf(silu_(acc));
            else if (n < 2056) {}
            else if (n < 2568) ug[t * 512 + (n - 2056)] = f2bf(gelu_(acc));
            else vgg[t * 512 + (n - 2568)] = f2bf(gelu_(acc));
        });
        ngemm<16>(lds, D, p.w_bg, 2048, 2048, [&](int i, int n, float acc) {
            gate[(size_t)(t0 + i) * 2048 + n] = f2bf(sigmoid_(acc + p.b_bg[n]));
        });
    }
}

__device__ void st_dnprep_naive(const P& p) {
    const int lane = tidx() & 63, gw = (blockIdx.x * NT + tidx()) >> 6, nw = (gridDim.x * NT) >> 6;
    const bf16_t* qkv = (const bf16_t*)(p.ws + OFF_QKV);
    float* qn = (p.out); float* kn = (p.out + (size_t)T * 512); float* vc = (float*)(p.ws + OFF_VC);
    for (int u = gw; u < T * 4; u += nw) {
        const int t = u >> 2, h = u & 3, s = t % SEQ;
        float r[3][2];
#pragma unroll
        for (int part = 0; part < 3; ++part)
#pragma unroll
            for (int j = 0; j < 2; ++j) {
                const int col = part * 512 + h * 128 + lane * 2 + j;
                float y = 0.f;
#pragma unroll
                for (int i = 0; i < 4; ++i) {
                    const int sp = s - 3 + i;
                    if (sp >= 0) y += bf2f(qkv[(size_t)(t - 3 + i) * 1536 + col]) * p.conv_w[i * 1536 + col];
                }
                r[part][j] = silu_(y);
            }
        const float qs = wave_sum(r[0][0] * r[0][0] + r[0][1] * r[0][1]);
        const float ks = wave_sum(r[1][0] * r[1][0] + r[1][1] * r[1][1]);
        const float qsc = rsqrtf(qs + 1e-6f) * 0.08838834764831845f, ksc = rsqrtf(ks + 1e-6f);
        const size_t o = (size_t)t * 512 + h * 128 + lane * 2;
        *(float2*)(qn + o) = make_float2(r[0][0] * qsc, r[0][1] * qsc);
        *(float2*)(kn + o) = make_float2(r[1][0] * ksc, r[1][1] * ksc);
        *(float2*)(vc + o) = make_float2(r[2][0], r[2][1]);
    }
}

__device__ void st_dnrec_naive(const P& p) {
    const int lane = tidx() & 63, gw = (blockIdx.x * NT + tidx()) >> 6, nw = (gridDim.x * NT) >> 6;
    const float* qn = (p.out); const float* kn = (p.out + (size_t)T * 512); const float* vc = (const float*)(p.ws + OFF_VC);
    const float* gb = (const float*)(p.ws + OFF_G); const float* bb = (const float*)(p.ws + OFF_BETA);
    bf16_t* ob = (bf16_t*)(p.ws + OFF_O);
    for (int u = gw; u < NBATCH * 4 * 128; u += nw) {
        const int b = u >> 9, h = (u >> 7) & 3, vcol = u & 127;
        float S0 = 0.f, S1 = 0.f;
        size_t t = (size_t)b * SEQ;
        float2 kk = *(const float2*)(kn + t * 512 + h * 128 + 2 * lane);
        float2 qq = *(const float2*)(qn + t * 512 + h * 128 + 2 * lane);
        float vv = vc[t * 512 + h * 128 + vcol], g = gb[t * 4 + h], be = bb[t * 4 + h];
        for (int s = 0; s < SEQ; ++s, ++t) {
            float2 kk2 = kk, qq2 = qq; float vv2 = vv, g2 = g, be2 = be;
            if (s + 1 < SEQ) {
                const size_t tn = t + 1;
                kk2 = *(const float2*)(kn + tn * 512 + h * 128 + 2 * lane);
                qq2 = *(const float2*)(qn + tn * 512 + h * 128 + 2 * lane);
                vv2 = vc[tn * 512 + h * 128 + vcol]; g2 = gb[tn * 4 + h]; be2 = bb[tn * 4 + h];
            }
            const float a = expf(g);
            const float dk = wave_sum(kk.x * S0 + kk.y * S1);
            const float dq = wave_sum(qq.x * S0 + qq.y * S1);
            const float qk = wave_sum(qq.x * kk.x + qq.y * kk.y);
            const float vnew = be * (vv - a * dk);
            const float o = a * dq + qk * vnew;
            S0 = a * S0 + kk.x * vnew; S1 = a * S1 + kk.y * vnew;
            if (lane == 0) ob[t * 512 + h * 128 + vcol] = f2bf(o);
            kk = kk2; qq = qq2; vv = vv2; g = g2; be = be2;
        }
    }
}

__device__ void st_sgln_naive(const P& p) {
    const int lane = tidx() & 63, gw = (blockIdx.x * NT + tidx()) >> 6, nw = (gridDim.x * NT) >> 6;
    const bf16_t* vgg = (const bf16_t*)(p.ws + OFF_VGG);
    float* vgn = (float*)(p.ws + OFF_VGN);
    for (int t = gw; t < T; t += nw) {
        float v[8]; float s = 0.f;
#pragma unroll
        for (int j = 0; j < 8; ++j) { v[j] = bf2f(vgg[(size_t)t * 512 + j * 64 + lane]); s += v[j]; }
        const float mu = wave_sum(s) * (1.f / 512.f);
        float q = 0.f;
#pragma unroll
        for (int j = 0; j < 8; ++j) { const float d = v[j] - mu; q += d * d; }
        const float rstd = rsqrtf(wave_sum(q) * (1.f / 512.f) + 1e-6f);
#pragma unroll
        for (int j = 0; j < 8; ++j) { const int c = j * 64 + lane; vgn[(size_t)t * 512 + c] = (v[j] - mu) * rstd * p.sg_ln_w[c] + p.sg_ln_b[c]; }
    }
}
__device__ void st_sgmix_naive(const P& p) {
    const int gtid = blockIdx.x * NT + tidx(), gsz = gridDim.x * NT;
    const float* vgn = (const float*)(p.ws + OFF_VGN);
    const bf16_t* ug = (const bf16_t*)(p.ws + OFF_UG);
    bf16_t* ysg = (bf16_t*)(p.ws + OFF_YSG);
    for (int i = gtid; i < T * 512; i += gsz) {
        const int t = i >> 9, c = i & 511, g = c >> 7, tt = t & 127, t0 = t - tt;
        const float* w = p.sg_w + ((size_t)g * 128 + tt) * 128;
        float acc = p.sg_b[g * 128 + tt];
        for (int s = 0; s <= tt; ++s) acc += w[s] * vgn[(size_t)(t0 + s) * 512 + c];
        ysg[i] = f2bf(bf2f(ug[i]) * acc);
    }
}

__device__ __forceinline__ void ydn_unit(const P& p, int u, int lane) {
    bf16_t* ob = (bf16_t*)(p.ws + OFF_O); const bf16_t* zs = (const bf16_t*)(p.ws + OFF_ZS);
    const size_t base = (size_t)(u >> 2) * 512 + (u & 3) * 128 + lane * 2;
    const float o0 = bf2f(ob[base]), o1 = bf2f(ob[base + 1]);
    const float rstd = rsqrtf(wave_sum(o0 * o0 + o1 * o1) * (1.f / 128.f) + 1e-6f);
    ob[base] = f2bf(o0 * rstd * p.dn_norm_w[lane * 2] * bf2f(zs[base]));
    ob[base + 1] = f2bf(o1 * rstd * p.dn_norm_w[lane * 2 + 1] * bf2f(zs[base + 1]));
}
__device__ __forceinline__ void ydn_token(const P& p, int t, int lane) {
    bf16_t* ob = (bf16_t*)(p.ws + OFF_O); const bf16_t* zs = (const bf16_t*)(p.ws + OFF_ZS);
    const float2 nw = *(const float2*)(p.dn_norm_w + lane * 2);
    unsigned ov[4], zv[4]; float ss[4];
#pragma unroll
    for (int h = 0; h < 4; ++h) { const size_t base = (size_t)t * 512 + h * 128 + lane * 2; ov[h] = *(const unsigned*)(ob + base); zv[h] = *(const unsigned*)(zs + base); }
#pragma unroll
    for (int h = 0; h < 4; ++h) { const float o0 = __uint_as_float(ov[h] << 16), o1 = __uint_as_float(ov[h] & 0xffff0000u); ss[h] = o0 * o0 + o1 * o1; }
#pragma unroll
    for (int o = 32; o > 0; o >>= 1) {
#pragma unroll
        for (int h = 0; h < 4; ++h) ss[h] += __shfl_xor(ss[h], o);
    }
#pragma unroll
    for (int h = 0; h < 4; ++h) {
        const float rstd = rsqrtf(ss[h] * (1.f / 128.f) + 1e-6f);
        const float o0 = __uint_as_float(ov[h] << 16), o1 = __uint_as_float(ov[h] & 0xffff0000u);
        *(unsigned*)(ob + (size_t)t * 512 + h * 128 + lane * 2) = pk2(o0 * rstd * nw.x * __uint_as_float(zv[h] << 16), o1 * rstd * nw.y * __uint_as_float(zv[h] & 0xffff0000u));
    }
}
__device__ void st_ydn_naive(const P& p) {
    const int lane = tidx() & 63, gw = (blockIdx.x * NT + tidx()) >> 6, nw = (gridDim.x * NT) >> 6;
    for (int u = gw; u < T * 4; u += nw) ydn_unit(p, u, lane);
}
__device__ void st_merged_naive(const P& p, float* lds) {
    const bf16_t* ydn = (const bf16_t*)(p.ws + OFF_O); const bf16_t* ysg = (const bf16_t*)(p.ws + OFF_YSG);
    const bf16_t* gate = (const bf16_t*)(p.ws + OFF_GATE);
    float* mg = (p.out);
    float* A1 = lds; float* A2 = lds + 16 * 512;
    for (int tile = blockIdx.x; tile < T / 16; tile += gridDim.x) {
        const int t0 = tile * 16;
        __syncthreads();
        for (int i = tidx(); i < 16 * 512; i += NT) { A1[i] = bf2f(ydn[(size_t)t0 * 512 + i]); A2[i] = bf2f(ysg[(size_t)t0 * 512 + i]); }
        __syncthreads();
        ngemm<16>(A1, 512, p.w_pdn, D, D, [&](int i, int n, float acc) { const size_t t = t0 + i; mg[t * D + n] = bf2f(gate[t * 2048 + n]) * acc; });
        ngemm<16>(A2, 512, p.w_psg, D, D, [&](int i, int n, float acc) { const size_t t = t0 + i; mg[t * D + n] += bf2f(gate[t * 2048 + 1024 + n]) * acc; });
    }
}
__device__ void st_wout_naive(const P& p, float* lds) {
    const float* mg = (p.out);
    float* y = (float*)(p.ws + OFF_Y);
    for (int tile = blockIdx.x; tile < T / 16; tile += gridDim.x) {
        const int t0 = tile * 16;
        __syncthreads();
        for (int i = tidx(); i < 16 * D; i += NT) lds[i] = mg[(size_t)t0 * D + i];
        __syncthreads();
        ngemm<16>(lds, D, p.w_out, D, D, [&](int i, int n, float acc) { y[(size_t)(t0 + i) * D + n] = acc; });
    }
}
__device__ __forceinline__ void x1hf_row(const P& p, int t, int lane, const float* lv) {
    const bf16_t* y = (const bf16_t*)(p.ws + OFF_Y);
    bf16_t* hf = (bf16_t*)(p.ws + OFF_HF);
    float4 yv[4]; float ss = 0.f;
#pragma unroll
    for (int i = 0; i < 4; ++i) {
        const uint2 u = *(const uint2*)(y + (size_t)t * D + i * 256 + lane * 4);
        yv[i] = make_float4(__uint_as_float(u.x << 16), __uint_as_float(u.x & 0xffff0000u), __uint_as_float(u.y << 16), __uint_as_float(u.y & 0xffff0000u));
        ss += yv[i].x * yv[i].x + yv[i].y * yv[i].y + yv[i].z * yv[i].z + yv[i].w * yv[i].w;
    }
    float4 xv[4];
#pragma unroll
    for (int i = 0; i < 4; ++i) xv[i] = *(const float4*)(p.x + (size_t)t * D + i * 256 + lane * 4);
    const float rstd = rsqrtf(wave_sum(ss) * (1.f / 1024.f) + 1e-6f);
    float4 x1[4]; float s2 = 0.f;
#pragma unroll
    for (int i = 0; i < 4; ++i) {
        const int k0 = i * 256 + lane * 4;
        const float4 gm = *(const float4*)(lv + k0);
        float4 v;
        v.x = xv[i].x + gm.x * (yv[i].x * rstd); v.y = xv[i].y + gm.y * (yv[i].y * rstd);
        v.z = xv[i].z + gm.z * (yv[i].z * rstd); v.w = xv[i].w + gm.w * (yv[i].w * rstd);
        x1[i] = v; s2 += v.x * v.x + v.y * v.y + v.z * v.z + v.w * v.w;
        *(float4*)(p.out + (size_t)t * D + k0) = v;
    }
    const float rstd2 = rsqrtf(wave_sum(s2) * (1.f / 1024.f) + 1e-6f);
#pragma unroll
    for (int i = 0; i < 4; ++i) {
        const int k0 = i * 256 + lane * 4;
        const float4 fp = *(const float4*)(lv + 1024 + k0), sh = *(const float4*)(lv + 2048 + k0);
        const float h0 = x1[i].x * rstd2 * fp.x + sh.x, h1 = x1[i].y * rstd2 * fp.y + sh.y;
        const float h2 = x1[i].z * rstd2 * fp.z + sh.z, h3 = x1[i].w * rstd2 * fp.w + sh.w;
        uint2 o;
        o.x = pk2(h0, h1); o.y = pk2(h2, h3);
        *(uint2*)(hf + (size_t)t * D + k0) = o;
        int w8 = __builtin_amdgcn_cvt_pk_fp8_f32(h0, h1, 0, false); w8 = __builtin_amdgcn_cvt_pk_fp8_f32(h2, h3, w8, true);
        *(int*)(p.ws + OFF_HF8 + (size_t)t * D + k0) = w8;
    }
}
__device__ void st_router_naive(const P& p, float* lds) {
    const bf16_t* hf = (const bf16_t*)(p.ws + OFF_HF);
    float* sc = (float*)(p.ws + OFF_SCORES);
    for (int tile = blockIdx.x; tile < T / 16; tile += gridDim.x) {
        const int t0 = tile * 16;
        __syncthreads();
        for (int i = tidx(); i < 16 * D; i += NT) lds[i] = bf2f(hf[(size_t)t0 * D + i]);
        __syncthreads();
        ngemm<16>(lds, D, p.w_router, NE, NE, [&](int i, int n, float acc) { sc[(size_t)(t0 + i) * NE + n] = sigmoid_(acc); });
    }
}
__device__ void st_topk_naive(const P& p) {
    const int gtid = blockIdx.x * NT + tidx(), gsz = gridDim.x * NT;
    const float* sc = (const float*)(p.ws + OFF_SCORES);
    unsigned* cnt = (unsigned*)(p.ws + OFF_CNT);
    int* lists = (int*)(p.ws + OFF_LISTS);
    float* wts = (float*)(p.ws + OFF_WTS); int* idxo = (int*)(p.ws + OFF_IDX);
    for (int t = gtid; t < T; t += gsz) {
        const float* s = sc + (size_t)t * NE;
        float gs[8];
#pragma unroll
        for (int g = 0; g < 8; ++g) {
            float m1 = -INFINITY, m2 = -INFINITY;
            for (int j = 0; j < 32; ++j) { const float v = s[g * 32 + j] + p.router_bias[g * 32 + j]; if (v > m1) { m2 = m1; m1 = v; } else if (v > m2) m2 = v; }
            gs[g] = m1 + m2;
        }
        unsigned gmask = 0;
#pragma unroll
        for (int g = 0; g < 8; ++g) {
            int rank = 0;
#pragma unroll
            for (int h = 0; h < 8; ++h) rank += (gs[h] > gs[g] || (gs[h] == gs[g] && h < g)) ? 1 : 0;
            if (rank < 4) gmask |= 1u << g;
        }
        float pv = INFINITY; int pi = -1;
        int sel[8]; float sw[8]; float wsum = 0.f;
#pragma unroll
        for (int k = 0; k < 8; ++k) {
            float bv = -INFINITY; int bi = 0;
            for (int e = 0; e < NE; ++e) {
                if (!((gmask >> (e >> 5)) & 1u)) continue;
                const float v = s[e] + p.router_bias[e];
                const bool elig = (v < pv) || (v == pv && e > pi);
                if (elig && v > bv) { bv = v; bi = e; }
            }
            pv = bv; pi = bi; sel[k] = bi; sw[k] = s[bi]; wsum += sw[k];
        }
        const float inv = 2.5f / wsum;
#pragma unroll
        for (int k = 0; k < 8; ++k) {
            const int e = sel[k];
            const unsigned pos = atomicAdd(&cnt[e], 1u);
            lists[(size_t)e * LCAP + pos] = t * 8 + k;
            wts[t * 8 + k] = sw[k] * inv; idxo[t * 8 + k] = e;
        }
    }
}

__device__ void st_shared_naive(const P& p, float* lds) {
    const bf16_t* hf = (const bf16_t*)(p.ws + OFF_HF);
    bf16_t* contrib = (bf16_t*)(p.ws + OFF_CONTRIB);
    float* A = lds; float* G = lds + 16 * D; float* H = G + 16 * EH;
    for (int tile = blockIdx.x; tile < T / 16; tile += gridDim.x) {
        const int t0 = tile * 16;
        __syncthreads();
        for (int i = tidx(); i < 16 * D; i += NT) A[i] = bf2f(hf[(size_t)t0 * D + i]);
        __syncthreads();
        ngemm<16>(A, D, p.w_shg, EH, EH, [&](int i, int n, float acc) { G[i * EH + n] = acc; });
        ngemm<16>(A, D, p.w_shu, EH, EH, [&](int i, int n, float acc) { H[i * EH + n] = silu_(G[i * EH + n]) * acc; });
        __syncthreads();
        ngemm<16>(H, EH, p.w_shd, D, D, [&](int i, int n, float acc) { contrib[((size_t)(t0 + i) * 8) * D + n] = f2bf(acc); });
    }
}
__device__ void st_experts_naive(const P& p, float* lds) {
    const bf16_t* hf = (const bf16_t*)(p.ws + OFF_HF);
    bf16_t* contrib = (bf16_t*)(p.ws + OFF_CONTRIB);
    const unsigned* cnt = (const unsigned*)(p.ws + OFF_CNT);
    const int* lists = (const int*)(p.ws + OFF_LISTS);
    const float* wts = (const float*)(p.ws + OFF_WTS);
    float* A = lds; float* G = lds + 16 * D; float* H = G + 16 * EH;
    int* ent = (int*)(H + 16 * EH);
    int* tstart = ent + 16;
    __syncthreads();
    if (tidx() == 0) { int acc = 0; for (int e = 0; e < NE; ++e) { tstart[e] = acc; acc += ((int)cnt[e] + 15) >> 4; } tstart[NE] = acc; }
    __syncthreads();
    const int ntiles = tstart[NE];
    int e = 0;
    for (int tile = blockIdx.x; tile < ntiles; tile += gridDim.x) {
        while (tstart[e + 1] <= tile) ++e;
        const int r0 = (tile - tstart[e]) * 16, ce = (int)cnt[e];
        __syncthreads();
        if (tidx() < 16) ent[tidx()] = (r0 + (int)tidx() < ce) ? lists[(size_t)e * LCAP + r0 + tidx()] : -1;
        __syncthreads();
        for (int i = tidx(); i < 16 * D; i += NT) { const int en = ent[i >> 10]; A[i] = en >= 0 ? bf2f(hf[(size_t)(en >> 3) * D + (i & 1023)]) : 0.f; }
        __syncthreads();
        ngemm<16>(A, D, p.w_eg + (size_t)e * D * EH, EH, EH, [&](int i, int n, float acc) { G[i * EH + n] = acc; });
        ngemm<16>(A, D, p.w_eu + (size_t)e * D * EH, EH, EH, [&](int i, int n, float acc) { H[i * EH + n] = silu_(G[i * EH + n]) * acc; });
        __syncthreads();
        ngemm<16>(H, EH, p.w_ed + (size_t)e * EH * D, D, D, [&](int i, int n, float acc) {
            const int en = ent[i];
            if (en >= 0) {
                float v = acc * wts[en];
                bf16_t* dst = contrib + (size_t)en * D + n;
                if ((en & 7) == 0) v += bf2f(*dst);
                *dst = f2bf(v);
            }
        });
    }
}
constexpr float C8_SCALE = 16.f, C8_INV = 1.f / 16.f;
__device__ void st_combine(const P& p, bool fin, float* lds) {
    const int lane0 = tidx() & 63, gw = (blockIdx.x * NT + tidx()) >> 6, nw = (gridDim.x * NT) >> 6;
    const float* mod = (const float*)(p.ws + OFF_MOD);
    const unsigned char* contrib = (const unsigned char*)(p.ws + OFF_CONTRIB);
    __syncthreads();
    for (int i = tidx(); i < 2048; i += NT) lds[i] = mod[(i >> 10) * 6144 + 5120 + (i & 1023)] * p.ffn_post[i & 1023];
    __syncthreads();
    for (int t = gw; t < T; t += nw) {
        int lane = lane0; asm volatile("" : "+v"(lane));
        const int b = t / SEQ;
        uint4 cv[8];
#pragma unroll
        for (int k = 0; k < 8; ++k) cv[k] = *(const uint4*)(contrib + ((size_t)t * 8 + k) * D + lane * 16);
        const bf16_t* sr = (const bf16_t*)(p.ws + OFF_SHO) + (size_t)t * D + lane * 16;
        const uint4 s0 = *(const uint4*)sr, s1 = *(const uint4*)(sr + 8);
        float4 xv[4];
#pragma unroll
        for (int q = 0; q < 4; ++q) xv[q] = *(const float4*)(p.out + (size_t)t * D + lane * 16 + q * 4);
        float y[16], r[16];
#pragma unroll
        for (int i = 0; i < 16; ++i) r[i] = 0.f;
#pragma unroll
        for (int k = 0; k < 8; ++k) {
            const unsigned w[4] = {cv[k].x, cv[k].y, cv[k].z, cv[k].w};
#pragma unroll
            for (int q = 0; q < 4; ++q) {
                const auto lo = __builtin_amdgcn_cvt_pk_f32_fp8((int)w[q], false), hi = __builtin_amdgcn_cvt_pk_f32_fp8((int)w[q], true);
                r[q * 4] += lo[0]; r[q * 4 + 1] += lo[1]; r[q * 4 + 2] += hi[0]; r[q * 4 + 3] += hi[1];
            }
        }
        { float v8[8]; unpack8(s0, v8);
#pragma unroll
          for (int j = 0; j < 8; ++j) y[j] = v8[j] + r[j] * C8_INV;
          unpack8(s1, v8);
#pragma unroll
          for (int j = 0; j < 8; ++j) y[8 + j] = v8[j] + r[8 + j] * C8_INV; }
        float ss = 0.f;
#pragma unroll
        for (int i = 0; i < 16; ++i) ss += y[i] * y[i];
        const float rstd = rsqrtf(wave_sum(ss) * (1.f / 1024.f) + 1e-6f);
#pragma unroll
        for (int q = 0; q < 4; ++q) {
            const int k0 = lane * 16 + q * 4;
            const float4 g2 = *(const float4*)(lds + b * 1024 + k0);
            float4 o = xv[q];
            o.x += g2.x * (y[q * 4] * rstd); o.y += g2.y * (y[q * 4 + 1] * rstd);
            o.z += g2.z * (y[q * 4 + 2] * rstd); o.w += g2.w * (y[q * 4 + 3] * rstd);
            if (fin) *(float4*)(p.out + (size_t)t * D + k0) = o;
            else if (o.x == 12345.678f) *(float4*)(p.out + (size_t)t * D + k0) = o;
        }
    }
}

typedef short bf16x8 __attribute__((ext_vector_type(8)));
typedef float f32x4 __attribute__((ext_vector_type(4)));

__device__ __forceinline__ float fexp_(float x) { return __builtin_amdgcn_exp2f(x * 1.4426950408889634f); }
__device__ __forceinline__ float fsigmoid_(float x) { return __builtin_amdgcn_rcpf(1.f + fexp_(-x)); }
__device__ __forceinline__ float fsilu_(float x) { return x * fsigmoid_(x); }
__device__ __forceinline__ float fgelu_(float v) {
    const float av = fabsf(v), t = __builtin_amdgcn_rcpf(av * 0.2316418882f + 1.0f);
    float q = t * 0.5307027145f + (-0.7265760135f); q = q * t + 0.7107068705f; q = q * t + (-0.142248368f); q = q * t + 0.127414796f; q = q * t;
    const float e = __builtin_amdgcn_exp2f((v * v) * (-0.72134752044f));
    const float m = v * (q * e);
    return v < 0.f ? m : v - m;
}

constexpr float W8_SCALE = 32.f, W8_INV = 1.f / 32.f;
struct CTile { const float* src; char* dst; int ld, ldd, esz; };
__device__ __forceinline__ CTile conv_decode(const P& p, int id) {
    const int NDENSE = 2048;
    const float* src; int ld, K, cb, kt, colbase = 0, esz = 2; char* dst; int drow0;
    if (id < NDENSE) {
        int r = id;
        if (r < 512) { src = p.w_in; ld = INCOLS; K = 1024; cb = r >> 3; kt = r & 7; dst = p.ws + (IN8 == 2 ? OFF_WT_IN8 : OFF_WT_IN); drow0 = cb * 32; esz = IN8 == 2 ? 1 : 2; }
        else if ((r -= 512) < 256) { src = p.w_in; ld = INCOLS; K = 1024; cb = r >> 3; kt = r & 7; colbase = 2056; dst = p.ws + (IN8 ? OFF_WT_IN8 : OFF_WT_IN); drow0 = 2048 + cb * 32; esz = IN8 ? 1 : 2; }
        else if ((r -= 256) < 512) { src = p.w_bg; ld = 2048; K = 1024; cb = r >> 3; kt = r & 7; dst = p.ws + (IN8 ? OFF_WT_IN8 : OFF_WT_IN); drow0 = 3072 + cb * 32; esz = IN8 ? 1 : 2; }
        else if ((r -= 512) < 128) { src = p.w_pdn; ld = 1024; K = 512; cb = r >> 2; kt = r & 3; dst = p.ws + OFF_WT_DN; drow0 = cb * 32; }
        else if ((r -= 128) < 128) { src = p.w_psg; ld = 1024; K = 512; cb = r >> 2; kt = r & 3; dst = p.ws + OFF_WT_SG; drow0 = cb * 32; }
        else if ((r -= 128) < 256) { src = p.w_out; ld = 1024; K = 1024; cb = r >> 3; kt = r & 7; dst = p.ws + OFF_WT_OUT; drow0 = cb * 32; }
        else if ((r -= 256) < 64) { src = p.w_router; ld = 256; K = 1024; cb = r >> 3; kt = r & 7; dst = p.ws + OFF_WT_RT; drow0 = cb * 32; }
        else if ((r -= 64) < 128) { const int pp = r >> 6; r &= 63; src = pp ? p.w_shu : p.w_shg; ld = 256; K = 1024; cb = r >> 3; kt = r & 7; dst = p.ws + OFF_WT_SHGU; drow0 = (cb >> 2) * 256 + (cb & 3) * 64 + pp * 32; esz = 1; }
        else { r -= 128; src = p.w_shd; ld = 1024; K = 256; cb = r >> 1; kt = r & 1; dst = p.ws + OFF_WT_SHD; drow0 = cb * 32; esz = 1; }
    } else {
        const int r = id - NDENSE, m = r / (256 * 64), e = (r >> 6) & 255, tl = r & 63;
        esz = 1;
        if (m < 2) { src = (m ? p.w_eu : p.w_eg) + (size_t)e * 1024 * 256; ld = 256; K = 1024; cb = tl >> 3; kt = tl & 7;
                     dst = p.ws + OFF_WT_GU + (size_t)e * 512 * 1024; drow0 = (cb >> 2) * 256 + (cb & 3) * 64 + m * 32; }
        else { src = p.w_ed + (size_t)e * 256 * 1024; ld = 1024; K = 256; cb = tl >> 1; kt = tl & 1; dst = p.ws + OFF_WT_D + (size_t)e * 1024 * 256; drow0 = cb * 32; }
    }
    CTile t; t.src = src + (size_t)(kt * 128) * ld + colbase + cb * 32; t.dst = dst + ((size_t)drow0 * K + kt * 128) * esz; t.ld = ld; t.ldd = K * esz; t.esz = esz;
    return t;
}
__device__ __forceinline__ uint2 pack8_fp8(const float (&v)[8]) {
    int w0 = __builtin_amdgcn_cvt_pk_fp8_f32(v[0], v[1], 0, false); w0 = __builtin_amdgcn_cvt_pk_fp8_f32(v[2], v[3], w0, true);
    int w1 = __builtin_amdgcn_cvt_pk_fp8_f32(v[4], v[5], 0, false); w1 = __builtin_amdgcn_cvt_pk_fp8_f32(v[6], v[7], w1, true);
    return make_uint2((unsigned)w0, (unsigned)w1);
}
__device__ void st_convert(const P& p, float* lds) {
    const int tid = tidx();
    const int NTOT = 2048 + 3 * 256 * 64;
    float4 v[4][2];
    auto issue = [&](int base) {
#pragma unroll
        for (int j = 0; j < 4; ++j) {
            const CTile t = conv_decode(p, base + j);
#pragma unroll
            for (int i = 0; i < 2; ++i) v[j][i] = *(const float4*)(t.src + (size_t)((tid >> 3) + 64 * i) * t.ld + (tid & 7) * 4);
        }
    };
    if (blockIdx.x * 4 < NTOT) issue(blockIdx.x * 4);
    for (int base = blockIdx.x * 4; base < NTOT; base += gridDim.x * 4) {
        __syncthreads();
#pragma unroll
        for (int j = 0; j < 4; ++j)
#pragma unroll
            for (int i = 0; i < 2; ++i) {
                float* d = lds + j * (128 * 33) + ((tid >> 3) + 64 * i) * 33 + (tid & 7) * 4;
                d[0] = v[j][i].x; d[1] = v[j][i].y; d[2] = v[j][i].z; d[3] = v[j][i].w;
            }
        __syncthreads();
        if (base + (int)gridDim.x * 4 < NTOT) issue(base + gridDim.x * 4);
#pragma unroll
        for (int j = 0; j < 4; ++j) {
            const CTile t = conv_decode(p, base + j);
            const int n = tid >> 4, kc = tid & 15;
            float o[8];
#pragma unroll
            for (int q = 0; q < 8; ++q) o[q] = lds[j * (128 * 33) + (kc * 8 + q) * 33 + n];
            if (t.esz == 2) *(uint4*)(t.dst + (size_t)n * t.ldd + kc * 16) = pack8(o);
            else {
#pragma unroll
                for (int q = 0; q < 8; ++q) o[q] *= W8_SCALE;
                *(uint2*)(t.dst + (size_t)n * t.ldd + kc * 8) = pack8_fp8(o);
            }
        }
    }
    __syncthreads();
    bf16_t* tw = (bf16_t*)(p.ws + OFF_TRILW);
    for (int i = blockIdx.x * NT + tidx(); i < 4 * 128 * 128; i += gridDim.x * NT) { const int t = (i >> 7) & 127, s = i & 127; tw[i] = s <= t ? f2bf(p.sg_w[i]) : (bf16_t)0; }
}

constexpr int XT_BYTES = 128 * 128, WT_BYTES = 256 * 128, STG_BYTES = XT_BYTES + WT_BYTES;
constexpr size_t OFF_ZERO = 480 * MiB + 320 * 1024;
#define LAS3 __attribute__((address_space(3)))

template <class F> __device__ __forceinline__ void epi_each(const f32x4 (&acc)[4][4], F f) {
    const int lane = tidx() & 63, wid = tidx() >> 6, wr = wid >> 2, wc = wid & 3, fr = lane & 15, fg = lane >> 4;
#pragma unroll
    for (int mi = 0; mi < 4; ++mi)
#pragma unroll
        for (int pp = 0; pp < 2; ++pp) {
            const float v[8] = {acc[mi][2 * pp][0], acc[mi][2 * pp][1], acc[mi][2 * pp][2], acc[mi][2 * pp][3],
                                acc[mi][2 * pp + 1][0], acc[mi][2 * pp + 1][1], acc[mi][2 * pp + 1][2], acc[mi][2 * pp + 1][3]};
            f(wr * 64 + mi * 16 + fr, wc * 64 + pp * 32 + 8 * fg, v);
        }
}

__device__ __forceinline__ uint4 dpp_ror8(const uint4 v) {
    uint4 r;
    r.x = (unsigned)__builtin_amdgcn_update_dpp(0, (int)v.x, 0x128, 0xf, 0xf, false); r.y = (unsigned)__builtin_amdgcn_update_dpp(0, (int)v.y, 0x128, 0xf, 0xf, false);
    r.z = (unsigned)__builtin_amdgcn_update_dpp(0, (int)v.z, 0x128, 0xf, 0xf, false); r.w = (unsigned)__builtin_amdgcn_update_dpp(0, (int)v.w, 0x128, 0xf, 0xf, false);
    return r;
}
template <class F, class G> __device__ __forceinline__ void epi_rows(const f32x4 (&acc)[4][4], F f, G st) {
    const int lane = tidx() & 63, wid = tidx() >> 6, wr = wid >> 2, wc = wid & 3, fr = lane & 15, fg = lane >> 4;
    const bool lo = fr < 8;
#pragma unroll
    for (int mi = 0; mi < 4; ++mi) {
        const float a0[8] = {acc[mi][0][0], acc[mi][0][1], acc[mi][0][2], acc[mi][0][3], acc[mi][1][0], acc[mi][1][1], acc[mi][1][2], acc[mi][1][3]};
        const float a1[8] = {acc[mi][2][0], acc[mi][2][1], acc[mi][2][2], acc[mi][2][3], acc[mi][3][0], acc[mi][3][1], acc[mi][3][2], acc[mi][3][3]};
        const int r = wr * 64 + mi * 16 + fr, c0 = wc * 64 + 8 * fg;
        const uint4 A = f(r, c0, a0), B = f(r, c0 + 32, a1);
        const uint4 Bs = dpp_ror8(B);
        const int rb = wr * 64 + mi * 16 + (fr & 7);
        st(rb, lo ? c0 : c0 + 32, lo ? A : Bs);
        st(rb + 8, lo ? c0 + 32 : c0, lo ? Bs : A);
    }
}

template <bool A_LDS, int ESTORES, class RowPtr, class WPtr, class Epi>
__device__ __forceinline__ void gemm_panel(RowPtr rp, const char* Hs, int hstride, WPtr wp, int ldw, int nk, int nv, char* stage, Epi epi) {
    const int tid = tidx(), lane = tid & 63, wid = tid >> 6, wr = wid >> 2, wc = wid & 3, fr = lane & 15, fg = lane >> 4;
    constexpr int XOFF = A_LDS ? 0 : XT_BYTES, BUFB = A_LDS ? WT_BYTES : STG_BYTES;
    const int l8 = lane >> 3, kcl = ((lane & 7) ^ l8) * 8;
    auto gload = [&](int v, int kt, int buf) {
        char* b = stage + buf * BUFB + lane * 16;
        const int k0 = kt * 64 + kcl;
        if constexpr (!A_LDS) {
#pragma unroll
            for (int i = 0; i < 2; ++i) {
                const int q = wid + 8 * i;
                __builtin_amdgcn_global_load_lds((const unsigned*)(rp(v, q * 8 + l8) + k0), (LAS3 unsigned*)(b + q * 1024), 16, 0, 0);
            }
        }
        const bf16_t* wb = wp(v) + k0;
#pragma unroll
        for (int i = 0; i < 4; ++i) {
            const int q = wid + 8 * i, rho = q * 8 + l8, ii = rho & 15;
            const int n = (rho & ~31) + 8 * (ii >> 2) + (ii & 3) + ((rho >> 2) & 4);
            __builtin_amdgcn_global_load_lds((const unsigned*)(wb + (size_t)n * ldw), (LAS3 unsigned*)(b + XOFF + q * 1024), 16, 0, 0);
        }
    };
    const int S = nk * nv;
    constexpr int NST = A_LDS ? 2 : 3;
    gload(0, 0, 0);
    if constexpr (NST == 3) { if (S > 1) gload(nk > 1 ? 0 : 1, nk > 1 ? 1 : 0, 1); }
    f32x4 acc[4][4];
    int v = 0, kt = 0;
    int vp = 0, ktp = 0;
#pragma unroll
    for (int i = 0; i < NST - 1; ++i) { if (++ktp == nk) { ktp = 0; ++vp; } }
    int bufc = 0, bufp = NST - 1;
    const int xc0 = (fg ^ (fr & 7)) * 16;
    const int wrow_off = (wc * 64 + fr) * 128;
    const int xrow_off = (wr * 64 + fr) * 128;
    bool pend = false; int vpend = 0;
    int since = 2;
    for (int s = 0; s < S; ++s) {
        if (NST == 3 && s + 1 < S) {
            if constexpr (A_LDS) asm volatile("s_waitcnt vmcnt(4)" ::: "memory");
            else if (ESTORES > 0 && since < 2) asm volatile("s_waitcnt vmcnt(%0)" :: "n"(6 + ESTORES) : "memory");
            else asm volatile("s_waitcnt vmcnt(6)" ::: "memory");
        }
        else asm volatile("s_waitcnt vmcnt(0)" ::: "memory");
        __builtin_amdgcn_s_barrier();
        if (pend) { epi(vpend, acc); pend = false; }
        if (s + NST - 1 < S) gload(vp, ktp, bufp);
        if (kt == 0) {
#pragma unroll
            for (int mi = 0; mi < 4; ++mi)
#pragma unroll
                for (int ni = 0; ni < 4; ++ni) acc[mi][ni] = (f32x4){0.f, 0.f, 0.f, 0.f};
        }
        const char* b = stage + bufc * BUFB;
#pragma unroll
        for (int ks = 0; ks < 2; ++ks) {
            bf16x8 xf[4], wf[4];
#pragma unroll
            for (int mi = 0; mi < 4; ++mi) {
                if constexpr (A_LDS) xf[mi] = *(const bf16x8*)(Hs + (wr * 64 + mi * 16 + fr) * hstride + (kt * 64 + ks * 32 + fg * 8) * 2);
                else xf[mi] = *(const bf16x8*)(b + xrow_off + mi * 2048 + (xc0 ^ (ks * 64)));
            }
#pragma unroll
            for (int ni = 0; ni < 4; ++ni) wf[ni] = *(const bf16x8*)(b + XOFF + wrow_off + ni * 2048 + (xc0 ^ (ks * 64)));
#pragma unroll
            for (int mi = 0; mi < 4; ++mi)
#pragma unroll
                for (int ni = 0; ni < 4; ++ni) acc[mi][ni] = __builtin_amdgcn_mfma_f32_16x16x32_bf16(wf[ni], xf[mi], acc[mi][ni], 0, 0, 0);
        }
        if (ESTORES > 0) { if (kt == nk - 1) { epi(v, acc); since = 0; } else if (since < 2) ++since; }
        else if (kt == nk - 1) { pend = true; vpend = v; }
        if (++kt == nk) { kt = 0; ++v; }
        if (++ktp == nk) { ktp = 0; ++vp; }
        if (++bufc == NST) bufc = 0;
        if (++bufp == NST) bufp = 0;
    }
    if (pend) epi(vpend, acc);
    __syncthreads();
}

typedef unsigned char u8_t;
template <bool A_LDS, int ESTORES, bool P16, class RowPtr, class WPtr, class Epi>
__device__ __forceinline__ void gemm_panel8(RowPtr rp, const char* Hs, int hstride, WPtr wp, int ldw, int nk, int nv, char* stage, Epi epi) {
    const int tid = tidx(), lane = tid & 63, wid = __builtin_amdgcn_readfirstlane(tid >> 6), wr = wid >> 2, wc = wid & 3, fr = lane & 15, fg = lane >> 4;
    constexpr int XOFF = A_LDS ? 0 : XT_BYTES, BUFB = A_LDS ? WT_BYTES : STG_BYTES;
    const int l8 = lane >> 3;
    auto gload = [&](int v, int kt, int buf) {
        char* b = stage + buf * BUFB + lane * 16;
        if constexpr (!A_LDS) {
#pragma unroll
            for (int i = 0; i < 2; ++i) {
                const int q = wid + 8 * i, k0 = kt * 128 + (((lane & 7) ^ l8 ^ (q & 1)) << 4);
                __builtin_amdgcn_global_load_lds((const unsigned*)(rp(v, q * 8 + l8) + k0), (LAS3 unsigned*)(b + q * 1024), 16, 0, 0);
            }
        }
        const u8_t* wb = wp(v) + kt * 128;
#pragma unroll
        for (int i = 0; i < 4; ++i) {
            const int q = wid + 8 * i, rho = q * 8 + l8, ii = rho & 15;
            const int n = P16 ? (rho & ~63) + 16 * (ii >> 2) + 4 * ((rho >> 4) & 3) + (ii & 3) : (rho & ~31) + 8 * (ii >> 2) + (ii & 3) + ((rho >> 2) & 4);
            __builtin_amdgcn_global_load_lds((const unsigned*)(wb + (size_t)n * ldw + (((lane & 7) ^ l8 ^ (q & 1)) << 4)), (LAS3 unsigned*)(b + XOFF + q * 1024), 16, 0, 0);
        }
    };
    const int S = nk * nv;
    gload(0, 0, 0);
    if (S > 1) gload(nk > 1 ? 0 : 1, nk > 1 ? 1 : 0, 1);
    f32x4 acc[4][4];
    int v = 0, kt = 0, vp = 0, ktp = 0;
#pragma unroll
    for (int i = 0; i < 2; ++i) { if (++ktp == nk) { ktp = 0; ++vp; } }
    int bufc = 0, bufp = 2;
    const int sw = (fr & 7) ^ (fr >> 3);
    const int wrow_off = XOFF + (wc * 64 + fr) * 128 + (fg & 1) * 8;
    const int xrow_off = (wr * 64 + fr) * 128 + (fg & 1) * 8;
    bool pend = false; int vpend = 0;
    int since = 2;
    constexpr int PER = A_LDS ? 4 : 6;
    for (int s = 0; s < S; ++s) {
        if (s + 1 < S) {
            if (ESTORES > 0 && since < 2) asm volatile("s_waitcnt vmcnt(%0)" :: "n"(PER + ESTORES) : "memory");
            else asm volatile("s_waitcnt vmcnt(%0)" :: "n"(PER) : "memory");
        }
        else asm volatile("s_waitcnt vmcnt(0)" ::: "memory");
        __builtin_amdgcn_s_barrier();
        if (pend) { epi(vpend, acc); pend = false; }
        if (s + 2 < S) gload(vp, ktp, bufp);
        if (kt == 0) {
#pragma unroll
            for (int mi = 0; mi < 4; ++mi)
#pragma unroll
                for (int ni = 0; ni < 4; ++ni) acc[mi][ni] = (f32x4){0.f, 0.f, 0.f, 0.f};
        }
        const char* b = stage + bufc * BUFB;
#pragma unroll
        for (int ks = 0; ks < 4; ++ks) {
            long xf[4], wf[4];
            const int co = ((ks * 2 + (fg >> 1)) ^ sw) << 4;
#pragma unroll
            for (int mi = 0; mi < 4; ++mi) {
                if constexpr (A_LDS) xf[mi] = *(const long*)(Hs + (wr * 64 + mi * 16 + fr) * hstride + kt * 128 + ks * 32 + fg * 8);
                else xf[mi] = *(const long*)(b + xrow_off + mi * 2048 + co);
            }
#pragma unroll
            for (int ni = 0; ni < 4; ++ni) wf[ni] = *(const long*)(b + wrow_off + ni * 2048 + co);
#pragma unroll
            for (int mi = 0; mi < 4; ++mi)
#pragma unroll
                for (int ni = 0; ni < 4; ++ni) acc[mi][ni] = __builtin_amdgcn_mfma_f32_16x16x32_fp8_fp8(wf[ni], xf[mi], acc[mi][ni], 0, 0, 0);
        }
        if (ESTORES > 0) { if (kt == nk - 1) { epi(v, acc); since = 0; } else if (since < 2) ++since; }
        else if (kt == nk - 1) { pend = true; vpend = v; }
        if (++kt == nk) { kt = 0; ++v; }
        if (++ktp == nk) { ktp = 0; ++vp; }
        if (++bufc == 3) bufc = 0;
        if (++bufp == 3) bufp = 0;
    }
    if (pend) epi(vpend, acc);
    __syncthreads();
}

__device__ void st_inproj_fast(const P& p, char* lds, int abl) {
    const bf16_t* hm = (const bf16_t*)(p.ws + OFF_HM);
    const bf16_t* wt = (const bf16_t*)(p.ws + OFF_WT_IN);
    bf16_t* qkv = (bf16_t*)(p.ws + OFF_QKV); bf16_t* zs = (bf16_t*)(p.ws + OFF_ZS); bf16_t* ug = (bf16_t*)(p.ws + OFF_UG);
    bf16_t* vgg = (bf16_t*)(p.ws + OFF_VGG); bf16_t* gate = (bf16_t*)(p.ws + OFF_GATE);
    bf16_t* lbias = (bf16_t*)(lds + 3 * STG_BYTES);
    for (int i = tidx(); i < 2048; i += NT) lbias[i] = f2bf(p.b_bg[i]);
    __syncthreads();
    for (int panel = blockIdx.x; panel < T / 128; panel += gridDim.x) {
        const size_t t0 = (size_t)panel * 128;
        auto epi = [&](int v, const f32x4 (&acc)[4][4]) {
            if (abl == 1) { if (acc[0][0][0] == 12345.678f) qkv[0] = 1; return; }
            epi_rows(acc,
                [&](int r, int c, const float (&a_)[8]) {
                    const int col = v * 256 + c;
                    float a[8], o[8];
#pragma unroll
                    for (int j = 0; j < 8; ++j) a[j] = ((IN8 == 1 && v >= 8) || IN8 == 2) ? a_[j] * W8_INV : a_[j];
                    if (v < 6 || abl == 2) {
#pragma unroll
                        for (int j = 0; j < 8; ++j) o[j] = a[j];
                    } else if (v < 8) {
#pragma unroll
                        for (int j = 0; j < 8; ++j) o[j] = fsilu_(a[j]);
                    } else if (v < 12) {
#pragma unroll
                        for (int j = 0; j < 8; ++j) o[j] = fgelu_(a[j]);
                    } else {
                        float bs[8]; unpack8(*(const uint4*)(lbias + (col - 3072)), bs);
#pragma unroll
                        for (int j = 0; j < 8; ++j) o[j] = fsigmoid_(a[j] + bs[j]);
                    }
                    return pack8(o);
                },
                [&](int r, int c, const uint4 d) {
                    const size_t t = t0 + r; const int col = v * 256 + c;
                    if (v < 6) *(uint4*)(qkv + t * 1536 + col) = d;
                    else if (v < 8) *(uint4*)(zs + t * 512 + (col - 1536)) = d;
                    else if (v < 10) *(uint4*)(ug + t * 512 + (col - 2048)) = d;
                    else if (v < 12) *(uint4*)(vgg + t * 512 + (col - 2560)) = d;
                    else *(uint4*)(gate + t * 2048 + (col - 3072)) = d;
                });
        };
        if (IN8 == 2) {
            gemm_panel8<false, 8, false>([&](int, int r) { return (const u8_t*)(p.ws + OFF_HM8) + (t0 + r) * D; }, nullptr, 0,
                               [&](int v) { return (const u8_t*)(p.ws + OFF_WT_IN8) + (size_t)v * 256 * D; }, D, 8, 20, lds, epi);
        } else if (IN8) {
            gemm_panel<false, 8>([&](int, int r) { return hm + (t0 + r) * D; }, nullptr, 0, [&](int v) { return wt + (size_t)v * 256 * D; }, D, 16, 8, lds, epi);
            gemm_panel8<false, 0, false>([&](int, int r) { return (const u8_t*)(p.ws + OFF_HM8) + (t0 + r) * D; }, nullptr, 0,
                               [&](int v) { return (const u8_t*)(p.ws + OFF_WT_IN8) + (size_t)(v + 8) * 256 * D; }, D, 8, 12, lds,
                               [&](int v, const f32x4 (&acc)[4][4]) { epi(v + 8, acc); });
        } else gemm_panel<false, 8>([&](int, int r) { return hm + (t0 + r) * D; }, nullptr, 0, [&](int v) { return wt + (size_t)v * 256 * D; }, D, 16, 20, lds, epi);
    }
}

constexpr int HSTRIDE = 272;
constexpr int HS_BYTES = 35 * 1024;
constexpr int LDS_ENT = 148 * 1024;

template <class RowSrc, class Store>
__device__ __forceinline__ void moe_tile(RowSrc rowsrc, const u8_t* wgu, const u8_t* wd, char* lds, Store store) {
    const int lane = tidx() & 63, wid = tidx() >> 6, wr = wid >> 2, wc = wid & 3, fr = lane & 15, fg = lane >> 4;
    uint2 h0[4], h1[4];
    gemm_panel8<false, 0, false>([&](int, int r) { return rowsrc(r); }, nullptr, 0, [&](int v) { return wgu + (size_t)v * 256 * D; }, D, 8, 2, lds,
                       [&](int v, const f32x4 (&acc)[4][4]) {
#pragma unroll
                           for (int mi = 0; mi < 4; ++mi) {
                               float h[8];
#pragma unroll
                               for (int j = 0; j < 4; ++j) {
                                   h[j] = fsilu_(acc[mi][0][j] * W8_INV) * (acc[mi][2][j] * W8_INV);
                                   h[4 + j] = fsilu_(acc[mi][1][j] * W8_INV) * (acc[mi][3][j] * W8_INV);
                               }
                               if (v == 0) h0[mi] = pack8_fp8(h); else h1[mi] = pack8_fp8(h);
                           }
                       });
#pragma unroll
    for (int mi = 0; mi < 4; ++mi) {
        char* hp = lds + (wr * 64 + mi * 16 + fr) * HSTRIDE + wc * 32 + 8 * fg;
        *(uint2*)(hp) = h0[mi]; *(uint2*)(hp + 128) = h1[mi];
    }
    __syncthreads();
    gemm_panel8<true, 4, true>([&](int, int) { return (const u8_t*)nullptr; }, lds, HSTRIDE, [&](int v) { return wd + (size_t)v * 256 * EH; }, EH, 2, 4, lds + HS_BYTES,
                      [&](int v, const f32x4 (&acc)[4][4]) {
#pragma unroll
                          for (int mi = 0; mi < 4; ++mi) {
                              const float a[16] = {acc[mi][0][0], acc[mi][0][1], acc[mi][0][2], acc[mi][0][3], acc[mi][1][0], acc[mi][1][1], acc[mi][1][2], acc[mi][1][3],
                                                   acc[mi][2][0], acc[mi][2][1], acc[mi][2][2], acc[mi][2][3], acc[mi][3][0], acc[mi][3][1], acc[mi][3][2], acc[mi][3][3]};
                              store(wr * 64 + mi * 16 + fr, v * 256 + wc * 64 + 16 * fg, a);
                          }
                      });
}

constexpr size_t OFF_TRASH = 505 * MiB;
__device__ __forceinline__ void st_moe_fast(const P& p, char* lds, bool fin, int which) {
    const u8_t* hf8 = (const u8_t*)(p.ws + OFF_HF8);
    u8_t* contrib = (u8_t*)(p.ws + OFF_CONTRIB);
    bf16_t* sho = (bf16_t*)(p.ws + OFF_SHO);
    u8_t* trash = (u8_t*)(p.ws + OFF_TRASH) + (size_t)blockIdx.x * D;
    const unsigned* cnt = (const unsigned*)(p.ws + OFF_CNT);
    const int* lists = (const int*)(p.ws + OFF_LISTS);
    const float* wts = (const float*)(p.ws + OFF_WTS);
    int* ent = (int*)(lds + LDS_ENT);
    int* tstart = ent + 128;
    float* wrow = (float*)(tstart + 260);
    __syncthreads();
    if (tidx() == 0) { int acc = 0; for (int e = 0; e < NE; ++e) { tstart[e] = acc; acc += ((int)cnt[e] + 127) >> 7; } tstart[NE] = acc; }
    __syncthreads();
    const int ntiles = which ? 0 : tstart[NE];
    int e = 0;
    for (int tile = blockIdx.x; tile < (which ? T / 128 : ntiles); tile += gridDim.x) {
        if (tile < ntiles) {
            while (tstart[e + 1] <= tile) ++e;
            const int r0 = (tile - tstart[e]) * 128, ce = (int)cnt[e];
            __syncthreads();
            if (tidx() < 128) { const int en = (r0 + (int)tidx() < ce) ? lists[(size_t)e * LCAP + r0 + tidx()] : -1; ent[tidx()] = en; wrow[tidx()] = en >= 0 ? wts[en] * W8_INV : 0.f; }
            __syncthreads();
            moe_tile([&](int r) { const int en = ent[r]; return en >= 0 ? hf8 + (size_t)(en >> 3) * D : (const u8_t*)(p.ws + OFF_ZERO); },
                     (const u8_t*)(p.ws + OFF_WT_GU) + (size_t)e * 512 * D, (const u8_t*)(p.ws + OFF_WT_D) + (size_t)e * D * EH, lds,
                     [&](int r, int col, const float (&a)[16]) {
                         const int en = ent[r];
                         const float w = wrow[r] * C8_SCALE;
                         float o0[8], o1[8];
#pragma unroll
                         for (int j = 0; j < 8; ++j) { o0[j] = a[j] * w; o1[j] = a[8 + j] * w; }
                         const uint2 lo = pack8_fp8(o0), hi = pack8_fp8(o1);
                         u8_t* dst = (en >= 0 && fin) ? contrib + (size_t)en * D + col : trash + col;
                         *(uint4*)dst = make_uint4(lo.x, lo.y, hi.x, hi.y);
                     });
        } else {
            const size_t t0 = (size_t)(tile - ntiles) * 128;
            __syncthreads();
            moe_tile([&](int r) { return hf8 + (t0 + r) * D; }, (const u8_t*)(p.ws + OFF_WT_SHGU), (const u8_t*)(p.ws + OFF_WT_SHD), lds,
                     [&](int r, int col, const float (&a)[16]) {
                         float o0[8], o1[8];
#pragma unroll
                         for (int j = 0; j < 8; ++j) { o0[j] = a[j] * W8_INV; o1[j] = a[8 + j] * W8_INV; }
                         *(uint4*)(sho + (t0 + r) * D + col) = pack8(o0); *(uint4*)(sho + (t0 + r) * D + col + 8) = pack8(o1);
                     });
        }
    }
}

constexpr size_t OFF_MERGEDB = 736 * MiB;
__device__ __forceinline__ void wg_sync() { asm volatile("s_waitcnt vmcnt(0)" ::: "memory"); __syncthreads(); }
struct TopE { float v; int e; };
__device__ __forceinline__ bool better(const TopE& a, const TopE& b) { return a.v > b.v || (a.v == b.v && a.e < b.e); }

__device__ void st_post_fast(const P& p, char* lds, bool fin) {
    const int tid = tidx(), lane = tid & 63, wid = tid >> 6, wr = wid >> 2, wc = wid & 3, fr = lane & 15, fg = lane >> 4;
    const bf16_t* ydn = (const bf16_t*)(p.ws + OFF_O); const bf16_t* ysg = (const bf16_t*)(p.ws + OFF_YSG);
    const bf16_t* gate = (const bf16_t*)(p.ws + OFF_GATE);
    bf16_t* mg = (bf16_t*)(p.ws + OFF_MERGEDB);
    bf16_t* yb = (bf16_t*)(p.ws + OFF_Y);
    const bf16_t* hf = (const bf16_t*)(p.ws + OFF_HF);
    unsigned* cnt = (unsigned*)(p.ws + OFF_CNT);
    int* lists = (int*)(p.ws + OFF_LISTS);
    float* wts = (float*)(p.ws + OFF_WTS);
    float* sc = (float*)lds;
    float* bias = (float*)(lds + 131584);
    int* hist = (int*)(lds + 132608);
    int* base = (int*)(lds + 133632);
    for (int panel = blockIdx.x; panel < T / 128; panel += gridDim.x) {
        const size_t t0 = (size_t)panel * 128;
        if (fin) for (int r = wid; r < 128; r += 8) ydn_token(p, (int)t0 + r, lane);
        wg_sync();
        {
            gemm_panel<false, 8>([&](int v, int r) { return ((v & 1) ? ysg : ydn) + (t0 + r) * 512; }, nullptr, 0,
                              [&](int v) { return (const bf16_t*)(p.ws + ((v & 1) ? OFF_WT_SG : OFF_WT_DN)) + (size_t)(v >> 1) * 256 * 512; }, 512, 8, 8, lds,
                              [&](int v, const f32x4 (&acc)[4][4]) {
                                  uint4 gv[4][2], mv[4][2];
#pragma unroll
                                  for (int mi = 0; mi < 4; ++mi)
#pragma unroll
                                      for (int pp = 0; pp < 2; ++pp) {
                                          const size_t t = t0 + wr * 64 + mi * 16 + fr; const int col = (v >> 1) * 256 + wc * 64 + pp * 32 + 8 * fg;
                                          gv[mi][pp] = *(const uint4*)(gate + t * 2048 + (v & 1) * 1024 + col);
                                          if (v & 1) mv[mi][pp] = *(const uint4*)(mg + t * D + col);
                                      }
#pragma unroll
                                  for (int mi = 0; mi < 4; ++mi)
#pragma unroll
                                      for (int pp = 0; pp < 2; ++pp) {
                                          const size_t t = t0 + wr * 64 + mi * 16 + fr; const int col = (v >> 1) * 256 + wc * 64 + pp * 32 + 8 * fg;
                                          float g[8], o[8]; unpack8(gv[mi][pp], g);
                                          const float a[8] = {acc[mi][2 * pp][0], acc[mi][2 * pp][1], acc[mi][2 * pp][2], acc[mi][2 * pp][3],
                                                              acc[mi][2 * pp + 1][0], acc[mi][2 * pp + 1][1], acc[mi][2 * pp + 1][2], acc[mi][2 * pp + 1][3]};
                                          if (v & 1) {
                                              float m[8]; unpack8(mv[mi][pp], m);
#pragma unroll
                                              for (int j = 0; j < 8; ++j) o[j] = m[j] + g[j] * a[j];
                                          } else {
#pragma unroll
                                              for (int j = 0; j < 8; ++j) o[j] = g[j] * a[j];
                                          }
                                          *(uint4*)(mg + t * D + col) = pack8(o);
                                      }
                              });
        }
        wg_sync();
        gemm_panel<false, 8>([&](int, int r) { return mg + (t0 + r) * D; }, nullptr, 0, [&](int v) { return (const bf16_t*)(p.ws + OFF_WT_OUT) + (size_t)v * 256 * D; }, D, 16, 4, lds,
                          [&](int v, const f32x4 (&acc)[4][4]) {
                              epi_each(acc, [&](int r, int c, const float (&a)[8]) { *(uint4*)(yb + (t0 + r) * D + v * 256 + c) = pack8(a); });
                          });
        wg_sync();
        {
            float* lv = (float*)lds;
            const float* mod = (const float*)(p.ws + OFF_MOD);
            const int b = (int)(t0 / SEQ);
            for (int k = tid; k < 1024; k += NT) {
                lv[k] = mod[b * 6144 + 2048 + k] * p.mix_post[k];
                lv[1024 + k] = p.ffn_pre[k] * (1.f + mod[b * 6144 + 4096 + k]);
                lv[2048 + k] = mod[b * 6144 + 3072 + k];
            }
            __syncthreads();
            for (int r = wid; r < 128; r += 8) x1hf_row(p, (int)t0 + r, lane, lv);
        }
        wg_sync();
        {
            f32x4 racc[4][4];
            gemm_panel<false, 0>([&](int, int r) { return hf + (t0 + r) * D; }, nullptr, 0, [&](int) { return (const bf16_t*)(p.ws + OFF_WT_RT); }, D, 16, 1, lds,
                              [&](int, const f32x4 (&acc)[4][4]) {
#pragma unroll
                                  for (int mi = 0; mi < 4; ++mi)
#pragma unroll
                                      for (int ni = 0; ni < 4; ++ni) racc[mi][ni] = acc[mi][ni];
                              });
            epi_each(racc, [&](int r, int c, const float (&a)[8]) {
#pragma unroll
                for (int j = 0; j < 8; ++j) sc[r * 257 + c + j] = fsigmoid_(a[j]);
            });
        }
        { int tt = tid; asm volatile("" : "+v"(tt)); if (tt < 256) { bias[tt] = p.router_bias[tt]; hist[tt] = 0; } }
        __syncthreads();
        {
            const int tok = tid >> 2, q = tid & 3;
            const float* srow = sc + tok * 257;
            TopE l[8];
#pragma unroll
            for (int k = 0; k < 8; ++k) { l[k].v = -INFINITY; l[k].e = 1 << 30; }
            float a1 = -INFINITY, a2 = -INFINITY, b1 = -INFINITY, b2 = -INFINITY;
            for (int i = 0; i < 64; ++i) {
                const int idx = (i + 8 * q) & 63, e = 64 * q + idx;
                const float v = srow[e] + bias[e];
                if (idx < 32) { if (v > a1) { a2 = a1; a1 = v; } else if (v > a2) a2 = v; }
                else { if (v > b1) { b2 = b1; b1 = v; } else if (v > b2) b2 = v; }
            }
            const float gs0 = a1 + a2, gs1 = b1 + b2;
            int r0 = 0, r1 = 0;
#pragma unroll
            for (int h = 0; h < 8; ++h) {
                const float gh = __shfl((h & 1) ? gs1 : gs0, (lane & ~3) | (h >> 1));
                r0 += (gh > gs0 || (gh == gs0 && h < 2 * q)) ? 1 : 0;
                r1 += (gh > gs1 || (gh == gs1 && h < 2 * q + 1)) ? 1 : 0;
            }
            const bool sel0 = r0 < 4, sel1 = r1 < 4;
            for (int i = 0; i < 64; ++i) {
                const int idx = (i + 8 * q) & 63, e = 64 * q + idx;
                if (idx < 32 ? sel0 : sel1) {
                    TopE cur; cur.v = srow[e] + bias[e]; cur.e = e;
                    if (better(cur, l[7])) {
#pragma unroll
                        for (int k = 0; k < 8; ++k) if (better(cur, l[k])) { const TopE tmp = l[k]; l[k] = cur; cur = tmp; }
                    }
                }
            }
            int we[8]; float wv[8]; float wsum = 0.f;
#pragma unroll
            for (int k = 0; k < 8; ++k) {
                TopE h = l[0];
#pragma unroll
                for (int o = 1; o < 4; o <<= 1) { TopE t2; t2.v = __shfl_xor(h.v, o); t2.e = __shfl_xor(h.e, o); if (better(t2, h)) h = t2; }
                if (l[0].e == h.e) {
#pragma unroll
                    for (int j = 0; j < 7; ++j) l[j] = l[j + 1];
                    l[7].v = -INFINITY; l[7].e = 1 << 30;
                }
                we[k] = h.e; wv[k] = srow[h.e]; wsum += wv[k];
            }
            const float inv = 2.5f / wsum;
            int rk0 = 0, rk1 = 0, e0 = 0, e1 = 0; float w0 = 0.f, w1 = 0.f;
#pragma unroll
            for (int k = 0; k < 8; ++k) if ((k >> 1) == q) { if (k & 1) { e1 = we[k]; w1 = wv[k] * inv; } else { e0 = we[k]; w0 = wv[k] * inv; } }
            rk0 = atomicAdd(&hist[e0], 1); rk1 = atomicAdd(&hist[e1], 1);
            __syncthreads();
            { int tt = tid; asm volatile("" : "+v"(tt)); if (tt < 256) { const int c = hist[tt]; base[tt] = (c > 0 && fin) ? (int)atomicAdd(&cnt[tt], (unsigned)c) : 0; } }
            __syncthreads();
            const int tg = (int)t0 + tok;
            if (fin) {
            lists[(size_t)e0 * LCAP + base[e0] + rk0] = tg * 8 + 2 * q; wts[tg * 8 + 2 * q] = w0;
            lists[(size_t)e1 * LCAP + base[e1] + rk1] = tg * 8 + 2 * q + 1; wts[tg * 8 + 2 * q + 1] = w1;
            }
        }
        __syncthreads();
    }
}

constexpr size_t OFF_GL  = 480 * MiB + 128 * 1024;
constexpr size_t OFF_KDT = 960 * MiB;
constexpr size_t OFF_QKF = 992 * MiB;
constexpr int DN_HALF = 73728;
constexpr int DQS = 0, DKS = 18432, DLS = 36864, DWL = 53248, DMISC = 71680;

__device__ __forceinline__ bf16x8 pack_b(const f32x4 a, const f32x4 b) {
    const uint4 u = make_uint4(pk2(a[0], a[1]), pk2(a[2], a[3]), pk2(b[0], b[1]), pk2(b[2], b[3]));
    return __builtin_bit_cast(bf16x8, u);
}

__device__ void st_dnprep_fast(const P& p, char* lds, int abl) {
    const int tid0 = tidx();
    const bf16_t* qkv = (const bf16_t*)(p.ws + OFF_QKV);
    const float* gb = (const float*)(p.ws + OFF_G); const float* bb = (const float*)(p.ws + OFF_BETA);
    float* GL = (float*)(p.ws + OFF_GL);
    bf16_t* KDT = (bf16_t*)(p.ws + OFF_KDT); bf16_t* QKF = (bf16_t*)(p.ws + OFF_QKF);
    float* UF = p.out; bf16_t* WC = (bf16_t*)((char*)p.out + 64 * MiB); bf16_t* QD = (bf16_t*)((char*)p.out + 96 * MiB);
    for (int it = blockIdx.x; it < 1024; it += gridDim.x) {
        int tid = tid0; asm volatile("" : "+v"(tid));
        const int lane = tid & 63, wid = tid >> 6, hb = wid >> 2, hw = __builtin_amdgcn_readfirstlane(wid & 3), ht = tid & 255, fr = lane & 15, fg = lane >> 4;
        char* L = lds + hb * DN_HALF;
        bf16_t* Qs = (bf16_t*)(L + DQS); bf16_t* Ks = (bf16_t*)(L + DKS); float* Ls = (float*)(L + DLS); bf16_t* Wl = (bf16_t*)(L + DWL);
        float* gc = (float*)(L + DMISC); float* beta = gc + 64; float* egc = gc + 128; float* ekl = gc + 192; float* rnq = gc + 256;
        const int unit = it * 2 + hb, h = unit & 3, cn = unit >> 2, t0 = cn * 64, s0 = t0 % SEQ;
        __syncthreads();
        if (hw == 0) {
            const float g = gb[(t0 + lane) * 4 + h], be = bb[(t0 + lane) * 4 + h];
            float c = g;
#pragma unroll
            for (int o = 1; o < 64; o <<= 1) { const float t = __shfl_up(c, o); if (lane >= o) c += t; }
            const float gl = __shfl(c, 63);
            gc[lane] = c; beta[lane] = be; egc[lane] = expf(c); ekl[lane] = expf(gl - c);
            if (lane == 0) GL[unit] = expf(gl);
        }
        {
            const int cp = ht & 63, part = (ht >> 6) & 1, rh = ht >> 7, col = part * 512 + h * 128 + cp * 2, i0 = rh * 32;
            bf16_t* dstp = (part ? Ks : Qs) + cp * 2;
            float2 cw[4];
#pragma unroll
            for (int tap = 0; tap < 4; ++tap) cw[tap] = *(const float2*)(p.conv_w + tap * 1536 + col);
            float2 w0, w1, w2;
            {
                const unsigned r0 = (s0 + i0 >= 3) ? *(const unsigned*)(qkv + (size_t)(t0 + i0 - 3) * 1536 + col) : 0u;
                const unsigned r1 = (s0 + i0 >= 2) ? *(const unsigned*)(qkv + (size_t)(t0 + i0 - 2) * 1536 + col) : 0u;
                const unsigned r2 = (s0 + i0 >= 1) ? *(const unsigned*)(qkv + (size_t)(t0 + i0 - 1) * 1536 + col) : 0u;
                w0 = make_float2(__uint_as_float(r0 << 16), __uint_as_float(r0 & 0xffff0000u));
                w1 = make_float2(__uint_as_float(r1 << 16), __uint_as_float(r1 & 0xffff0000u));
                w2 = make_float2(__uint_as_float(r2 << 16), __uint_as_float(r2 & 0xffff0000u));
            }
            if (!(abl & 1)) {
#pragma unroll
            for (int i = 0; i < 32; ++i) {
                const unsigned r3 = *(const unsigned*)(qkv + (size_t)(t0 + i0 + i) * 1536 + col);
                const float2 w3 = make_float2(__uint_as_float(r3 << 16), __uint_as_float(r3 & 0xffff0000u));
                *(unsigned*)(dstp + (i0 + i) * 144) = pk2(fsilu_(w0.x * cw[0].x + w1.x * cw[1].x + w2.x * cw[2].x + w3.x * cw[3].x),
                                                          fsilu_(w0.y * cw[0].y + w1.y * cw[1].y + w2.y * cw[2].y + w3.y * cw[3].y));
                w0 = w1; w1 = w2; w2 = w3;
            }
            }
        }
        __syncthreads();
        if (ht < 128) {
            const int part = ht >> 6, row = ht & 63;
            const bf16_t* rp_ = (part ? Ks : Qs) + row * 144;
            float ss = 0.f;
#pragma unroll
            for (int q = 0; q < 16; ++q) { float v8[8]; unpack8(*(const uint4*)(rp_ + q * 8), v8);
#pragma unroll
                for (int j = 0; j < 8; ++j) ss += v8[j] * v8[j]; }
            rnq[part * 64 + row] = rsqrtf(ss + 1e-6f) * (part ? 1.f : 0.08838834764831845f);
        }
        __syncthreads();
        {
            f32x4 akk[4], aqk[4];
#pragma unroll
            for (int jt = 0; jt < 4; ++jt) { akk[jt] = (f32x4){0.f, 0.f, 0.f, 0.f}; aqk[jt] = akk[jt]; }
#pragma unroll
            for (int ks = 0; ks < 4; ++ks) {
                const bf16x8 aK = *(const bf16x8*)(Ks + (16 * hw + fr) * 144 + 32 * ks + 8 * fg);
                const bf16x8 aQ = *(const bf16x8*)(Qs + (16 * hw + fr) * 144 + 32 * ks + 8 * fg);
#pragma unroll
                for (int jt = 0; jt < 4; ++jt) {
                    if (jt <= hw) {
                        const bf16x8 bK = *(const bf16x8*)(Ks + (16 * jt + fr) * 144 + 32 * ks + 8 * fg);
                        akk[jt] = __builtin_amdgcn_mfma_f32_16x16x32_bf16(aK, bK, akk[jt], 0, 0, 0);
                        aqk[jt] = __builtin_amdgcn_mfma_f32_16x16x32_bf16(aQ, bK, aqk[jt], 0, 0, 0);
                    }
                }
            }
#pragma unroll
            for (int jt = 0; jt < 4; ++jt) {
                const int j = 16 * jt + fr;
                const float gj = gc[j], rkj = rnq[64 + j];
                float lt[4];
#pragma unroll
                for (int r = 0; r < 4; ++r) {
                    const int i = 16 * hw + 4 * fg + r;
                    const float dec = (i >= j) ? fexp_(gc[i] - gj) * rkj : 0.f;
                    lt[r] = (i > j) ? beta[i] * rnq[64 + i] * akk[jt][r] * dec : 0.f;
                    const int idx = ((hw * 2 + (j >> 5)) * 64 + ((j & 15) >> 2) * 16 + (i & 15)) * 8 + ((j >> 4) & 1) * 4 + (j & 3);
                    QKF[(size_t)unit * 4096 + idx] = f2bf(aqk[jt][r] * rnq[i] * dec);
                }
                *(float4*)(Ls + j * 64 + 16 * hw + 4 * fg) = make_float4(lt[0], lt[1], lt[2], lt[3]);
            }
        }
        __syncthreads();
        {
            float x[64];
            const int c = ht;
            if (c < 128) {
                const int col = 1024 + h * 128 + c;
                float cw[4];
#pragma unroll
                for (int tap = 0; tap < 4; ++tap) cw[tap] = p.conv_w[tap * 1536 + col];
                float w0 = (s0 >= 3) ? bf2f(qkv[(size_t)(t0 - 3) * 1536 + col]) : 0.f;
                float w1 = (s0 >= 2) ? bf2f(qkv[(size_t)(t0 - 2) * 1536 + col]) : 0.f;
                float w2 = (s0 >= 1) ? bf2f(qkv[(size_t)(t0 - 1) * 1536 + col]) : 0.f;
#pragma unroll
                for (int i = 0; i < 64; ++i) {
                    const float w3 = bf2f(qkv[(size_t)(t0 + i) * 1536 + col]);
                    x[i] = fsilu_(w0 * cw[0] + w1 * cw[1] + w2 * cw[2] + w3 * cw[3]) * beta[i];
                    w0 = w1; w1 = w2; w2 = w3;
                }
            } else {
#pragma unroll
                for (int i = 0; i < 64; ++i) x[i] = bf2f(Ks[i * 144 + (c - 128)]) * rnq[64 + i] * beta[i] * egc[i];
            }
            if (!(abl & 2)) {
#pragma unroll
            for (int j = 0; j < 63; ++j) {
                const float xj = x[j];
#pragma unroll
                for (int i = j + 1; i < 64; ++i) x[i] -= Ls[j * 64 + i] * xj;
                if ((j & 1) == 1) __builtin_amdgcn_sched_barrier(0);
            }
            }
            if (c < 128) {
#pragma unroll
                for (int rt = 0; rt < 4; ++rt)
#pragma unroll
                    for (int g4 = 0; g4 < 4; ++g4)
                        *(float4*)(UF + (size_t)unit * 8192 + ((((c >> 4) * 4 + rt) * 64 + g4 * 16 + (c & 15)) << 2)) =
                            make_float4(x[16 * rt + 4 * g4], x[16 * rt + 4 * g4 + 1], x[16 * rt + 4 * g4 + 2], x[16 * rt + 4 * g4 + 3]);
            } else {
#pragma unroll
                for (int i = 0; i < 64; ++i) Wl[i * 144 + (c - 128)] = f2bf(x[i]);
            }
        }
        __syncthreads();
        if (!(abl & 4)) {
#pragma unroll
        for (int m = 0; m < 4; ++m) {
            const int q = ht + 256 * m, frag = q >> 6, l = q & 63, lfr = l & 15, lfg = l >> 4;
            {
                const int row = 16 * (frag >> 2) + lfr, k0 = 32 * (frag & 3) + 4 * lfg;
                const uint2 lo = *(const uint2*)(Wl + row * 144 + k0), hi = *(const uint2*)(Wl + row * 144 + k0 + 16);
                *(uint4*)(WC + (size_t)unit * 8192 + q * 8) = make_uint4(lo.x, lo.y, hi.x, hi.y);
                const uint2 ql = *(const uint2*)(Qs + row * 144 + k0), qh = *(const uint2*)(Qs + row * 144 + k0 + 16);
                const float e = egc[row] * rnq[row];
                float v[8]; unpack8(make_uint4(ql.x, ql.y, qh.x, qh.y), v);
#pragma unroll
                for (int j = 0; j < 8; ++j) v[j] *= e;
                *(uint4*)(QD + (size_t)unit * 8192 + q * 8) = pack8(v);
            }
            {
                const int kd = 16 * (frag >> 1) + lfr, c0 = 32 * (frag & 1) + 4 * lfg;
                float v[8];
#pragma unroll
                for (int j = 0; j < 8; ++j) { const int cpos = c0 + 16 * (j >> 2) + (j & 3); v[j] = bf2f(Ks[cpos * 144 + kd]) * ekl[cpos] * rnq[64 + cpos]; }
                *(uint4*)(KDT + (size_t)unit * 8192 + q * 8) = pack8(v);
            }
        }
        }
    }
}

__device__ void st_dnscan_fast(const P& p, char* lds) {
    const int tid = tidx(), lane = tid & 63, wid = tid >> 6, fr = lane & 15, fg = lane >> 4;
    const int sb = blockIdx.x, vq = sb & 3, h = (sb >> 2) & 3, b = sb >> 4;
    const float* GL = (const float*)(p.ws + OFF_GL);
    const char* KDT = p.ws + OFF_KDT; const char* QKF = p.ws + OFF_QKF;
    const char* UF = (const char*)p.out; const char* WC = (const char*)p.out + 64 * MiB; const char* QD = (const char*)p.out + 96 * MiB;
    bf16_t* ob = (bf16_t*)(p.ws + OFF_O);
    auto dma = [&](int n, int buf) {
        const size_t unit = (size_t)((b * 256 + n) * 4 + h);
        const int lw = wid - 2;
#pragma unroll
        for (int j = 0; j < 11; ++j) {
            const int pi = lw + 6 * j;
            if (pi < 64) {
                const char* src;
                if (pi < 16) src = WC + unit * 16384 + pi * 1024;
                else if (pi < 32) src = QD + unit * 16384 + (pi - 16) * 1024;
                else if (pi < 48) src = KDT + unit * 16384 + (pi - 32) * 1024;
                else if (pi < 56) src = QKF + unit * 8192 + (pi - 48) * 1024;
                else src = UF + unit * 32768 + (size_t)(2 * vq + ((pi - 56) >> 2)) * 4096 + ((pi - 56) & 3) * 1024;
                __builtin_amdgcn_global_load_lds((const unsigned*)(src + lane * 16), (LAS3 unsigned*)(lds + buf * 65536 + pi * 1024 + lane * 16), 16, 0, 0);
            }
        }
    };
    f32x4 S[8];
#pragma unroll
    for (int k = 0; k < 8; ++k) S[k] = (f32x4){0.f, 0.f, 0.f, 0.f};
    if (wid >= 2) dma(0, 0);
    asm volatile("s_waitcnt vmcnt(0)" ::: "memory");
    __syncthreads();
    for (int n = 0; n < 256; ++n) {
        if (wid >= 2) {
            if (n + 1 < 256) dma(n + 1, (n + 1) & 1);
        } else {
            const int vs = 2 * vq + wid;
            const char* B = lds + (n & 1) * 65536 + lane * 16;
            const float egl = GL[(b * 256 + n) * 4 + h];
            bf16x8 Sb[4];
#pragma unroll
            for (int s = 0; s < 4; ++s) Sb[s] = pack_b(S[2 * s], S[2 * s + 1]);
            f32x4 vn[4], o[4];
#pragma unroll
            for (int rt = 0; rt < 4; ++rt) {
                f32x4 pm = (f32x4){0.f, 0.f, 0.f, 0.f}, qo = pm;
#pragma unroll
                for (int s = 0; s < 4; ++s) {
                    pm = __builtin_amdgcn_mfma_f32_16x16x32_bf16(*(const bf16x8*)(B + (rt * 4 + s) * 1024), Sb[s], pm, 0, 0, 0);
                    qo = __builtin_amdgcn_mfma_f32_16x16x32_bf16(*(const bf16x8*)(B + (16 + rt * 4 + s) * 1024), Sb[s], qo, 0, 0, 0);
                }
                const float4 u4 = *(const float4*)(B + (56 + 4 * wid + rt) * 1024);
                vn[rt] = (f32x4){u4.x - pm[0], u4.y - pm[1], u4.z - pm[2], u4.w - pm[3]};
                o[rt] = qo;
            }
            bf16x8 Vb[2];
            Vb[0] = pack_b(vn[0], vn[1]); Vb[1] = pack_b(vn[2], vn[3]);
#pragma unroll
            for (int rt = 0; rt < 4; ++rt)
#pragma unroll
                for (int s2 = 0; s2 < 2; ++s2) o[rt] = __builtin_amdgcn_mfma_f32_16x16x32_bf16(*(const bf16x8*)(B + (48 + rt * 2 + s2) * 1024), Vb[s2], o[rt], 0, 0, 0);
#pragma unroll
            for (int kt = 0; kt < 8; ++kt) {
                S[kt] = S[kt] * egl;
#pragma unroll
                for (int s2 = 0; s2 < 2; ++s2) S[kt] = __builtin_amdgcn_mfma_f32_16x16x32_bf16(*(const bf16x8*)(B + (32 + kt * 2 + s2) * 1024), Vb[s2], S[kt], 0, 0, 0);
            }
            const size_t t0 = (size_t)(b * 256 + n) * 64;
#pragma unroll
            for (int rt = 0; rt < 4; ++rt)
#pragma unroll
                for (int r = 0; r < 4; ++r) ob[(t0 + 16 * rt + 4 * fg + r) * 512 + h * 128 + vs * 16 + fr] = f2bf(o[rt][r]);
        }
        if (wid >= 2) asm volatile("s_waitcnt vmcnt(0)" ::: "memory");
        __builtin_amdgcn_s_barrier();
    }
}

constexpr size_t OFF_MG  = 384 * MiB;
constexpr size_t OFF_BG  = 392 * MiB;
constexpr size_t OFF_SGS = 400 * MiB;

__device__ void st_scan_l1(const P& p, char* lds) {
    const int tid = tidx(), lane = tid & 63, wid = __builtin_amdgcn_readfirstlane(tid >> 6), fr = lane & 15, fg = lane >> 4;
    const float* GL = (const float*)(p.ws + OFF_GL);
    const char* KDT = p.ws + OFF_KDT;
    const char* UF = (const char*)p.out; const char* WC = (const char*)p.out + 64 * MiB;
    for (int blk = blockIdx.x; blk < 256; blk += gridDim.x) {
        const int g2 = blk >> 1, half = blk & 1, bh = g2 >> 4, g = g2 & 15, b = bh >> 2, h = bh & 3;
        const int npieces = half ? 64 : 32;
        auto dma = [&](int i, int buf) {
            const size_t unit = (size_t)((b * 256 + g * 16 + i) * 4 + h);
            for (int pi = wid; pi < npieces; pi += 8) {
                const char* src;
                if (pi < 16) src = WC + unit * 16384 + pi * 1024;
                else if (pi < 32) src = KDT + unit * 16384 + (pi - 16) * 1024;
                else src = UF + unit * 32768 + (pi - 32) * 1024;
                __builtin_amdgcn_global_load_lds((const unsigned*)(src + lane * 16), (LAS3 unsigned*)(lds + buf * 65536 + pi * 1024 + lane * 16), 16, 0, 0);
            }
        };
        f32x4 X[8];
#pragma unroll
        for (int t = 0; t < 8; ++t)
#pragma unroll
            for (int r = 0; r < 4; ++r) X[t][r] = (!half && (16 * t + 4 * fg + r == 16 * wid + fr)) ? 1.f : 0.f;
        __syncthreads();
        dma(0, 0);
        asm volatile("s_waitcnt vmcnt(0)" ::: "memory");
        __syncthreads();
        for (int i = 0; i < 16; ++i) {
            if (i + 1 < 16) dma(i + 1, (i + 1) & 1);
            const char* B = lds + (i & 1) * 65536 + lane * 16;
            const float egl = GL[(b * 256 + g * 16 + i) * 4 + h];
            bf16x8 Xb[4];
#pragma unroll
            for (int s = 0; s < 4; ++s) Xb[s] = pack_b(X[2 * s], X[2 * s + 1]);
            f32x4 vn[4];
#pragma unroll
            for (int rt = 0; rt < 4; ++rt) {
                f32x4 pm = (f32x4){0.f, 0.f, 0.f, 0.f};
#pragma unroll
                for (int s = 0; s < 4; ++s) pm = __builtin_amdgcn_mfma_f32_16x16x32_bf16(*(const bf16x8*)(B + (rt * 4 + s) * 1024), Xb[s], pm, 0, 0, 0);
                if (half) { const float4 u4 = *(const float4*)(B + (32 + 4 * wid + rt) * 1024); vn[rt] = (f32x4){u4.x - pm[0], u4.y - pm[1], u4.z - pm[2], u4.w - pm[3]}; }
                else vn[rt] = (f32x4){-pm[0], -pm[1], -pm[2], -pm[3]};
            }
            bf16x8 Vb[2];
            Vb[0] = pack_b(vn[0], vn[1]); Vb[1] = pack_b(vn[2], vn[3]);
#pragma unroll
            for (int kt = 0; kt < 8; ++kt) {
                X[kt] = X[kt] * egl;
#pragma unroll
                for (int s2 = 0; s2 < 2; ++s2) X[kt] = __builtin_amdgcn_mfma_f32_16x16x32_bf16(*(const bf16x8*)(B + (16 + kt * 2 + s2) * 1024), Vb[s2], X[kt], 0, 0, 0);
            }
            asm volatile("s_waitcnt vmcnt(0)" ::: "memory");
            __builtin_amdgcn_s_barrier();
        }
        if (half) {
            float4* bg = (float4*)(p.ws + OFF_BG) + ((size_t)(g2 * 8 + wid) * 8) * 64 + lane;
#pragma unroll
            for (int t = 0; t < 8; ++t) bg[t * 64] = make_float4(X[t][0], X[t][1], X[t][2], X[t][3]);
        } else {
            bf16_t* Ml = (bf16_t*)lds;
#pragma unroll
            for (int t = 0; t < 8; ++t)
#pragma unroll
                for (int r = 0; r < 4; ++r) Ml[(16 * t + 4 * fg + r) * 136 + 16 * wid + fr] = f2bf(X[t][r]);
            __syncthreads();
            bf16_t* mg = (bf16_t*)(p.ws + OFF_MG) + (size_t)g2 * 16384;
#pragma unroll
            for (int m = 0; m < 4; ++m) {
                const int q = tid + 512 * m, frag = q >> 6, l = q & 63, row = 16 * (frag >> 2) + (l & 15), k0 = 32 * (frag & 3) + 4 * (l >> 4);
                const uint2 lo = *(const uint2*)(Ml + row * 136 + k0), hi = *(const uint2*)(Ml + row * 136 + k0 + 16);
                *(uint4*)(mg + q * 8) = make_uint4(lo.x, lo.y, hi.x, hi.y);
            }
        }
    }
}

__device__ void st_scan_l2(const P& p, char* lds) {
    const int tid = tidx(), lane = tid & 63, wid = __builtin_amdgcn_readfirstlane(tid >> 6);
    const int bh = blockIdx.x;
    const char* MG = p.ws + OFF_MG;
    auto dma = [&](int g, int buf) {
#pragma unroll
        for (int j = 0; j < 4; ++j) {
            const int pi = wid + 8 * j;
            __builtin_amdgcn_global_load_lds((const unsigned*)(MG + (size_t)(bh * 16 + g) * 32768 + pi * 1024 + lane * 16), (LAS3 unsigned*)(lds + buf * 32768 + pi * 1024 + lane * 16), 16, 0, 0);
        }
    };
    f32x4 S[8];
#pragma unroll
    for (int t = 0; t < 8; ++t) S[t] = (f32x4){0.f, 0.f, 0.f, 0.f};
    __syncthreads();
    dma(0, 0);
    asm volatile("s_waitcnt vmcnt(0)" ::: "memory");
    __syncthreads();
    for (int g = 0; g < 16; ++g) {
        if (g + 1 < 16) dma(g + 1, (g + 1) & 1);
        float4* sg = (float4*)(p.ws + OFF_SGS) + ((size_t)((bh * 16 + g) * 8 + wid) * 8) * 64 + lane;
        const float4* bg = (const float4*)(p.ws + OFF_BG) + ((size_t)((bh * 16 + g) * 8 + wid) * 8) * 64 + lane;
#pragma unroll
        for (int t = 0; t < 8; ++t) sg[t * 64] = make_float4(S[t][0], S[t][1], S[t][2], S[t][3]);
        const char* B = lds + (g & 1) * 32768 + lane * 16;
        bf16x8 Sb[4];
#pragma unroll
        for (int s = 0; s < 4; ++s) Sb[s] = pack_b(S[2 * s], S[2 * s + 1]);
#pragma unroll
        for (int t = 0; t < 8; ++t) {
            const float4 b4 = bg[t * 64];
            f32x4 a = (f32x4){b4.x, b4.y, b4.z, b4.w};
#pragma unroll
            for (int s = 0; s < 4; ++s) a = __builtin_amdgcn_mfma_f32_16x16x32_bf16(*(const bf16x8*)(B + (t * 4 + s) * 1024), Sb[s], a, 0, 0, 0);
            S[t] = a;
        }
        asm volatile("s_waitcnt vmcnt(0)" ::: "memory");
        __builtin_amdgcn_s_barrier();
    }
}

__device__ void st_scan_l3(const P& p, char* lds) {
    const int tid = tidx(), lane = tid & 63, wid = __builtin_amdgcn_readfirstlane(tid >> 6), fr = lane & 15, fg = lane >> 4;
    const float* GL = (const float*)(p.ws + OFF_GL);
    const char* KDT = p.ws + OFF_KDT; const char* QKF = p.ws + OFF_QKF;
    const char* UF = (const char*)p.out; const char* WC = (const char*)p.out + 64 * MiB; const char* QD = (const char*)p.out + 96 * MiB;
    bf16_t* ob = (bf16_t*)(p.ws + OFF_O);
    for (int blk = blockIdx.x; blk < 256; blk += gridDim.x) {
        const int g2 = blk >> 1, vh = blk & 1, bh = g2 >> 4, g = g2 & 15, b = bh >> 2, h = bh & 3;
        auto dma = [&](int i, int buf) {
            const size_t unit = (size_t)((b * 256 + g * 16 + i) * 4 + h);
            for (int pi = wid - 4; pi < 72; pi += 4) {
                const char* src;
                if (pi < 16) src = WC + unit * 16384 + pi * 1024;
                else if (pi < 32) src = QD + unit * 16384 + (pi - 16) * 1024;
                else if (pi < 48) src = KDT + unit * 16384 + (pi - 32) * 1024;
                else if (pi < 56) src = QKF + unit * 8192 + (pi - 48) * 1024;
                else src = UF + unit * 32768 + (size_t)vh * 16384 + (pi - 56) * 1024;
                __builtin_amdgcn_global_load_lds((const unsigned*)(src + lane * 16), (LAS3 unsigned*)(lds + buf * 73728 + pi * 1024 + lane * 16), 16, 0, 0);
            }
        };
        f32x4 S[8];
        if (wid < 4) {
            const float4* sg = (const float4*)(p.ws + OFF_SGS) + ((size_t)(g2 * 8 + vh * 4 + wid) * 8) * 64 + lane;
#pragma unroll
            for (int t = 0; t < 8; ++t) { const float4 s4 = sg[t * 64]; S[t] = (f32x4){s4.x, s4.y, s4.z, s4.w}; }
        }
        __syncthreads();
        if (wid >= 4) dma(0, 0);
        asm volatile("s_waitcnt vmcnt(0)" ::: "memory");
        __syncthreads();
        for (int i = 0; i < 16; ++i) {
            if (wid >= 4) {
                if (i + 1 < 16) dma(i + 1, (i + 1) & 1);
            } else {
                const int vs = vh * 4 + wid, n = g * 16 + i;
                const char* B = lds + (i & 1) * 73728 + lane * 16;
                const float egl = GL[(b * 256 + n) * 4 + h];
                bf16x8 Sb[4];
#pragma unroll
                for (int s = 0; s < 4; ++s) Sb[s] = pack_b(S[2 * s], S[2 * s + 1]);
                f32x4 vn[4], o[4];
#pragma unroll
                for (int rt = 0; rt < 4; ++rt) {
                    f32x4 pm = (f32x4){0.f, 0.f, 0.f, 0.f}, qo = pm;
#pragma unroll
                    for (int s = 0; s < 4; ++s) {
                        pm = __builtin_amdgcn_mfma_f32_16x16x32_bf16(*(const bf16x8*)(B + (rt * 4 + s) * 1024), Sb[s], pm, 0, 0, 0);
                        qo = __builtin_amdgcn_mfma_f32_16x16x32_bf16(*(const bf16x8*)(B + (16 + rt * 4 + s) * 1024), Sb[s], qo, 0, 0, 0);
                    }
                    const float4 u4 = *(const float4*)(B + (56 + 4 * wid + rt) * 1024);
                    vn[rt] = (f32x4){u4.x - pm[0], u4.y - pm[1], u4.z - pm[2], u4.w - pm[3]};
                    o[rt] = qo;
                }
                bf16x8 Vb[2];
                Vb[0] = pack_b(vn[0], vn[1]); Vb[1] = pack_b(vn[2], vn[3]);
#pragma unroll
                for (int rt = 0; rt < 4; ++rt)
#pragma unroll
                    for (int s2 = 0; s2 < 2; ++s2) o[rt] = __builtin_amdgcn_mfma_f32_16x16x32_bf16(*(const bf16x8*)(B + (48 + rt * 2 + s2) * 1024), Vb[s2], o[rt], 0, 0, 0);
#pragma unroll
                for (int kt = 0; kt < 8; ++kt) {
                    S[kt] = S[kt] * egl;
#pragma unroll
                    for (int s2 = 0; s2 < 2; ++s2) S[kt] = __builtin_amdgcn_mfma_f32_16x16x32_bf16(*(const bf16x8*)(B + (32 + kt * 2 + s2) * 1024), Vb[s2], S[kt], 0, 0, 0);
                }
                const size_t t0 = (size_t)(b * 256 + n) * 64;
#pragma unroll
                for (int rt = 0; rt < 4; ++rt)
#pragma unroll
                    for (int r = 0; r < 4; ++r) ob[(t0 + 16 * rt + 4 * fg + r) * 512 + h * 128 + vs * 16 + fr] = f2bf(o[rt][r]);
            }
            if (wid >= 4) asm volatile("s_waitcnt vmcnt(0)" ::: "memory");
            __builtin_amdgcn_s_barrier();
        }
    }
}

__device__ void st_sg_fast(const P& p, char* lds, int first, int stride) {
    const int tid = tidx(), lane = tid & 63, wid = tid >> 6, fr = lane & 15, fg = lane >> 4;
    const bf16_t* vgg = (const bf16_t*)(p.ws + OFF_VGG); const bf16_t* ug = (const bf16_t*)(p.ws + OFF_UG);
    const bf16_t* tw = (const bf16_t*)(p.ws + OFF_TRILW);
    bf16_t* ysg = (bf16_t*)(p.ws + OFF_YSG);
    bf16_t* XT = (bf16_t*)lds;
    float* mean = (float*)(lds + 147456); float* rstd = mean + 128;
    for (int unit = first; unit < T / 128; unit += stride) {
        const size_t t0 = (size_t)unit * 128;
        __syncthreads();
        for (int rr = 0; rr < 16; ++rr) {
            const int s = wid * 16 + rr;
            float v[8]; unpack8(*(const uint4*)(vgg + (t0 + s) * 512 + lane * 8), v);
            float sm = 0.f;
#pragma unroll
            for (int j = 0; j < 8; ++j) sm += v[j];
            const float mu = wave_sum(sm) * (1.f / 512.f);
            float q = 0.f;
#pragma unroll
            for (int j = 0; j < 8; ++j) { const float d = v[j] - mu; q += d * d; }
            const float rs = rsqrtf(wave_sum(q) * (1.f / 512.f) + 1e-6f);
            if (lane == 0) { mean[s] = mu; rstd[s] = rs; }
        }
        __syncthreads();
        {
            const int s = tid & 127, cq = tid >> 7;
            const float mu = mean[s], rs = rstd[s];
            for (int cc = 0; cc < 16; ++cc) {
                const int c = cq * 128 + cc * 8;
                float v[8]; unpack8(*(const uint4*)(vgg + (t0 + s) * 512 + c), v);
#pragma unroll
                for (int j = 0; j < 8; ++j) XT[(c + j) * 144 + s] = f2bf((v[j] - mu) * rs * p.sg_ln_w[c + j] + p.sg_ln_b[c + j]);
            }
        }
        __syncthreads();
        const int g = wid >> 1;
        const bf16_t* W = tw + (size_t)g * 128 * 128;
#pragma unroll
        for (int th = 0; th < 2; ++th) {
            f32x4 acc[4][4];
#pragma unroll
            for (int ci = 0; ci < 4; ++ci)
#pragma unroll
                for (int tt = 0; tt < 4; ++tt) acc[ci][tt] = (f32x4){0.f, 0.f, 0.f, 0.f};
#pragma unroll
            for (int ks = 0; ks < 4; ++ks) {
                if (ks <= 2 * th + 1) {
                    bf16x8 a[4], bw[4];
#pragma unroll
                    for (int ci = 0; ci < 4; ++ci) a[ci] = *(const bf16x8*)(XT + (64 * wid + (ci >> 1) * 32 + 8 * (fr >> 2) + (fr & 3) + 4 * (ci & 1)) * 144 + 32 * ks + 8 * fg);
#pragma unroll
                    for (int tt = 0; tt < 4; ++tt) bw[tt] = *(const bf16x8*)(W + (64 * th + 16 * tt + fr) * 128 + 32 * ks + 8 * fg);
#pragma unroll
                    for (int ci = 0; ci < 4; ++ci)
#pragma unroll
                        for (int tt = 0; tt < 4; ++tt)
                            if (2 * ks <= 4 * th + tt) acc[ci][tt] = __builtin_amdgcn_mfma_f32_16x16x32_bf16(a[ci], bw[tt], acc[ci][tt], 0, 0, 0);
                }
            }
#pragma unroll
            for (int pp = 0; pp < 2; ++pp)
#pragma unroll
                for (int tt = 0; tt < 4; ++tt) {
                    const int tl = 64 * th + 16 * tt + fr, c0 = 64 * wid + pp * 32 + 8 * fg;
                    const float bsv = p.sg_b[g * 128 + tl];
                    float u[8], o[8]; unpack8(*(const uint4*)(ug + (t0 + tl) * 512 + c0), u);
#pragma unroll
                    for (int j = 0; j < 4; ++j) { o[j] = u[j] * (acc[2 * pp][tt][j] + bsv); o[4 + j] = u[4 + j] * (acc[2 * pp + 1][tt][j] + bsv); }
                    *(uint4*)(ysg + (t0 + tl) * 512 + c0) = pack8(o);
                }
        }
    }
}

#define XB_TMO      128
#define XB_XCNT(j)  (256  + 64 * (j))
#define XB_XSUB(j)  (1280 + 64 * (j))
#define XB_XGEN(j)  (2304 + 64 * (j))
#define XB_TOP      3328
#define XB_TOPGEN   3392
#define XCD_BAR_WORDS 3456
#define XB_SPIN_CAP (1u << 18)
#define LAS __attribute__((address_space(3)))

__device__ __forceinline__ unsigned xb_ld(unsigned* p)              { return __hip_atomic_load(p, __ATOMIC_RELAXED, __HIP_MEMORY_SCOPE_AGENT); }
__device__ __forceinline__ unsigned xb_add(unsigned* p, unsigned v) { return __hip_atomic_fetch_add(p, v, __ATOMIC_RELAXED, __HIP_MEMORY_SCOPE_AGENT); }
__device__ __forceinline__ unsigned xb_xcc_id() { return (unsigned)__builtin_amdgcn_s_getreg((3 << 11) | 20) & 0xFu; }
#define XB_SPIN(cond, bar) do { unsigned _sp = 0; while (cond) { __builtin_amdgcn_s_sleep(1); \
    if ((++_sp & 255u) == 0u) { if (xb_ld(&(bar)[XB_TMO])) break; if (_sp > XB_SPIN_CAP) { atomicAdd(&(bar)[XB_TMO], 1u); break; } } } } while (0)

struct XcdBarrier {
    unsigned* bar; unsigned x;
    volatile LAS unsigned* st;
};

__device__ __forceinline__ XcdBarrier xcd_barrier_post(unsigned* bar, volatile LAS unsigned* st) {
    XcdBarrier b; b.bar = bar; b.x = xb_xcc_id(); b.st = st;
    if (threadIdx.x == 0) (void)xb_add(&bar[XB_XCNT(b.x)], 1u);
    return b;
}
__device__ __forceinline__ void xcd_barrier_complete(unsigned* bar, unsigned x, unsigned& nloc, unsigned& nx) {
    const unsigned G = gridDim.x * gridDim.y * gridDim.z;
    unsigned sum, cnt, mine, sp = 0u;
    for (;;) {
        sum = 0u; cnt = 0u; mine = 0u;
#pragma unroll
        for (unsigned j = 0; j < 16; ++j) { const unsigned c = xb_ld(&bar[XB_XCNT(j)]); sum += c; cnt += (c > 0u) ? 1u : 0u; mine = (j == x) ? c : mine; }
        if (sum == G) break;
        __builtin_amdgcn_s_sleep(1);
        if ((++sp & 255u) == 0u) { if (xb_ld(&bar[XB_TMO])) break; if (sp > XB_SPIN_CAP) { atomicAdd(&bar[XB_TMO], 1u); break; } }
    }
    nloc = mine > 0u ? mine : 1u; nx = cnt > 0u ? cnt : 1u;
}

__device__ __forceinline__ void xcd_barrier(const XcdBarrier& b) {
    asm volatile("s_waitcnt vmcnt(0)" ::: "memory");
    __syncthreads();
    if (threadIdx.x == 0) {
        unsigned* bar = b.bar;
        __builtin_amdgcn_s_waitcnt(0);
        unsigned nloc = b.st[0], nx = b.st[1];
        if (nloc == 0u) { xcd_barrier_complete(bar, b.x, nloc, nx); b.st[0] = nloc; b.st[1] = nx; }
        const unsigned old = xb_add(&bar[XB_XSUB(b.x)], 1u);
        const unsigned gen = old / nloc;
        if (old + 1u == (gen + 1u) * nloc) {
            __builtin_amdgcn_fence(__ATOMIC_RELEASE, "agent");
            asm volatile("s_waitcnt vmcnt(0)" ::: "memory");
            const unsigned og = xb_add(&bar[XB_TOP], 1u);
            const unsigned tg = og / nx;
            if (og + 1u == (tg + 1u) * nx) xb_add(&bar[XB_TOPGEN], 1u);
            else XB_SPIN(xb_ld(&bar[XB_TOPGEN]) == tg, bar);
            __builtin_amdgcn_fence(__ATOMIC_ACQUIRE, "agent");
            xb_add(&bar[XB_XGEN(b.x)], 1u);
            asm volatile("s_waitcnt vmcnt(0)" ::: "memory");
        } else {
            XB_SPIN(xb_ld(&bar[XB_XGEN(b.x)]) == gen, bar);
            __builtin_amdgcn_fence(__ATOMIC_ACQUIRE, "agent");
            asm volatile("s_waitcnt vmcnt(0)" ::: "memory");
        }
    }
    __syncthreads();
}


constexpr size_t OFF_BAR = 480 * MiB + 256 * 1024;
constexpr int LDS_BARW = 152 * 1024 - 16;

constexpr int NSTAGE = 15;
#ifndef NP2
#define NP2 1
#endif
#ifndef ABL2
#define ABL2 0
#endif
#ifndef NP3
#define NP3 1
#endif
#ifndef ABL3
#define ABL3 0
#endif
#ifndef NP7
#define NP7 1
#endif
#ifndef NP9
#define NP9 1
#endif
#ifndef NP10
#define NP10 1
#endif
constexpr int NSTG = 11;
template <int S> __device__ __forceinline__ void run_stage(const P& p, float* lds) {
    if constexpr (S == 0) { st_mod(p, lds); st_convert(p, lds); }
    else if constexpr (S == 1) st_hm(p, lds);
    else if constexpr (S == 2) {
#pragma nounroll
        for (int ps = 0; ps < NP2; ++ps) st_inproj_fast(p, (char*)lds, ps == NP2 - 1 ? 0 : ABL2);
    }
    else if constexpr (S == 3) {
#pragma nounroll
        for (int ps = 0; ps < NP3; ++ps) st_dnprep_fast(p, (char*)lds, ps == NP3 - 1 ? 0 : ABL3);
    }
    else if constexpr (S == 4) st_scan_l1(p, (char*)lds);
    else if constexpr (S == 5) {
        if (blockIdx.x < 8) st_scan_l2(p, (char*)lds);
        st_sg_fast(p, (char*)lds, blockIdx.x < 8 ? 248 + (int)blockIdx.x : (int)blockIdx.x - 8, 256);
    }
    else if constexpr (S == 6) st_scan_l3(p, (char*)lds);
    else if constexpr (S == 7) {
#pragma nounroll
        for (int ps = 0; ps < NP7; ++ps) st_post_fast(p, (char*)lds, ps == NP7 - 1);
    }
    else if constexpr (S == 8 || S == 9) {
#pragma nounroll
        for (int ps = 0; ps < (S == 9 ? NP9 : 1); ++ps) st_moe_fast(p, (char*)lds, S == 8 || ps == NP9 - 1, S == 8 ? 1 : 0);
    }
    else if constexpr (S == 10) {
#pragma nounroll
        for (int ps = 0; ps < NP10; ++ps) st_combine(p, ps == NP10 - 1, lds);
    }
}

constexpr int LDS_BYTES = 152 * 1024;

#if !MEGA
template <int S> __global__ void __launch_bounds__(NT) k_stage(P p) {
    extern __shared__ __attribute__((aligned(16))) float lds[];
    run_stage<S>(p, lds);
}
template <int S> static void launch_all(const P& p, int grid, hipStream_t stream) {
    if constexpr (S < NSTG) {
        (void)hipFuncSetAttribute((const void*)k_stage<S>, hipFuncAttributeMaxDynamicSharedMemorySize, LDS_BYTES);
        k_stage<S><<<grid, NT, LDS_BYTES, stream>>>(p);
        launch_all<S + 1>(p, grid, stream);
    }
}
#else
template <int S> __device__ __forceinline__ void run_from(const P& p, float* lds, const XcdBarrier& bar) {
    if constexpr (S < NSTG) {
        run_stage<S>(p, lds);
#ifdef PROBE_REPEAT
        if constexpr (S == PROBE_REPEAT) { xcd_barrier(bar); run_stage<S>(p, lds); }
#endif
        if constexpr (S < NSTG - 1) xcd_barrier(bar);
        run_from<S + 1>(p, lds, bar);
    }
}
__global__ void __launch_bounds__(NT) k_mega(P p) {
    extern __shared__ __attribute__((aligned(16))) float lds[];
    volatile LAS unsigned* st = (volatile LAS unsigned*)((LAS char*)lds + LDS_BARW);
    if (threadIdx.x == 0) { st[0] = 0u; st[1] = 0u; }
    __syncthreads();
    const XcdBarrier bar = xcd_barrier_post((unsigned*)(p.ws + OFF_BAR), st);
#if USE_CG_SYNC
    cg::this_grid().sync();
#endif
    run_from<0>(p, lds, bar);
}
#endif

extern "C" void kernel_launch(void* const* d_in, const int* in_sizes, int n_in, void* d_out, int out_size, void* d_ws, size_t ws_size,
                              hipStream_t stream) {
    if (n_in != 30 || out_size != T * D || ws_size < WS_NEED) {
        fprintf(stderr, "kernel_launch: unexpected problem (n_in %d, out %d, ws %zu)\n", n_in, out_size, ws_size);
        return;
    }
    P p{};
    const float** f = (const float**)&p;
    for (int i = 0; i < 30; ++i) f[i] = (const float*)d_in[i];
    p.out = (float*)d_out;
    p.ws = (char*)d_ws;
    static int grid = 0;
    if (!grid) {
        int dev = 0, cus = 0;
        (void)hipGetDevice(&dev);
        (void)hipDeviceGetAttribute(&cus, hipDeviceAttributeMultiprocessorCount, dev);
#if MEGA
        int per_cu = 0;
        (void)hipFuncSetAttribute((const void*)k_mega, hipFuncAttributeMaxDynamicSharedMemorySize, LDS_BYTES);
        (void)hipOccupancyMaxActiveBlocksPerMultiprocessor(&per_cu, (const void*)k_mega, NT, LDS_BYTES);
        if (per_cu < 1) per_cu = 1;
        if (per_cu > 1) per_cu = 1;
        grid = cus * per_cu;
#else
        grid = cus;
#endif
    }
#if MEGA
    (void)hipMemsetAsync((char*)d_ws + OFF_BAR, 0, XCD_BAR_WORDS * sizeof(unsigned), stream);
    void* args[] = {&p};
    hipError_t e = hipLaunchCooperativeKernel((const void*)k_mega, dim3(grid), dim3(NT), args, LDS_BYTES, stream);
    if (e != hipSuccess) fprintf(stderr, "cooperative launch failed: %s (grid %d)\n", hipGetErrorString(e), grid);
#else
    launch_all<0>(p, grid, stream);
#endif
}
```

```cpp
#include <hip/hip_runtime.h>
#include <hip/hip_cooperative_groups.h>
#include <cstdint>
#include <cstdio>
namespace cg = cooperative_groups;

#ifndef MEGA
#define MEGA 1
#endif
#ifndef USE_CG_SYNC
#define USE_CG_SYNC 1
#endif
#ifndef IN8
#define IN8 2
#endif

constexpr int D = 1024, NBATCH = 2, SEQ = 16384, T = NBATCH * SEQ;
constexpr int INCOLS = 3080;
constexpr int NE = 256, EH = 256;
constexpr int NT = 512;
constexpr int LCAP = 32768;

typedef unsigned short bf16_t;
__device__ __forceinline__ float bf2f(bf16_t v) { return __uint_as_float(((unsigned)v) << 16); }
__device__ __forceinline__ bf16_t f2bf(float f) { unsigned u = __float_as_uint(f); u += 0x7fffu + ((u >> 16) & 1u); return (bf16_t)(u >> 16); }

constexpr size_t MiB = 1024ull * 1024ull;
constexpr size_t OFF_HF     = 384 * MiB;
constexpr size_t OFF_WT_IN8 = 192 * MiB;
constexpr size_t OFF_HM8    = 160 * MiB;
constexpr size_t OFF_SHO    = 320 * MiB;
constexpr size_t OFF_HF8    = 128 * MiB;
constexpr size_t OFF_LISTS  = 448 * MiB;
constexpr size_t OFF_MOD    = 480 * MiB;
constexpr size_t OFF_CNT    = 480 * MiB + 64 * 1024;
constexpr size_t OFF_WAB    = 480 * MiB + 384 * 1024;
constexpr size_t OFF_G      = 481 * MiB;
constexpr size_t OFF_BETA   = 481 * MiB + 512 * 1024;
constexpr size_t OFF_WTS    = 482 * MiB;
constexpr size_t OFF_IDX    = 483 * MiB;
constexpr size_t OFF_CONTRIB= 512 * MiB;
constexpr size_t OFF_GATE   = 512 * MiB;
constexpr size_t OFF_ZS     = 640 * MiB;
constexpr size_t OFF_YSG    = 672 * MiB;
constexpr size_t OFF_O      = 704 * MiB;
constexpr size_t OFF_QKV    = 736 * MiB;
constexpr size_t OFF_UG     = 832 * MiB;
constexpr size_t OFF_VGG    = 864 * MiB;
constexpr size_t OFF_HM     = 896 * MiB;
constexpr size_t OFF_Y      = 800 * MiB;
constexpr size_t OFF_WT_GU  = 0;
constexpr size_t OFF_WT_D   = 256 * MiB;
constexpr size_t OFF_WT_IN  = 484 * MiB;
constexpr size_t OFF_WT_DN  = 494 * MiB;
constexpr size_t OFF_WT_SG  = 495 * MiB;
constexpr size_t OFF_WT_OUT = 496 * MiB;
constexpr size_t OFF_WT_RT  = 498 * MiB;
constexpr size_t OFF_WT_SHGU= 499 * MiB;
constexpr size_t OFF_WT_SHD = 500 * MiB;
constexpr size_t OFF_TRILW  = 501 * MiB;
constexpr size_t OFF_VC     = 960 * MiB;
constexpr size_t OFF_VGN    = 896 * MiB;
constexpr size_t OFF_SCORES = 832 * MiB;
constexpr size_t WS_NEED    = 1024 * MiB;

struct P {
    const float *x, *c, *ada_w, *ada_b, *mix_pre, *mix_post, *w_in, *conv_w, *a_log, *dt_bias, *dn_norm_w, *sg_ln_w, *sg_ln_b,
        *sg_w, *sg_b, *w_bg, *b_bg, *w_pdn, *w_psg, *w_out, *ffn_pre, *ffn_post, *w_router, *router_bias, *w_eg, *w_eu, *w_ed,
        *w_shg, *w_shu, *w_shd;
    float* out;
    char* ws;
};

__device__ __forceinline__ int tidx() { int t = threadIdx.x; asm volatile("" : "+v"(t)); return t; }
__device__ __forceinline__ float wave_sum(float v) {
#pragma unroll
    for (int o = 32; o > 0; o >>= 1) v += __shfl_xor(v, o);
    return v;
}
__device__ __forceinline__ float sigmoid_(float x) { return 1.f / (1.f + expf(-x)); }
__device__ __forceinline__ float silu_(float x) { return x / (1.f + expf(-x)); }
__device__ __forceinline__ float gelu_(float x) { return 0.5f * x * (1.f + erff(x * 0.70710678118654752f)); }
__device__ __forceinline__ float softplus_(float x) { return fmaxf(x, 0.f) + log1pf(expf(-fabsf(x))); }

typedef __bf16 bf2_t __attribute__((ext_vector_type(2)));
typedef float f2_t __attribute__((ext_vector_type(2)));
__device__ __forceinline__ unsigned pk2(float a, float b) { const f2_t v = {a, b}; return __builtin_bit_cast(unsigned, __builtin_convertvector(v, bf2_t)); }
__device__ __forceinline__ uint4 pack8(const float (&v)[8]) { return make_uint4(pk2(v[0], v[1]), pk2(v[2], v[3]), pk2(v[4], v[5]), pk2(v[6], v[7])); }

__device__ __forceinline__ void unpack8(const uint4 u, float (&o)[8]) {
    o[0] = __uint_as_float(u.x << 16); o[1] = __uint_as_float(u.x & 0xffff0000u); o[2] = __uint_as_float(u.y << 16); o[3] = __uint_as_float(u.y & 0xffff0000u);
    o[4] = __uint_as_float(u.z << 16); o[5] = __uint_as_float(u.z & 0xffff0000u); o[6] = __uint_as_float(u.w << 16); o[7] = __uint_as_float(u.w & 0xffff0000u);
}

__device__ __forceinline__ float wave_sum8(const float (&v)[8], int lane) {
    float a[4];
#pragma unroll
    for (int i = 0; i < 4; ++i) { const float keep = (lane & 32) ? v[4 + i] : v[i], send = (lane & 32) ? v[i] : v[4 + i]; a[i] = keep + __shfl_xor(send, 32); }
    float b[2];
#pragma unroll
    for (int i = 0; i < 2; ++i) { const float keep = (lane & 16) ? a[2 + i] : a[i], send = (lane & 16) ? a[i] : a[2 + i]; b[i] = keep + __shfl_xor(send, 16); }
    float c;
    { const float keep = (lane & 8) ? b[1] : b[0], send = (lane & 8) ? b[0] : b[1]; c = keep + __shfl_xor(send, 8); }
    c += __shfl_xor(c, 4); c += __shfl_xor(c, 2); c += __shfl_xor(c, 1);
    return c;
}

template <int TOK, class Epi>
__device__ __forceinline__ void ngemm(const float* As, int K, const float* __restrict__ W, int ldw, int ncols, Epi epi) {
    for (int n = tidx(); n < ncols; n += NT) {
        float acc[TOK];
#pragma unroll
        for (int i = 0; i < TOK; ++i) acc[i] = 0.f;
        const float* wp = W + n;
        for (int k = 0; k < K; k += 4) {
            const float w0 = wp[(size_t)k * ldw], w1 = wp[(size_t)(k + 1) * ldw], w2 = wp[(size_t)(k + 2) * ldw], w3 = wp[(size_t)(k + 3) * ldw];
#pragma unroll
            for (int i = 0; i < TOK; ++i) {
                const float4 a = *(const float4*)(As + i * K + k);
                acc[i] += a.x * w0 + a.y * w1 + a.z * w2 + a.w * w3;
            }
        }
#pragma unroll
        for (int i = 0; i < TOK; ++i) epi(i, n, acc[i]);
    }
}

__device__ void st_mod(const P& p, float* lds) {
    const int tid = tidx(), lane = tid & 63, wid = tid >> 6;
    const int gtid = blockIdx.x * NT + tid, gsz = gridDim.x * NT;
    float* mod = (float*)(p.ws + OFF_MOD);
    for (int task = blockIdx.x; task < 192; task += gridDim.x) {
        const int b = task / 96, j = (task % 96) * 64 + lane;
        float acc = 0.f;
        for (int k = wid * 128; k < wid * 128 + 128; ++k) acc += silu_(p.c[b * 1024 + k]) * p.ada_w[(size_t)k * 6144 + j];
        __syncthreads();
        lds[wid * 64 + lane] = acc;
        __syncthreads();
        if (wid == 0) {
            float s = p.ada_b[j];
#pragma unroll
            for (int w = 0; w < 8; ++w) s += lds[w * 64 + lane];
            mod[b * 6144 + j] = s;
        }
    }
    __syncthreads();
    unsigned* cnt = (unsigned*)(p.ws + OFF_CNT);
    for (int i = gtid; i < NE; i += gsz) cnt[i] = 0u;
    unsigned* zr = (unsigned*)(p.ws + 480 * MiB + 320 * 1024);
    for (int i = gtid; i < 1024; i += gsz) zr[i] = 0u;
    float* wab = (float*)(p.ws + OFF_WAB);
    for (int i = gtid; i < 8192; i += gsz) wab[i] = p.w_in[(size_t)(i & 1023) * INCOLS + 2048 + (i >> 10)];
}

__device__ void st_hm(const P& p, float* lds) {
    const int lane = tidx() & 63, gw = (blockIdx.x * NT + tidx()) >> 6, nw = (gridDim.x * NT) >> 6;
    const float* mod = (const float*)(p.ws + OFF_MOD);
    bf16_t* hm = (bf16_t*)(p.ws + OFF_HM);
    float* gb = (float*)(p.ws + OFF_G);
    float* bb = (float*)(p.ws + OFF_BETA);
    const float* wab = (const float*)(p.ws + OFF_WAB);
    float* lwab = lds;
    float* lA = lds + 8192;
    float* lB = lds + 8192 + 2048;
    __syncthreads();
    for (int i = tidx(); i < 8192; i += NT) lwab[i] = wab[i];
    for (int i = tidx(); i < 2048; i += NT) { const int b = i >> 10, k = i & 1023; lA[i] = p.mix_pre[k] * (1.f + mod[b * 6144 + 1024 + k]); lB[i] = mod[b * 6144 + k]; }
    __syncthreads();
    const int lane0 = lane;
    float4 vnx[4];
#pragma unroll
    for (int i = 0; i < 4; ++i) vnx[i] = (gw < T) ? *(const float4*)(p.x + (size_t)gw * D + i * 256 + lane0 * 4) : make_float4(0.f, 0.f, 0.f, 0.f);
    for (int t = gw; t < T; t += nw) {
        int lane = lane0; asm volatile("" : "+v"(lane));
        const int b = t / SEQ;
        float4 v[4];
        float ss = 0.f;
#pragma unroll
        for (int i = 0; i < 4; ++i) { v[i] = vnx[i]; ss += v[i].x * v[i].x + v[i].y * v[i].y + v[i].z * v[i].z + v[i].w * v[i].w; }
        if (t + nw < T) {
#pragma unroll
            for (int i = 0; i < 4; ++i) vnx[i] = *(const float4*)(p.x + (size_t)(t + nw) * D + i * 256 + lane * 4);
        }
        ss = wave_sum(ss);
        const float rstd = rsqrtf(ss * (1.f / 1024.f) + 1e-6f);
        float ab[8];
#pragma unroll
        for (int q = 0; q < 8; ++q) ab[q] = 0.f;
#pragma unroll
        for (int i = 0; i < 4; ++i) {
            const int k0 = i * 256 + lane * 4;
            const float xv[4] = {v[i].x, v[i].y, v[i].z, v[i].w};
            const float4 mw = *(const float4*)(lA + b * 1024 + k0), sh = *(const float4*)(lB + b * 1024 + k0);
            const float mwa[4] = {mw.x, mw.y, mw.z, mw.w}, sha[4] = {sh.x, sh.y, sh.z, sh.w};
            float h[4];
#pragma unroll
            for (int j = 0; j < 4; ++j) h[j] = xv[j] * rstd * mwa[j] + sha[j];
#pragma unroll
            for (int q = 0; q < 8; ++q) {
                const float4 w4 = *(const float4*)(lwab + q * 1024 + k0);
                ab[q] += h[0] * w4.x + h[1] * w4.y + h[2] * w4.z + h[3] * w4.w;
            }
            if (IN8) {
                int w8 = __builtin_amdgcn_cvt_pk_fp8_f32(h[0], h[1], 0, false); w8 = __builtin_amdgcn_cvt_pk_fp8_f32(h[2], h[3], w8, true);
                *(int*)(p.ws + OFF_HM8 + (size_t)t * D + k0) = w8;
            }
            { ushort4 o; o.x = f2bf(h[0]); o.y = f2bf(h[1]); o.z = f2bf(h[2]); o.w = f2bf(h[3]);
              *(ushort4*)(hm + (size_t)t * D + k0) = o; }
        }
        {
            const float tot = wave_sum8(ab, lane);
            const int q = ((lane >> 5) & 1) * 4 + ((lane >> 4) & 1) * 2 + ((lane >> 3) & 1);
            if ((lane & 7) == 0) {
                if (q < 4) gb[t * 4 + q] = -expf(p.a_log[q]) * softplus_(tot + p.dt_bias[q]);
                else bb[t * 4 + (q - 4)] = sigmoid_(tot);
            }
        }
    }
}

__device__ void st_inproj_naive(const P& p, float* lds) {
    const bf16_t* hm = (const bf16_t*)(p.ws + OFF_HM);
    bf16_t* qkv = (bf16_t*)(p.ws + OFF_QKV); bf16_t* zs = (bf16_t*)(p.ws + OFF_ZS); bf16_t* ug = (bf16_t*)(p.ws + OFF_UG);
    bf16_t* vgg = (bf16_t*)(p.ws + OFF_VGG); bf16_t* gate = (bf16_t*)(p.ws + OFF_GATE);
    for (int tile = blockIdx.x; tile < T / 16; tile += gridDim.x) {
        const int t0 = tile * 16;
        __syncthreads();
        for (int i = tidx(); i < 16 * D; i += NT) lds[i] = bf2f(hm[(size_t)t0 * D + i]);
        __syncthreads();
        ngemm<16>(lds, D, p.w_in, INCOLS, INCOLS, [&](int i, int n, float acc) {
            const size_t t = t0 + i;
            if (n < 1536) qkv[t * 1536 + n] = f2bf(acc);
            else if (n < 2048) zs[t * 512 + (n - 1536)] = f2bf(silu_(acc));
            else if (n < 2056) {}
            else if (n < 2568) ug[t * 512 + (n - 2056)] = f2bf(gelu_(acc));
            else vgg[t * 512 + (n - 2568)] = f2bf(gelu_(acc));
        });
        ngemm<16>(lds, D, p.w_bg, 2048, 2048, [&](int i, int n, float acc) {
            gate[(size_t)(t0 + i) * 2048 + n] = f2bf(sigmoid_(acc + p.b_bg[n]));
        });
    }
}

__device__ void st_dnprep_naive(const P& p) {
    const int lane = tidx() & 63, gw = (blockIdx.x * NT + tidx()) >> 6, nw = (gridDim.x * NT) >> 6;
    const bf16_t* qkv = (const bf16_t*)(p.ws + OFF_QKV);
    float* qn = (p.out); float* kn = (p.out + (size_t)T * 512); float* vc = (float*)(p.ws + OFF_VC);
    for (int u = gw; u < T * 4; u += nw) {
        const int t = u >> 2, h = u & 3, s = t % SEQ;
        float r[3][2];
#pragma unroll
        for (int part = 0; part < 3; ++part)
#pragma unroll
            for (int j = 0; j < 2; ++j) {
                const int col = part * 512 + h * 128 + lane * 2 + j;
                float y = 0.f;
#pragma unroll
                for (int i = 0; i < 4; ++i) {
                    const int sp = s - 3 + i;
                    if (sp >= 0) y += bf2f(qkv[(size_t)(t - 3 + i) * 1536 + col]) * p.conv_w[i * 1536 + col];
                }
                r[part][j] = silu_(y);
            }
        const float qs = wave_sum(r[0][0] * r[0][0] + r[0][1] * r[0][1]);
        const float ks = wave_sum(r[1][0] * r[1][0] + r[1][1] * r[1][1]);
        const float qsc = rsqrtf(qs + 1e-6f) * 0.08838834764831845f, ksc = rsqrtf(ks + 1e-6f);
        const size_t o = (size_t)t * 512 + h * 128 + lane * 2;
        *(float2*)(qn + o) = make_float2(r[0][0] * qsc, r[0][1] * qsc);
        *(float2*)(kn + o) = make_float2(r[1][0] * ksc, r[1][1] * ksc);
        *(float2*)(vc + o) = make_float2(r[2][0], r[2][1]);
    }
}

__device__ void st_dnrec_naive(const P& p) {
    const int lane = tidx() & 63, gw = (blockIdx.x * NT + tidx()) >> 6, nw = (gridDim.x * NT) >> 6;
    const float* qn = (p.out); const float* kn = (p.out + (size_t)T * 512); const float* vc = (const float*)(p.ws + OFF_VC);
    const float* gb = (const float*)(p.ws + OFF_G); const float* bb = (const float*)(p.ws + OFF_BETA);
    bf16_t* ob = (bf16_t*)(p.ws + OFF_O);
    for (int u = gw; u < NBATCH * 4 * 128; u += nw) {
        const int b = u >> 9, h = (u >> 7) & 3, vcol = u & 127;
        float S0 = 0.f, S1 = 0.f;
        size_t t = (size_t)b * SEQ;
        float2 kk = *(const float2*)(kn + t * 512 + h * 128 + 2 * lane);
        float2 qq = *(const float2*)(qn + t * 512 + h * 128 + 2 * lane);
        float vv = vc[t * 512 + h * 128 + vcol], g = gb[t * 4 + h], be = bb[t * 4 + h];
        for (int s = 0; s < SEQ; ++s, ++t) {
            float2 kk2 = kk, qq2 = qq; float vv2 = vv, g2 = g, be2 = be;
            if (s + 1 < SEQ) {
                const size_t tn = t + 1;
                kk2 = *(const float2*)(kn + tn * 512 + h * 128 + 2 * lane);
                qq2 = *(const float2*)(qn + tn * 512 + h * 128 + 2 * lane);
                vv2 = vc[tn * 512 + h * 128 + vcol]; g2 = gb[tn * 4 + h]; be2 = bb[tn * 4 + h];
            }
            const float a = expf(g);
            const float dk = wave_sum(kk.x * S0 + kk.y * S1);
            const float dq = wave_sum(qq.x * S0 + qq.y * S1);
            const float qk = wave_sum(qq.x * kk.x + qq.y * kk.y);
            const float vnew = be * (vv - a * dk);
            const float o = a * dq + qk * vnew;
            S0 = a * S0 + kk.x * vnew; S1 = a * S1 + kk.y * vnew;
            if (lane == 0) ob[t * 512 + h * 128 + vcol] = f2bf(o);
            kk = kk2; qq = qq2; vv = vv2; g = g2; be = be2;
        }
    }
}

__device__ void st_sgln_naive(const P& p) {
    const int lane = tidx() & 63, gw = (blockIdx.x * NT + tidx()) >> 6, nw = (gridDim.x * NT) >> 6;
    const bf16_t* vgg = (const bf16_t*)(p.ws + OFF_VGG);
    float* vgn = (float*)(p.ws + OFF_VGN);
    for (int t = gw; t < T; t += nw) {
        float v[8]; float s = 0.f;
#pragma unroll
        for (int j = 0; j < 8; ++j) { v[j] = bf2f(vgg[(size_t)t * 512 + j * 64 + lane]); s += v[j]; }
        const float mu = wave_sum(s) * (1.f / 512.f);
        float q = 0.f;
#pragma unroll
        for (int j = 0; j < 8; ++j) { const float d = v[j] - mu; q += d * d; }
        const float rstd = rsqrtf(wave_sum(q) * (1.f / 512.f) + 1e-6f);
#pragma unroll
        for (int j = 0; j < 8; ++j) { const int c = j * 64 + lane; vgn[(size_t)t * 512 + c] = (v[j] - mu) * rstd * p.sg_ln_w[c] + p.sg_ln_b[c]; }
    }
}
__device__ void st_sgmix_naive(const P& p) {
    const int gtid = blockIdx.x * NT + tidx(), gsz = gridDim.x * NT;
    const float* vgn = (const float*)(p.ws + OFF_VGN);
    const bf16_t* ug = (const bf16_t*)(p.ws + OFF_UG);
    bf16_t* ysg = (bf16_t*)(p.ws + OFF_YSG);
    for (int i = gtid; i < T * 512; i += gsz) {
        const int t = i >> 9, c = i & 511, g = c >> 7, tt = t & 127, t0 = t - tt;
        const float* w = p.sg_w + ((size_t)g * 128 + tt) * 128;
        float acc = p.sg_b[g * 128 + tt];
        for (int s = 0; s <= tt; ++s) acc += w[s] * vgn[(size_t)(t0 + s) * 512 + c];
        ysg[i] = f2bf(bf2f(ug[i]) * acc);
    }
}

__device__ __forceinline__ void ydn_unit(const P& p, int u, int lane) {
    bf16_t* ob = (bf16_t*)(p.ws + OFF_O); const bf16_t* zs = (const bf16_t*)(p.ws + OFF_ZS);
    const size_t base = (size_t)(u >> 2) * 512 + (u & 3) * 128 + lane * 2;
    const float o0 = bf2f(ob[base]), o1 = bf2f(ob[base + 1]);
    const float rstd = rsqrtf(wave_sum(o0 * o0 + o1 * o1) * (1.f / 128.f) + 1e-6f);
    ob[base] = f2bf(o0 * rstd * p.dn_norm_w[lane * 2] * bf2f(zs[base]));
    ob[base + 1] = f2bf(o1 * rstd * p.dn_norm_w[lane * 2 + 1] * bf2f(zs[base + 1]));
}
__device__ __forceinline__ void ydn_token(const P& p, int t, int lane) {
    bf16_t* ob = (bf16_t*)(p.ws + OFF_O); const bf16_t* zs = (const bf16_t*)(p.ws + OFF_ZS);
    const float2 nw = *(const float2*)(p.dn_norm_w + lane * 2);
    unsigned ov[4], zv[4]; float ss[4];
#pragma unroll
    for (int h = 0; h < 4; ++h) { const size_t base = (size_t)t * 512 + h * 128 + lane * 2; ov[h] = *(const unsigned*)(ob + base); zv[h] = *(const unsigned*)(zs + base); }
#pragma unroll
    for (int h = 0; h < 4; ++h) { const float o0 = __uint_as_float(ov[h] << 16), o1 = __uint_as_float(ov[h] & 0xffff0000u); ss[h] = o0 * o0 + o1 * o1; }
#pragma unroll
    for (int o = 32; o > 0; o >>= 1) {
#pragma unroll
        for (int h = 0; h < 4; ++h) ss[h] += __shfl_xor(ss[h], o);
    }
#pragma unroll
    for (int h = 0; h < 4; ++h) {
        const float rstd = rsqrtf(ss[h] * (1.f / 128.f) + 1e-6f);
        const float o0 = __uint_as_float(ov[h] << 16), o1 = __uint_as_float(ov[h] & 0xffff0000u);
        *(unsigned*)(ob + (size_t)t * 512 + h * 128 + lane * 2) = pk2(o0 * rstd * nw.x * __uint_as_float(zv[h] << 16), o1 * rstd * nw.y * __uint_as_float(zv[h] & 0xffff0000u));
    }
}
__device__ void st_ydn_naive(const P& p) {
    const int lane = tidx() & 63, gw = (blockIdx.x * NT + tidx()) >> 6, nw = (gridDim.x * NT) >> 6;
    for (int u = gw; u < T * 4; u += nw) ydn_unit(p, u, lane);
}
__device__ void st_merged_naive(const P& p, float* lds) {
    const bf16_t* ydn = (const bf16_t*)(p.ws + OFF_O); const bf16_t* ysg = (const bf16_t*)(p.ws + OFF_YSG);
    const bf16_t* gate = (const bf16_t*)(p.ws + OFF_GATE);
    float* mg = (p.out);
    float* A1 = lds; float* A2 = lds + 16 * 512;
    for (int tile = blockIdx.x; tile < T / 16; tile += gridDim.x) {
        const int t0 = tile * 16;
        __syncthreads();
        for (int i = tidx(); i < 16 * 512; i += NT) { A1[i] = bf2f(ydn[(size_t)t0 * 512 + i]); A2[i] = bf2f(ysg[(size_t)t0 * 512 + i]); }
        __syncthreads();
        ngemm<16>(A1, 512, p.w_pdn, D, D, [&](int i, int n, float acc) { const size_t t = t0 + i; mg[t * D + n] = bf2f(gate[t * 2048 + n]) * acc; });
        ngemm<16>(A2, 512, p.w_psg, D, D, [&](int i, int n, float acc) { const size_t t = t0 + i; mg[t * D + n] += bf2f(gate[t * 2048 + 1024 + n]) * acc; });
    }
}
__device__ void st_wout_naive(const P& p, float* lds) {
    const float* mg = (p.out);
    float* y = (float*)(p.ws + OFF_Y);
    for (int tile = blockIdx.x; tile < T / 16; tile += gridDim.x) {
        const int t0 = tile * 16;
        __syncthreads();
        for (int i = tidx(); i < 16 * D; i += NT) lds[i] = mg[(size_t)t0 * D + i];
        __syncthreads();
        ngemm<16>(lds, D, p.w_out, D, D, [&](int i, int n, float acc) { y[(size_t)(t0 + i) * D + n] = acc; });
    }
}
__device__ __forceinline__ void x1hf_row(const P& p, int t, int lane, const float* lv) {
    const bf16_t* y = (const bf16_t*)(p.ws + OFF_Y);
    bf16_t* hf = (bf16_t*)(p.ws + OFF_HF);
    float4 yv[4]; float ss = 0.f;
#pragma unroll
    for (int i = 0; i < 4; ++i) {
        const uint2 u = *(const uint2*)(y + (size_t)t * D + i * 256 + lane * 4);
        yv[i] = make_float4(__uint_as_float(u.x << 16), __uint_as_float(u.x & 0xffff0000u), __uint_as_float(u.y << 16), __uint_as_float(u.y & 0xffff0000u));
        ss += yv[i].x * yv[i].x + yv[i].y * yv[i].y + yv[i].z * yv[i].z + yv[i].w * yv[i].w;
    }
    float4 xv[4];
#pragma unroll
    for (int i = 0; i < 4; ++i) xv[i] = *(const float4*)(p.x + (size_t)t * D + i * 256 + lane * 4);
    const float rstd = rsqrtf(wave_sum(ss) * (1.f / 1024.f) + 1e-6f);
    float4 x1[4]; float s2 = 0.f;
#pragma unroll
    for (int i = 0; i < 4; ++i) {
        const int k0 = i * 256 + lane * 4;
        const float4 gm = *(const float4*)(lv + k0);
        float4 v;
        v.x = xv[i].x + gm.x * (yv[i].x * rstd); v.y = xv[i].y + gm.y * (yv[i].y * rstd);
        v.z = xv[i].z + gm.z * (yv[i].z * rstd); v.w = xv[i].w + gm.w * (yv[i].w * rstd);
        x1[i] = v; s2 += v.x * v.x + v.y * v.y + v.z * v.z + v.w * v.w;
        *(float4*)(p.out + (size_t)t * D + k0) = v;
    }
    const float rstd2 = rsqrtf(wave_sum(s2) * (1.f / 1024.f) + 1e-6f);
#pragma unroll
    for (int i = 0; i < 4; ++i) {
        const int k0 = i * 256 + lane * 4;
        const float4 fp = *(const float4*)(lv + 1024 + k0), sh = *(const float4*)(lv + 2048 + k0);
        const float h0 = x1[i].x * rstd2 * fp.x + sh.x, h1 = x1[i].y * rstd2 * fp.y + sh.y;
        const float h2 = x1[i].z * rstd2 * fp.z + sh.z, h3 = x1[i].w * rstd2 * fp.w + sh.w;
        uint2 o;
        o.x = pk2(h0, h1); o.y = pk2(h2, h3);
        *(uint2*)(hf + (size_t)t * D + k0) = o;
        int w8 = __builtin_amdgcn_cvt_pk_fp8_f32(h0, h1, 0, false); w8 = __builtin_amdgcn_cvt_pk_fp8_f32(h2, h3, w8, true);
        *(int*)(p.ws + OFF_HF8 + (size_t)t * D + k0) = w8;
    }
}
__device__ void st_router_naive(const P& p, float* lds) {
    const bf16_t* hf = (const bf16_t*)(p.ws + OFF_HF);
    float* sc = (float*)(p.ws + OFF_SCORES);
    for (int tile = blockIdx.x; tile < T / 16; tile += gridDim.x) {
        const int t0 = tile * 16;
        __syncthreads();
        for (int i = tidx(); i < 16 * D; i += NT) lds[i] = bf2f(hf[(size_t)t0 * D + i]);
        __syncthreads();
        ngemm<16>(lds, D, p.w_router, NE, NE, [&](int i, int n, float acc) { sc[(size_t)(t0 + i) * NE + n] = sigmoid_(acc); });
    }
}
__device__ void st_topk_naive(const P& p) {
    const int gtid = blockIdx.x * NT + tidx(), gsz = gridDim.x * NT;
    const float* sc = (const float*)(p.ws + OFF_SCORES);
    unsigned* cnt = (unsigned*)(p.ws + OFF_CNT);
    int* lists = (int*)(p.ws + OFF_LISTS);
    float* wts = (float*)(p.ws + OFF_WTS); int* idxo = (int*)(p.ws + OFF_IDX);
    for (int t = gtid; t < T; t += gsz) {
        const float* s = sc + (size_t)t * NE;
        float gs[8];
#pragma unroll
        for (int g = 0; g < 8; ++g) {
            float m1 = -INFINITY, m2 = -INFINITY;
            for (int j = 0; j < 32; ++j) { const float v = s[g * 32 + j] + p.router_bias[g * 32 + j]; if (v > m1) { m2 = m1; m1 = v; } else if (v > m2) m2 = v; }
            gs[g] = m1 + m2;
        }
        unsigned gmask = 0;
#pragma unroll
        for (int g = 0; g < 8; ++g) {
            int rank = 0;
#pragma unroll
            for (int h = 0; h < 8; ++h) rank += (gs[h] > gs[g] || (gs[h] == gs[g] && h < g)) ? 1 : 0;
            if (rank < 4) gmask |= 1u << g;
        }
        float pv = INFINITY; int pi = -1;
        int sel[8]; float sw[8]; float wsum = 0.f;
#pragma unroll
        for (int k = 0; k < 8; ++k) {
            float bv = -INFINITY; int bi = 0;
            for (int e = 0; e < NE; ++e) {
                if (!((gmask >> (e >> 5)) & 1u)) continue;
                const float v = s[e] + p.router_bias[e];
                const bool elig = (v < pv) || (v == pv && e > pi);
                if (elig && v > bv) { bv = v; bi = e; }
            }
            pv = bv; pi = bi; sel[k] = bi; sw[k] = s[bi]; wsum += sw[k];
        }
        const float inv = 2.5f / wsum;
#pragma unroll
        for (int k = 0; k < 8; ++k) {
            const int e = sel[k];
            const unsigned pos = atomicAdd(&cnt[e], 1u);
            lists[(size_t)e * LCAP + pos] = t * 8 + k;
            wts[t * 8 + k] = sw[k] * inv; idxo[t * 8 + k] = e;
        }
    }
}

__device__ void st_shared_naive(const P& p, float* lds) {
    const bf16_t* hf = (const bf16_t*)(p.ws + OFF_HF);
    bf16_t* contrib = (bf16_t*)(p.ws + OFF_CONTRIB);
    float* A = lds; float* G = lds + 16 * D; float* H = G + 16 * EH;
    for (int tile = blockIdx.x; tile < T / 16; tile += gridDim.x) {
        const int t0 = tile * 16;
        __syncthreads();
        for (int i = tidx(); i < 16 * D; i += NT) A[i] = bf2f(hf[(size_t)t0 * D + i]);
        __syncthreads();
        ngemm<16>(A, D, p.w_shg, EH, EH, [&](int i, int n, float acc) { G[i * EH + n] = acc; });
        ngemm<16>(A, D, p.w_shu, EH, EH, [&](int i, int n, float acc) { H[i * EH + n] = silu_(G[i * EH + n]) * acc; });
        __syncthreads();
        ngemm<16>(H, EH, p.w_shd, D, D, [&](int i, int n, float acc) { contrib[((size_t)(t0 + i) * 8) * D + n] = f2bf(acc); });
    }
}
__device__ void st_experts_naive(const P& p, float* lds) {
    const bf16_t* hf = (const bf16_t*)(p.ws + OFF_HF);
    bf16_t* contrib = (bf16_t*)(p.ws + OFF_CONTRIB);
    const unsigned* cnt = (const unsigned*)(p.ws + OFF_CNT);
    const int* lists = (const int*)(p.ws + OFF_LISTS);
    const float* wts = (const float*)(p.ws + OFF_WTS);
    float* A = lds; float* G = lds + 16 * D; float* H = G + 16 * EH;
    int* ent = (int*)(H + 16 * EH);
    int* tstart = ent + 16;
    __syncthreads();
    if (tidx() == 0) { int acc = 0; for (int e = 0; e < NE; ++e) { tstart[e] = acc; acc += ((int)cnt[e] + 15) >> 4; } tstart[NE] = acc; }
    __syncthreads();
    const int ntiles = tstart[NE];
    int e = 0;
    for (int tile = blockIdx.x; tile < ntiles; tile += gridDim.x) {
        while (tstart[e + 1] <= tile) ++e;
        const int r0 = (tile - tstart[e]) * 16, ce = (int)cnt[e];
        __syncthreads();
        if (tidx() < 16) ent[tidx()] = (r0 + (int)tidx() < ce) ? lists[(size_t)e * LCAP + r0 + tidx()] : -1;
        __syncthreads();
        for (int i = tidx(); i < 16 * D; i += NT) { const int en = ent[i >> 10]; A[i] = en >= 0 ? bf2f(hf[(size_t)(en >> 3) * D + (i & 1023)]) : 0.f; }
        __syncthreads();
        ngemm<16>(A, D, p.w_eg + (size_t)e * D * EH, EH, EH, [&](int i, int n, float acc) { G[i * EH + n] = acc; });
        ngemm<16>(A, D, p.w_eu + (size_t)e * D * EH, EH, EH, [&](int i, int n, float acc) { H[i * EH + n] = silu_(G[i * EH + n]) * acc; });
        __syncthreads();
        ngemm<16>(H, EH, p.w_ed + (size_t)e * EH * D, D, D, [&](int i, int n, float acc) {
            const int en = ent[i];
            if (en >= 0) {
                float v = acc * wts[en];
                bf16_t* dst = contrib + (size_t)en * D + n;
                if ((en & 7) == 0) v += bf2f(*dst);
                *dst = f2bf(v);
            }
        });
    }
}
constexpr float C8_SCALE = 16.f, C8_INV = 1.f / 16.f;
__device__ void st_combine(const P& p, bool fin, float* lds) {
    const int lane0 = tidx() & 63, gw = (blockIdx.x * NT + tidx()) >> 6, nw = (gridDim.x * NT) >> 6;
    const float* mod = (const float*)(p.ws + OFF_MOD);
    const unsigned char* contrib = (const unsigned char*)(p.ws + OFF_CONTRIB);
    __syncthreads();
    for (int i = tidx(); i < 2048; i += NT) lds[i] = mod[(i >> 10) * 6144 + 5120 + (i & 1023)] * p.ffn_post[i & 1023];
    __syncthreads();
    for (int t = gw; t < T; t += nw) {
        int lane = lane0; asm volatile("" : "+v"(lane));
        const int b = t / SEQ;
        uint4 cv[8];
#pragma unroll
        for (int k = 0; k < 8; ++k) cv[k] = *(const uint4*)(contrib + ((size_t)t * 8 + k) * D + lane * 16);
        const bf16_t* sr = (const bf16_t*)(p.ws + OFF_SHO) + (size_t)t * D + lane * 16;
        const uint4 s0 = *(const uint4*)sr, s1 = *(const uint4*)(sr + 8);
        float4 xv[4];
#pragma unroll
        for (int q = 0; q < 4; ++q) xv[q] = *(const float4*)(p.out + (size_t)t * D + lane * 16 + q * 4);
        float y[16], r[16];
#pragma unroll
        for (int i = 0; i < 16; ++i) r[i] = 0.f;
#pragma unroll
        for (int k = 0; k < 8; ++k) {
            const unsigned w[4] = {cv[k].x, cv[k].y, cv[k].z, cv[k].w};
#pragma unroll
            for (int q = 0; q < 4; ++q) {
                const auto lo = __builtin_amdgcn_cvt_pk_f32_fp8((int)w[q], false), hi = __builtin_amdgcn_cvt_pk_f32_fp8((int)w[q], true);
                r[q * 4] += lo[0]; r[q * 4 + 1] += lo[1]; r[q * 4 + 2] += hi[0]; r[q * 4 + 3] += hi[1];
            }
        }
        { float v8[8]; unpack8(s0, v8);
#pragma unroll
          for (int j = 0; j < 8; ++j) y[j] = v8[j] + r[j] * C8_INV;
          unpack8(s1, v8);
#pragma unroll
          for (int j = 0; j < 8; ++j) y[8 + j] = v8[j] + r[8 + j] * C8_INV; }
        float ss = 0.f;
#pragma unroll
        for (int i = 0; i < 16; ++i) ss += y[i] * y[i];
        const float rstd = rsqrtf(wave_sum(ss) * (1.f / 1024.f) + 1e-6f);
#pragma unroll
        for (int q = 0; q < 4; ++q) {
            const int k0 = lane * 16 + q * 4;
            const float4 g2 = *(const float4*)(lds + b * 1024 + k0);
            float4 o = xv[q];
            o.x += g2.x * (y[q * 4] * rstd); o.y += g2.y * (y[q * 4 + 1] * rstd);
            o.z += g2.z * (y[q * 4 + 2] * rstd); o.w += g2.w * (y[q * 4 + 3] * rstd);
            if (fin) *(float4*)(p.out + (size_t)t * D + k0) = o;
            else if (o.x == 12345.678f) *(float4*)(p.out + (size_t)t * D + k0) = o;
        }
    }
}

typedef short bf16x8 __attribute__((ext_vector_type(8)));
typedef float f32x4 __attribute__((ext_vector_type(4)));

__device__ __forceinline__ float fexp_(float x) { return __builtin_amdgcn_exp2f(x * 1.4426950408889634f); }
__device__ __forceinline__ float fsigmoid_(float x) { return __builtin_amdgcn_rcpf(1.f + fexp_(-x)); }
__device__ __forceinline__ float fsilu_(float x) { return x * fsigmoid_(x); }
__device__ __forceinline__ float fgelu_(float v) {
    const float av = fabsf(v), t = __builtin_amdgcn_rcpf(av * 0.2316418882f + 1.0f);
    float q = t * 0.5307027145f + (-0.7265760135f); q = q * t + 0.7107068705f; q = q * t + (-0.142248368f); q = q * t + 0.127414796f; q = q * t;
    const float e = __builtin_amdgcn_exp2f((v * v) * (-0.72134752044f));
    const float m = v * (q * e);
    return v < 0.f ? m : v - m;
}

constexpr float W8_SCALE = 32.f, W8_INV = 1.f / 32.f;
struct CTile { const float* src; char* dst; int ld, ldd, esz; };
__device__ __forceinline__ CTile conv_decode(const P& p, int id) {
    const int NDENSE = 2048;
    const float* src; int ld, K, cb, kt, colbase = 0, esz = 2; char* dst; int drow0;
    if (id < NDENSE) {
        int r = id;
        if (r < 512) { src = p.w_in; ld = INCOLS; K = 1024; cb = r >> 3; kt = r & 7; dst = p.ws + (IN8 == 2 ? OFF_WT_IN8 : OFF_WT_IN); drow0 = cb * 32; esz = IN8 == 2 ? 1 : 2; }
        else if ((r -= 512) < 256) { src = p.w_in; ld = INCOLS; K = 1024; cb = r >> 3; kt = r & 7; colbase = 2056; dst = p.ws + (IN8 ? OFF_WT_IN8 : OFF_WT_IN); drow0 = 2048 + cb * 32; esz = IN8 ? 1 : 2; }
        else if ((r -= 256) < 512) { src = p.w_bg; ld = 2048; K = 1024; cb = r >> 3; kt = r & 7; dst = p.ws + (IN8 ? OFF_WT_IN8 : OFF_WT_IN); drow0 = 3072 + cb * 32; esz = IN8 ? 1 : 2; }
        else if ((r -= 512) < 128) { src = p.w_pdn; ld = 1024; K = 512; cb = r >> 2; kt = r & 3; dst = p.ws + OFF_WT_DN; drow0 = cb * 32; }
        else if ((r -= 128) < 128) { src = p.w_psg; ld = 1024; K = 512; cb = r >> 2; kt = r & 3; dst = p.ws + OFF_WT_SG; drow0 = cb * 32; }
        else if ((r -= 128) < 256) { src = p.w_out; ld = 1024; K = 1024; cb = r >> 3; kt = r & 7; dst = p.ws + OFF_WT_OUT; drow0 = cb * 32; }
        else if ((r -= 256) < 64) { src = p.w_router; ld = 256; K = 1024; cb = r >> 3; kt = r & 7; dst = p.ws + OFF_WT_RT; drow0 = cb * 32; }
        else if ((r -= 64) < 128) { const int pp = r >> 6; r &= 63; src = pp ? p.w_shu : p.w_shg; ld = 256; K = 1024; cb = r >> 3; kt = r & 7; dst = p.ws + OFF_WT_SHGU; drow0 = (cb >> 2) * 256 + (cb & 3) * 64 + pp * 32; esz = 1; }
        else { r -= 128; src = p.w_shd; ld = 1024; K = 256; cb = r >> 1; kt = r & 1; dst = p.ws + OFF_WT_SHD; drow0 = cb * 32; esz = 1; }
    } else {
        const int r = id - NDENSE, m = r / (256 * 64), e = (r >> 6) & 255, tl = r & 63;
        esz = 1;
        if (m < 2) { src = (m ? p.w_eu : p.w_eg) + (size_t)e * 1024 * 256; ld = 256; K = 1024; cb = tl >> 3; kt = tl & 7;
                     dst = p.ws + OFF_WT_GU + (size_t)e * 512 * 1024; drow0 = (cb >> 2) * 256 + (cb & 3) * 64 + m * 32; }
        else { src = p.w_ed + (size_t)e * 256 * 1024; ld = 1024; K = 256; cb = tl >> 1; kt = tl & 1; dst = p.ws + OFF_WT_D + (size_t)e * 1024 * 256; drow0 = cb * 32; }
    }
    CTile t; t.src = src + (size_t)(kt * 128) * ld + colbase + cb * 32; t.dst = dst + ((size_t)drow0 * K + kt * 128) * esz; t.ld = ld; t.ldd = K * esz; t.esz = esz;
    return t;
}
__device__ __forceinline__ uint2 pack8_fp8(const float (&v)[8]) {
    int w0 = __builtin_amdgcn_cvt_pk_fp8_f32(v[0], v[1], 0, false); w0 = __builtin_amdgcn_cvt_pk_fp8_f32(v[2], v[3], w0, true);
    int w1 = __builtin_amdgcn_cvt_pk_fp8_f32(v[4], v[5], 0, false); w1 = __builtin_amdgcn_cvt_pk_fp8_f32(v[6], v[7], w1, true);
    return make_uint2((unsigned)w0, (unsigned)w1);
}
__device__ void st_convert(const P& p, float* lds) {
    const int tid = tidx();
    const int NTOT = 2048 + 3 * 256 * 64;
    float4 v[4][2];
    auto issue = [&](int base) {
#pragma unroll
        for (int j = 0; j < 4; ++j) {
            const CTile t = conv_decode(p, base + j);
#pragma unroll
            for (int i = 0; i < 2; ++i) v[j][i] = *(const float4*)(t.src + (size_t)((tid >> 3) + 64 * i) * t.ld + (tid & 7) * 4);
        }
    };
    if (blockIdx.x * 4 < NTOT) issue(blockIdx.x * 4);
    for (int base = blockIdx.x * 4; base < NTOT; base += gridDim.x * 4) {
        __syncthreads();
#pragma unroll
        for (int j = 0; j < 4; ++j)
#pragma unroll
            for (int i = 0; i < 2; ++i) {
                float* d = lds + j * (128 * 33) + ((tid >> 3) + 64 * i) * 33 + (tid & 7) * 4;
                d[0] = v[j][i].x; d[1] = v[j][i].y; d[2] = v[j][i].z; d[3] = v[j][i].w;
            }
        __syncthreads();
        if (base + (int)gridDim.x * 4 < NTOT) issue(base + gridDim.x * 4);
#pragma unroll
        for (int j = 0; j < 4; ++j) {
            const CTile t = conv_decode(p, base + j);
            const int n = tid >> 4, kc = tid & 15;
            float o[8];
#pragma unroll
            for (int q = 0; q < 8; ++q) o[q] = lds[j * (128 * 33) + (kc * 8 + q) * 33 + n];
            if (t.esz == 2) *(uint4*)(t.dst + (size_t)n * t.ldd + kc * 16) = pack8(o);
            else {
#pragma unroll
                for (int q = 0; q < 8; ++q) o[q] *= W8_SCALE;
                *(uint2*)(t.dst + (size_t)n * t.ldd + kc * 8) = pack8_fp8(o);
            }
        }
    }
    __syncthreads();
    bf16_t* tw = (bf16_t*)(p.ws + OFF_TRILW);
    for (int i = blockIdx.x * NT + tidx(); i < 4 * 128 * 128; i += gridDim.x * NT) { const int t = (i >> 7) & 127, s = i & 127; tw[i] = s <= t ? f2bf(p.sg_w[i]) : (bf16_t)0; }
}

constexpr int XT_BYTES = 128 * 128, WT_BYTES = 256 * 128, STG_BYTES = XT_BYTES + WT_BYTES;
constexpr size_t OFF_ZERO = 480 * MiB + 320 * 1024;
#define LAS3 __attribute__((address_space(3)))

template <class F> __device__ __forceinline__ void epi_each(const f32x4 (&acc)[4][4], F f) {
    const int lane = tidx() & 63, wid = tidx() >> 6, wr = wid >> 2, wc = wid & 3, fr = lane & 15, fg = lane >> 4;
#pragma unroll
    for (int mi = 0; mi < 4; ++mi)
#pragma unroll
        for (int pp = 0; pp < 2; ++pp) {
            const float v[8] = {acc[mi][2 * pp][0], acc[mi][2 * pp][1], acc[mi][2 * pp][2], acc[mi][2 * pp][3],
                                acc[mi][2 * pp + 1][0], acc[mi][2 * pp + 1][1], acc[mi][2 * pp + 1][2], acc[mi][2 * pp + 1][3]};
            f(wr * 64 + mi * 16 + fr, wc * 64 + pp * 32 + 8 * fg, v);
        }
}

__device__ __forceinline__ uint4 dpp_ror8(const uint4 v) {
    uint4 r;
    r.x = (unsigned)__builtin_amdgcn_update_dpp(0, (int)v.x, 0x128, 0xf, 0xf, false); r.y = (unsigned)__builtin_amdgcn_update_dpp(0, (int)v.y, 0x128, 0xf, 0xf, false);
    r.z = (unsigned)__builtin_amdgcn_update_dpp(0, (int)v.z, 0x128, 0xf, 0xf, false); r.w = (unsigned)__builtin_amdgcn_update_dpp(0, (int)v.w, 0x128, 0xf, 0xf, false);
    return r;
}
template <class F, class G> __device__ __forceinline__ void epi_rows(const f32x4 (&acc)[4][4], F f, G st) {
    const int lane = tidx() & 63, wid = tidx() >> 6, wr = wid >> 2, wc = wid & 3, fr = lane & 15, fg = lane >> 4;
    const bool lo = fr < 8;
#pragma unroll
    for (int mi = 0; mi < 4; ++mi) {
        const float a0[8] = {acc[mi][0][0], acc[mi][0][1], acc[mi][0][2], acc[mi][0][3], acc[mi][1][0], acc[mi][1][1], acc[mi][1][2], acc[mi][1][3]};
        const float a1[8] = {acc[mi][2][0], acc[mi][2][1], acc[mi][2][2], acc[mi][2][3], acc[mi][3][0], acc[mi][3][1], acc[mi][3][2], acc[mi][3][3]};
        const int r = wr * 64 + mi * 16 + fr, c0 = wc * 64 + 8 * fg;
        const uint4 A = f(r, c0, a0), B = f(r, c0 + 32, a1);
        const uint4 Bs = dpp_ror8(B);
        const int rb = wr * 64 + mi * 16 + (fr & 7);
        st(rb, lo ? c0 : c0 + 32, lo ? A : Bs);
        st(rb + 8, lo ? c0 + 32 : c0, lo ? Bs : A);
    }
}

template <bool A_LDS, int ESTORES, class RowPtr, class WPtr, class Epi>
__device__ __forceinline__ void gemm_panel(RowPtr rp, const char* Hs, int hstride, WPtr wp, int ldw, int nk, int nv, char* stage, Epi epi) {
    const int tid = tidx(), lane = tid & 63, wid = tid >> 6, wr = wid >> 2, wc = wid & 3, fr = lane & 15, fg = lane >> 4;
    constexpr int XOFF = A_LDS ? 0 : XT_BYTES, BUFB = A_LDS ? WT_BYTES : STG_BYTES;
    const int l8 = lane >> 3, kcl = ((lane & 7) ^ l8) * 8;
    auto gload = [&](int v, int kt, int buf) {
        char* b = stage + buf * BUFB + lane * 16;
        const int k0 = kt * 64 + kcl;
        if constexpr (!A_LDS) {
#pragma unroll
            for (int i = 0; i < 2; ++i) {
                const int q = wid + 8 * i;
                __builtin_amdgcn_global_load_lds((const unsigned*)(rp(v, q * 8 + l8) + k0), (LAS3 unsigned*)(b + q * 1024), 16, 0, 0);
            }
        }
        const bf16_t* wb = wp(v) + k0;
#pragma unroll
        for (int i = 0; i < 4; ++i) {
            const int q = wid + 8 * i, rho = q * 8 + l8, ii = rho & 15;
            const int n = (rho & ~31) + 8 * (ii >> 2) + (ii & 3) + ((rho >> 2) & 4);
            __builtin_amdgcn_global_load_lds((const unsigned*)(wb + (size_t)n * ldw), (LAS3 unsigned*)(b + XOFF + q * 1024), 16, 0, 0);
        }
    };
    const int S = nk * nv;
    constexpr int NST = A_LDS ? 2 : 3;
    gload(0, 0, 0);
    if constexpr (NST == 3) { if (S > 1) gload(nk > 1 ? 0 : 1, nk > 1 ? 1 : 0, 1); }
    f32x4 acc[4][4];
    int v = 0, kt = 0;
    int vp = 0, ktp = 0;
#pragma unroll
    for (int i = 0; i < NST - 1; ++i) { if (++ktp == nk) { ktp = 0; ++vp; } }
    int bufc = 0, bufp = NST - 1;
    const int xc0 = (fg ^ (fr & 7)) * 16;
    const int wrow_off = (wc * 64 + fr) * 128;
    const int xrow_off = (wr * 64 + fr) * 128;
    bool pend = false; int vpend = 0;
    int since = 2;
    for (int s = 0; s < S; ++s) {
        if (NST == 3 && s + 1 < S) {
            if constexpr (A_LDS) asm volatile("s_waitcnt vmcnt(4)" ::: "memory");
            else if (ESTORES > 0 && since < 2) asm volatile("s_waitcnt vmcnt(%0)" :: "n"(6 + ESTORES) : "memory");
            else asm volatile("s_waitcnt vmcnt(6)" ::: "memory");
        }
        else asm volatile("s_waitcnt vmcnt(0)" ::: "memory");
        __builtin_amdgcn_s_barrier();
        if (pend) { epi(vpend, acc); pend = false; }
        if (s + NST - 1 < S) gload(vp, ktp, bufp);
        if (kt == 0) {
#pragma unroll
            for (int mi = 0; mi < 4; ++mi)
#pragma unroll
                for (int ni = 0; ni < 4; ++ni) acc[mi][ni] = (f32x4){0.f, 0.f, 0.f, 0.f};
        }
        const char* b = stage + bufc * BUFB;
#pragma unroll
        for (int ks = 0; ks < 2; ++ks) {
            bf16x8 xf[4], wf[4];
#pragma unroll
            for (int mi = 0; mi < 4; ++mi) {
                if constexpr (A_LDS) xf[mi] = *(const bf16x8*)(Hs + (wr * 64 + mi * 16 + fr) * hstride + (kt * 64 + ks * 32 + fg * 8) * 2);
                else xf[mi] = *(const bf16x8*)(b + xrow_off + mi * 2048 + (xc0 ^ (ks * 64)));
            }
#pragma unroll
            for (int ni = 0; ni < 4; ++ni) wf[ni] = *(const bf16x8*)(b + XOFF + wrow_off + ni * 2048 + (xc0 ^ (ks * 64)));
#pragma unroll
            for (int mi = 0; mi < 4; ++mi)
#pragma unroll
                for (int ni = 0; ni < 4; ++ni) acc[mi][ni] = __builtin_amdgcn_mfma_f32_16x16x32_bf16(wf[ni], xf[mi], acc[mi][ni], 0, 0, 0);
        }
        if (ESTORES > 0) { if (kt == nk - 1) { epi(v, acc); since = 0; } else if (since < 2) ++since; }
        else if (kt == nk - 1) { pend = true; vpend = v; }
        if (++kt == nk) { kt = 0; ++v; }
        if (++ktp == nk) { ktp = 0; ++vp; }
        if (++bufc == NST) bufc = 0;
        if (++bufp == NST) bufp = 0;
    }
    if (pend) epi(vpend, acc);
    __syncthreads();
}

typedef unsigned char u8_t;
template <bool A_LDS, int ESTORES, bool P16, class RowPtr, class WPtr, class Epi>
__device__ __forceinline__ void gemm_panel8(RowPtr rp, const char* Hs, int hstride, WPtr wp, int ldw, int nk, int nv, char* stage, Epi epi) {
    const int tid = tidx(), lane = tid & 63, wid = __builtin_amdgcn_readfirstlane(tid >> 6), wr = wid >> 2, wc = wid & 3, fr = lane & 15, fg = lane >> 4;
    constexpr int XOFF = A_LDS ? 0 : XT_BYTES, BUFB = A_LDS ? WT_BYTES : STG_BYTES;
    const int l8 = lane >> 3;
    auto gload = [&](int v, int kt, int buf) {
        char* b = stage + buf * BUFB + lane * 16;
        if constexpr (!A_LDS) {
#pragma unroll
            for (int i = 0; i < 2; ++i) {
                const int q = wid + 8 * i, k0 = kt * 128 + (((lane & 7) ^ l8 ^ (q & 1)) << 4);
                __builtin_amdgcn_global_load_lds((const unsigned*)(rp(v, q * 8 + l8) + k0), (LAS3 unsigned*)(b + q * 1024), 16, 0, 0);
            }
        }
        const u8_t* wb = wp(v) + kt * 128;
#pragma unroll
        for (int i = 0; i < 4; ++i) {
            const int q = wid + 8 * i, rho = q * 8 + l8, ii = rho & 15;
            const int n = P16 ? (rho & ~63) + 16 * (ii >> 2) + 4 * ((rho >> 4) & 3) + (ii & 3) : (rho & ~31) + 8 * (ii >> 2) + (ii & 3) + ((rho >> 2) & 4);
            __builtin_amdgcn_global_load_lds((const unsigned*)(wb + (size_t)n * ldw + (((lane & 7) ^ l8 ^ (q & 1)) << 4)), (LAS3 unsigned*)(b + XOFF + q * 1024), 16, 0, 0);
        }
    };
    const int S = nk * nv;
    gload(0, 0, 0);
    if (S > 1) gload(nk > 1 ? 0 : 1, nk > 1 ? 1 : 0, 1);
    f32x4 acc[4][4];
    int v = 0, kt = 0, vp = 0, ktp = 0;
#pragma unroll
    for (int i = 0; i < 2; ++i) { if (++ktp == nk) { ktp = 0; ++vp; } }
    int bufc = 0, bufp = 2;
    const int sw = (fr & 7) ^ (fr >> 3);
    const int wrow_off = XOFF + (wc * 64 + fr) * 128 + (fg & 1) * 8;
    const int xrow_off = (wr * 64 + fr) * 128 + (fg & 1) * 8;
    bool pend = false; int vpend = 0;
    int since = 2;
    constexpr int PER = A_LDS ? 4 : 6;
    for (int s = 0; s < S; ++s) {
        if (s + 1 < S) {
            if (ESTORES > 0 && since < 2) asm volatile("s_waitcnt vmcnt(%0)" :: "n"(PER + ESTORES) : "memory");
            else asm volatile("s_waitcnt vmcnt(%0)" :: "n"(PER) : "memory");
        }
        else asm volatile("s_waitcnt vmcnt(0)" ::: "memory");
        __builtin_amdgcn_s_barrier();
        if (pend) { epi(vpend, acc); pend = false; }
        if (s + 2 < S) gload(vp, ktp, bufp);
        if (kt == 0) {
#pragma unroll
            for (int mi = 0; mi < 4; ++mi)
#pragma unroll
                for (int ni = 0; ni < 4; ++ni) acc[mi][ni] = (f32x4){0.f, 0.f, 0.f, 0.f};
        }
        const char* b = stage + bufc * BUFB;
#pragma unroll
        for (int ks = 0; ks < 4; ++ks) {
            long xf[4], wf[4];
            const int co = ((ks * 2 + (fg >> 1)) ^ sw) << 4;
#pragma unroll
            for (int mi = 0; mi < 4; ++mi) {
                if constexpr (A_LDS) xf[mi] = *(const long*)(Hs + (wr * 64 + mi * 16 + fr) * hstride + kt * 128 + ks * 32 + fg * 8);
                else xf[mi] = *(const long*)(b + xrow_off + mi * 2048 + co);
            }
#pragma unroll
            for (int ni = 0; ni < 4; ++ni) wf[ni] = *(const long*)(b + wrow_off + ni * 2048 + co);
#pragma unroll
            for (int mi = 0; mi < 4; ++mi)
#pragma unroll
                for (int ni = 0; ni < 4; ++ni) acc[mi][ni] = __builtin_amdgcn_mfma_f32_16x16x32_fp8_fp8(wf[ni], xf[mi], acc[mi][ni], 0, 0, 0);
        }
        if (ESTORES > 0) { if (kt == nk - 1) { epi(v, acc); since = 0; } else if (since < 2) ++since; }
        else if (kt == nk - 1) { pend = true; vpend = v; }
        if (++kt == nk) { kt = 0; ++v; }
        if (++ktp == nk) { ktp = 0; ++vp; }
        if (++bufc == 3) bufc = 0;
        if (++bufp == 3) bufp = 0;
    }
    if (pend) epi(vpend, acc);
    __syncthreads();
}

__device__ void st_inproj_fast(const P& p, char* lds, int abl) {
    const bf16_t* hm = (const bf16_t*)(p.ws + OFF_HM);
    const bf16_t* wt = (const bf16_t*)(p.ws + OFF_WT_IN);
    bf16_t* qkv = (bf16_t*)(p.ws + OFF_QKV); bf16_t* zs = (bf16_t*)(p.ws + OFF_ZS); bf16_t* ug = (bf16_t*)(p.ws + OFF_UG);
    bf16_t* vgg = (bf16_t*)(p.ws + OFF_VGG); bf16_t* gate = (bf16_t*)(p.ws + OFF_GATE);
    bf16_t* lbias = (bf16_t*)(lds + 3 * STG_BYTES);
    for (int i = tidx(); i < 2048; i += NT) lbias[i] = f2bf(p.b_bg[i]);
    __syncthreads();
    for (int panel = blockIdx.x; panel < T / 128; panel += gridDim.x) {
        const size_t t0 = (size_t)panel * 128;
        auto epi = [&](int v, const f32x4 (&acc)[4][4]) {
            if (abl == 1) { if (acc[0][0][0] == 12345.678f) qkv[0] = 1; return; }
            epi_rows(acc,
                [&](int r, int c, const float (&a_)[8]) {
                    const int col = v * 256 + c;
                    float a[8], o[8];
#pragma unroll
                    for (int j = 0; j < 8; ++j) a[j] = ((IN8 == 1 && v >= 8) || IN8 == 2) ? a_[j] * W8_INV : a_[j];
                    if (v < 6 || abl == 2) {
#pragma unroll
                        for (int j = 0; j < 8; ++j) o[j] = a[j];
                    } else if (v < 8) {
#pragma unroll
                        for (int j = 0; j < 8; ++j) o[j] = fsilu_(a[j]);
                    } else if (v < 12) {
#pragma unroll
                        for (int j = 0; j < 8; ++j) o[j] = fgelu_(a[j]);
                    } else {
                        float bs[8]; unpack8(*(const uint4*)(lbias + (col - 3072)), bs);
#pragma unroll
                        for (int j = 0; j < 8; ++j) o[j] = fsigmoid_(a[j] + bs[j]);
                    }
                    return pack8(o);
                },
                [&](int r, int c, const uint4 d) {
                    const size_t t = t0 + r; const int col = v * 256 + c;
                    if (v < 6) *(uint4*)(qkv + t * 1536 + col) = d;
                    else if (v < 8) *(uint4*)(zs + t * 512 + (col - 1536)) = d;
                    else if (v < 10) *(uint4*)(ug + t * 512 + (col - 2048)) = d;
                    else if (v < 12) *(uint4*)(vgg + t * 512 + (col - 2560)) = d;
                    else *(uint4*)(gate + t * 2048 + (col - 3072)) = d;
                });
        };
        if (IN8 == 2) {
            gemm_panel8<false, 8, false>([&](int, int r) { return (const u8_t*)(p.ws + OFF_HM8) + (t0 + r) * D; }, nullptr, 0,
                               [&](int v) { return (const u8_t*)(p.ws + OFF_WT_IN8) + (size_t)v * 256 * D; }, D, 8, 12, lds, epi);
            gemm_panel8<false, 4, true>([&](int, int r) { return (const u8_t*)(p.ws + OFF_HM8) + (t0 + r) * D; }, nullptr, 0,
                               [&](int v) { return (const u8_t*)(p.ws + OFF_WT_IN8) + (size_t)(v + 12) * 256 * D; }, D, 8, 8, lds,
                               [&](int v, const f32x4 (&acc)[4][4]) {
                                   const int lane = tidx() & 63, wid = tidx() >> 6, wr = wid >> 2, wc = wid & 3, fr = lane & 15, fg = lane >> 4;
#pragma unroll
                                   for (int mi = 0; mi < 4; ++mi) {
                                       const int col = v * 256 + wc * 64 + 16 * fg;
                                       float b0[8], b1[8], o0[8], o1[8];
                                       unpack8(*(const uint4*)(lbias + col), b0); unpack8(*(const uint4*)(lbias + col + 8), b1);
#pragma unroll
                                       for (int j = 0; j < 4; ++j) {
                                           o0[j] = fsigmoid_(acc[mi][0][j] * W8_INV + b0[j]); o0[4 + j] = fsigmoid_(acc[mi][1][j] * W8_INV + b0[4 + j]);
                                           o1[j] = fsigmoid_(acc[mi][2][j] * W8_INV + b1[j]); o1[4 + j] = fsigmoid_(acc[mi][3][j] * W8_INV + b1[4 + j]);
                                       }
                                       const uint2 lo = pack8_fp8(o0), hi = pack8_fp8(o1);
                                       *(uint4*)((u8_t*)gate + (t0 + wr * 64 + mi * 16 + fr) * 2048 + col) = make_uint4(lo.x, lo.y, hi.x, hi.y);
                                   }
                               });
        } else if (IN8) {
            gemm_panel<false, 8>([&](int, int r) { return hm + (t0 + r) * D; }, nullptr, 0, [&](int v) { return wt + (size_t)v * 256 * D; }, D, 16, 8, lds, epi);
            gemm_panel8<false, 0, false>([&](int, int r) { return (const u8_t*)(p.ws + OFF_HM8) + (t0 + r) * D; }, nullptr, 0,
                               [&](int v) { return (const u8_t*)(p.ws + OFF_WT_IN8) + (size_t)(v + 8) * 256 * D; }, D, 8, 12, lds,
                               [&](int v, const f32x4 (&acc)[4][4]) { epi(v + 8, acc); });
        } else gemm_panel<false, 8>([&](int, int r) { return hm + (t0 + r) * D; }, nullptr, 0, [&](int v) { return wt + (size_t)v * 256 * D; }, D, 16, 20, lds, epi);
    }
}

constexpr int HSTRIDE = 272;
constexpr int HS_BYTES = 35 * 1024;
constexpr int LDS_ENT = 148 * 1024;

template <class RowSrc, class Store>
__device__ __forceinline__ void moe_tile(RowSrc rowsrc, const u8_t* wgu, const u8_t* wd, char* lds, Store store) {
    const int lane = tidx() & 63, wid = tidx() >> 6, wr = wid >> 2, wc = wid & 3, fr = lane & 15, fg = lane >> 4;
    uint2 h0[4], h1[4];
    gemm_panel8<false, 0, false>([&](int, int r) { return rowsrc(r); }, nullptr, 0, [&](int v) { return wgu + (size_t)v * 256 * D; }, D, 8, 2, lds,
                       [&](int v, const f32x4 (&acc)[4][4]) {
#pragma unroll
                           for (int mi = 0; mi < 4; ++mi) {
                               float h[8];
#pragma unroll
                               for (int j = 0; j < 4; ++j) {
                                   h[j] = fsilu_(acc[mi][0][j] * W8_INV) * (acc[mi][2][j] * W8_INV);
                                   h[4 + j] = fsilu_(acc[mi][1][j] * W8_INV) * (acc[mi][3][j] * W8_INV);
                               }
                               if (v == 0) h0[mi] = pack8_fp8(h); else h1[mi] = pack8_fp8(h);
                           }
                       });
#pragma unroll
    for (int mi = 0; mi < 4; ++mi) {
        char* hp = lds + (wr * 64 + mi * 16 + fr) * HSTRIDE + wc * 32 + 8 * fg;
        *(uint2*)(hp) = h0[mi]; *(uint2*)(hp + 128) = h1[mi];
    }
    __syncthreads();
    gemm_panel8<true, 4, true>([&](int, int) { return (const u8_t*)nullptr; }, lds, HSTRIDE, [&](int v) { return wd + (size_t)v * 256 * EH; }, EH, 2, 4, lds + HS_BYTES,
                      [&](int v, const f32x4 (&acc)[4][4]) {
#pragma unroll
                          for (int mi = 0; mi < 4; ++mi) {
                              const float a[16] = {acc[mi][0][0], acc[mi][0][1], acc[mi][0][2], acc[mi][0][3], acc[mi][1][0], acc[mi][1][1], acc[mi][1][2], acc[mi][1][3],
                                                   acc[mi][2][0], acc[mi][2][1], acc[mi][2][2], acc[mi][2][3], acc[mi][3][0], acc[mi][3][1], acc[mi][3][2], acc[mi][3][3]};
                              store(wr * 64 + mi * 16 + fr, v * 256 + wc * 64 + 16 * fg, a);
                          }
                      });
}

constexpr size_t OFF_TRASH = 505 * MiB;
__device__ __forceinline__ void st_moe_fast(const P& p, char* lds, bool fin, int which) {
    const u8_t* hf8 = (const u8_t*)(p.ws + OFF_HF8);
    u8_t* contrib = (u8_t*)(p.ws + OFF_CONTRIB);
    bf16_t* sho = (bf16_t*)(p.ws + OFF_SHO);
    u8_t* trash = (u8_t*)(p.ws + OFF_TRASH) + (size_t)blockIdx.x * D;
    const unsigned* cnt = (const unsigned*)(p.ws + OFF_CNT);
    const int* lists = (const int*)(p.ws + OFF_LISTS);
    const float* wts = (const float*)(p.ws + OFF_WTS);
    int* ent = (int*)(lds + LDS_ENT);
    int* tstart = ent + 128;
    float* wrow = (float*)(tstart + 260);
    const int xg = blockIdx.x & 7, xi = blockIdx.x >> 3, nxb = (gridDim.x + 7 - xg) >> 3;
    __syncthreads();
    if (tidx() == 0) { int acc = 0; for (int j = 0; j < NE / 8; ++j) { tstart[j] = acc; acc += ((int)cnt[xg + 8 * j] + 127) >> 7; } tstart[NE / 8] = acc; }
    __syncthreads();
    const int ntiles = which ? 0 : tstart[NE / 8];
    int ej = 0;
    for (int tile = which ? (int)blockIdx.x : xi; tile < (which ? T / 128 : ntiles); tile += which ? (int)gridDim.x : nxb) {
        if (tile < ntiles) {
            while (tstart[ej + 1] <= tile) ++ej;
            const int e = xg + 8 * ej;
            const int r0 = (tile - tstart[ej]) * 128, ce = (int)cnt[e];
            __syncthreads();
            if (tidx() < 128) { const int en = (r0 + (int)tidx() < ce) ? lists[(size_t)e * LCAP + r0 + tidx()] : -1; ent[tidx()] = en; wrow[tidx()] = en >= 0 ? wts[en] * W8_INV : 0.f; }
            __syncthreads();
            moe_tile([&](int r) { const int en = ent[r]; return en >= 0 ? hf8 + (size_t)(en >> 3) * D : (const u8_t*)(p.ws + OFF_ZERO); },
                     (const u8_t*)(p.ws + OFF_WT_GU) + (size_t)e * 512 * D, (const u8_t*)(p.ws + OFF_WT_D) + (size_t)e * D * EH, lds,
                     [&](int r, int col, const float (&a)[16]) {
                         const int en = ent[r];
                         const float w = wrow[r] * C8_SCALE;
                         float o0[8], o1[8];
#pragma unroll
                         for (int j = 0; j < 8; ++j) { o0[j] = a[j] * w; o1[j] = a[8 + j] * w; }
                         const uint2 lo = pack8_fp8(o0), hi = pack8_fp8(o1);
                         u8_t* dst = (en >= 0 && fin) ? contrib + (size_t)en * D + col : trash + col;
                         *(uint4*)dst = make_uint4(lo.x, lo.y, hi.x, hi.y);
                     });
        } else {
            const size_t t0 = (size_t)(tile - ntiles) * 128;
            __syncthreads();
            moe_tile([&](int r) { return hf8 + (t0 + r) * D; }, (const u8_t*)(p.ws + OFF_WT_SHGU), (const u8_t*)(p.ws + OFF_WT_SHD), lds,
                     [&](int r, int col, const float (&a)[16]) {
                         float o0[8], o1[8];
#pragma unroll
                         for (int j = 0; j < 8; ++j) { o0[j] = a[j] * W8_INV; o1[j] = a[8 + j] * W8_INV; }
                         *(uint4*)(sho + (t0 + r) * D + col) = pack8(o0); *(uint4*)(sho + (t0 + r) * D + col + 8) = pack8(o1);
                     });
        }
    }
}

constexpr size_t OFF_MERGEDB = 736 * MiB;
__device__ __forceinline__ void wg_sync() { asm volatile("s_waitcnt vmcnt(0)" ::: "memory"); __syncthreads(); }
struct TopE { float v; int e; };
__device__ __forceinline__ bool better(const TopE& a, const TopE& b) { return a.v > b.v || (a.v == b.v && a.e < b.e); }

__device__ void st_post_fast(const P& p, char* lds, bool fin) {
    const int tid = tidx(), lane = tid & 63, wid = tid >> 6, wr = wid >> 2, wc = wid & 3, fr = lane & 15, fg = lane >> 4;
    const bf16_t* ydn = (const bf16_t*)(p.ws + OFF_O); const bf16_t* ysg = (const bf16_t*)(p.ws + OFF_YSG);
    const bf16_t* gate = (const bf16_t*)(p.ws + OFF_GATE);
    bf16_t* mg = (bf16_t*)(p.ws + OFF_MERGEDB);
    bf16_t* yb = (bf16_t*)(p.ws + OFF_Y);
    const bf16_t* hf = (const bf16_t*)(p.ws + OFF_HF);
    unsigned* cnt = (unsigned*)(p.ws + OFF_CNT);
    int* lists = (int*)(p.ws + OFF_LISTS);
    float* wts = (float*)(p.ws + OFF_WTS);
    float* sc = (float*)lds;
    float* bias = (float*)(lds + 131584);
    int* hist = (int*)(lds + 132608);
    int* base = (int*)(lds + 133632);
    for (int panel = blockIdx.x; panel < T / 128; panel += gridDim.x) {
        const size_t t0 = (size_t)panel * 128;
        if (fin) for (int r = wid; r < 128; r += 8) ydn_token(p, (int)t0 + r, lane);
        wg_sync();
        {
            gemm_panel<false, 8>([&](int v, int r) { return ((v & 1) ? ysg : ydn) + (t0 + r) * 512; }, nullptr, 0,
                              [&](int v) { return (const bf16_t*)(p.ws + ((v & 1) ? OFF_WT_SG : OFF_WT_DN)) + (size_t)(v >> 1) * 256 * 512; }, 512, 8, 8, lds,
                              [&](int v, const f32x4 (&acc)[4][4]) {
                                  uint4 gv[4][2], mv[4][2];
#pragma unroll
                                  for (int mi = 0; mi < 4; ++mi)
#pragma unroll
                                      for (int pp = 0; pp < 2; ++pp) {
                                          const size_t t = t0 + wr * 64 + mi * 16 + fr; const int col = (v >> 1) * 256 + wc * 64 + pp * 32 + 8 * fg;
                                          if (IN8 == 2) { const uint2 g8 = *(const uint2*)((const u8_t*)gate + t * 2048 + (v & 1) * 1024 + col); gv[mi][pp] = make_uint4(g8.x, g8.y, 0u, 0u); }
                                          else gv[mi][pp] = *(const uint4*)(gate + t * 2048 + (v & 1) * 1024 + col);
                                          if (v & 1) mv[mi][pp] = *(const uint4*)(mg + t * D + col);
                                      }
#pragma unroll
                                  for (int mi = 0; mi < 4; ++mi)
#pragma unroll
                                      for (int pp = 0; pp < 2; ++pp) {
                                          const size_t t = t0 + wr * 64 + mi * 16 + fr; const int col = (v >> 1) * 256 + wc * 64 + pp * 32 + 8 * fg;
                                          float g[8], o[8];
                                          if (IN8 == 2) {
                                              const auto a0 = __builtin_amdgcn_cvt_pk_f32_fp8((int)gv[mi][pp].x, false), a1 = __builtin_amdgcn_cvt_pk_f32_fp8((int)gv[mi][pp].x, true);
                                              const auto a2 = __builtin_amdgcn_cvt_pk_f32_fp8((int)gv[mi][pp].y, false), a3 = __builtin_amdgcn_cvt_pk_f32_fp8((int)gv[mi][pp].y, true);
                                              g[0] = a0[0]; g[1] = a0[1]; g[2] = a1[0]; g[3] = a1[1]; g[4] = a2[0]; g[5] = a2[1]; g[6] = a3[0]; g[7] = a3[1];
                                          } else unpack8(gv[mi][pp], g);
                                          const float a[8] = {acc[mi][2 * pp][0], acc[mi][2 * pp][1], acc[mi][2 * pp][2], acc[mi][2 * pp][3],
                                                              acc[mi][2 * pp + 1][0], acc[mi][2 * pp + 1][1], acc[mi][2 * pp + 1][2], acc[mi][2 * pp + 1][3]};
                                          if (v & 1) {
                                              float m[8]; unpack8(mv[mi][pp], m);
#pragma unroll
                                              for (int j = 0; j < 8; ++j) o[j] = m[j] + g[j] * a[j];
                                          } else {
#pragma unroll
                                              for (int j = 0; j < 8; ++j) o[j] = g[j] * a[j];
                                          }
                                          *(uint4*)(mg + t * D + col) = pack8(o);
                                      }
                              });
        }
        wg_sync();
        gemm_panel<false, 8>([&](int, int r) { return mg + (t0 + r) * D; }, nullptr, 0, [&](int v) { return (const bf16_t*)(p.ws + OFF_WT_OUT) + (size_t)v * 256 * D; }, D, 16, 4, lds,
                          [&](int v, const f32x4 (&acc)[4][4]) {
                              epi_each(acc, [&](int r, int c, const float (&a)[8]) { *(uint4*)(yb + (t0 + r) * D + v * 256 + c) = pack8(a); });
                          });
        wg_sync();
        {
            float* lv = (float*)lds;
            const float* mod = (const float*)(p.ws + OFF_MOD);
            const int b = (int)(t0 / SEQ);
            for (int k = tid; k < 1024; k += NT) {
                lv[k] = mod[b * 6144 + 2048 + k] * p.mix_post[k];
                lv[1024 + k] = p.ffn_pre[k] * (1.f + mod[b * 6144 + 4096 + k]);
                lv[2048 + k] = mod[b * 6144 + 3072 + k];
            }
            __syncthreads();
            for (int r = wid; r < 128; r += 8) x1hf_row(p, (int)t0 + r, lane, lv);
        }
        wg_sync();
        {
            f32x4 racc[4][4];
            gemm_panel<false, 0>([&](int, int r) { return hf + (t0 + r) * D; }, nullptr, 0, [&](int) { return (const bf16_t*)(p.ws + OFF_WT_RT); }, D, 16, 1, lds,
                              [&](int, const f32x4 (&acc)[4][4]) {
#pragma unroll
                                  for (int mi = 0; mi < 4; ++mi)
#pragma unroll
                                      for (int ni = 0; ni < 4; ++ni) racc[mi][ni] = acc[mi][ni];
                              });
            epi_each(racc, [&](int r, int c, const float (&a)[8]) {
#pragma unroll
                for (int j = 0; j < 8; ++j) sc[r * 257 + c + j] = fsigmoid_(a[j]);
            });
        }
        { int tt = tid; asm volatile("" : "+v"(tt)); if (tt < 256) { bias[tt] = p.router_bias[tt]; hist[tt] = 0; } }
        __syncthreads();
        {
            const int tok = tid >> 2, q = tid & 3;
            const float* srow = sc + tok * 257;
            TopE l[8];
#pragma unroll
            for (int k = 0; k < 8; ++k) { l[k].v = -INFINITY; l[k].e = 1 << 30; }
            float a1 = -INFINITY, a2 = -INFINITY, b1 = -INFINITY, b2 = -INFINITY;
            for (int i = 0; i < 64; ++i) {
                const int idx = (i + 8 * q) & 63, e = 64 * q + idx;
                const float v = srow[e] + bias[e];
                if (idx < 32) { if (v > a1) { a2 = a1; a1 = v; } else if (v > a2) a2 = v; }
                else { if (v > b1) { b2 = b1; b1 = v; } else if (v > b2) b2 = v; }
            }
            const float gs0 = a1 + a2, gs1 = b1 + b2;
            int r0 = 0, r1 = 0;
#pragma unroll
            for (int h = 0; h < 8; ++h) {
                const float gh = __shfl((h & 1) ? gs1 : gs0, (lane & ~3) | (h >> 1));
                r0 += (gh > gs0 || (gh == gs0 && h < 2 * q)) ? 1 : 0;
                r1 += (gh > gs1 || (gh == gs1 && h < 2 * q + 1)) ? 1 : 0;
            }
            const bool sel0 = r0 < 4, sel1 = r1 < 4;
            for (int i = 0; i < 64; ++i) {
                const int idx = (i + 8 * q) & 63, e = 64 * q + idx;
                if (idx < 32 ? sel0 : sel1) {
                    TopE cur; cur.v = srow[e] + bias[e]; cur.e = e;
                    if (better(cur, l[7])) {
#pragma unroll
                        for (int k = 0; k < 8; ++k) if (better(cur, l[k])) { const TopE tmp = l[k]; l[k] = cur; cur = tmp; }
                    }
                }
            }
            int we[8]; float wv[8]; float wsum = 0.f;
#pragma unroll
            for (int k = 0; k < 8; ++k) {
                TopE h = l[0];
#pragma unroll
                for (int o = 1; o < 4; o <<= 1) { TopE t2; t2.v = __shfl_xor(h.v, o); t2.e = __shfl_xor(h.e, o); if (better(t2, h)) h = t2; }
                if (l[0].e == h.e) {
#pragma unroll
                    for (int j = 0; j < 7; ++j) l[j] = l[j + 1];
                    l[7].v = -INFINITY; l[7].e = 1 << 30;
                }
                we[k] = h.e; wv[k] = srow[h.e]; wsum += wv[k];
            }
            const float inv = 2.5f / wsum;
            int rk0 = 0, rk1 = 0, e0 = 0, e1 = 0; float w0 = 0.f, w1 = 0.f;
#pragma unroll
            for (int k = 0; k < 8; ++k) if ((k >> 1) == q) { if (k & 1) { e1 = we[k]; w1 = wv[k] * inv; } else { e0 = we[k]; w0 = wv[k] * inv; } }
            rk0 = atomicAdd(&hist[e0], 1); rk1 = atomicAdd(&hist[e1], 1);
            __syncthreads();
            { int tt = tid; asm volatile("" : "+v"(tt)); if (tt < 256) { const int c = hist[tt]; base[tt] = (c > 0 && fin) ? (int)atomicAdd(&cnt[tt], (unsigned)c) : 0; } }
            __syncthreads();
            const int tg = (int)t0 + tok;
            if (fin) {
            lists[(size_t)e0 * LCAP + base[e0] + rk0] = tg * 8 + 2 * q; wts[tg * 8 + 2 * q] = w0;
            lists[(size_t)e1 * LCAP + base[e1] + rk1] = tg * 8 + 2 * q + 1; wts[tg * 8 + 2 * q + 1] = w1;
            }
        }
        __syncthreads();
    }
}

constexpr size_t OFF_GL  = 480 * MiB + 128 * 1024;
constexpr size_t OFF_KDT = 960 * MiB;
constexpr size_t OFF_QKF = 992 * MiB;
constexpr int DN_HALF = 73728;
constexpr int DQS = 0, DKS = 18432, DLS = 36864, DWL = 53248, DMISC = 71680;

__device__ __forceinline__ bf16x8 pack_b(const f32x4 a, const f32x4 b) {
    const uint4 u = make_uint4(pk2(a[0], a[1]), pk2(a[2], a[3]), pk2(b[0], b[1]), pk2(b[2], b[3]));
    return __builtin_bit_cast(bf16x8, u);
}

__device__ void st_dnprep_fast(const P& p, char* lds, int abl) {
    const int tid0 = tidx();
    const bf16_t* qkv = (const bf16_t*)(p.ws + OFF_QKV);
    const float* gb = (const float*)(p.ws + OFF_G); const float* bb = (const float*)(p.ws + OFF_BETA);
    float* GL = (float*)(p.ws + OFF_GL);
    bf16_t* KDT = (bf16_t*)(p.ws + OFF_KDT); bf16_t* QKF = (bf16_t*)(p.ws + OFF_QKF);
    float* UF = p.out; bf16_t* WC = (bf16_t*)((char*)p.out + 64 * MiB); bf16_t* QD = (bf16_t*)((char*)p.out + 96 * MiB);
    for (int it = blockIdx.x; it < 1024; it += gridDim.x) {
        int tid = tid0; asm volatile("" : "+v"(tid));
        const int lane = tid & 63, wid = tid >> 6, hb = wid >> 2, hw = __builtin_amdgcn_readfirstlane(wid & 3), ht = tid & 255, fr = lane & 15, fg = lane >> 4;
        char* L = lds + hb * DN_HALF;
        bf16_t* Qs = (bf16_t*)(L + DQS); bf16_t* Ks = (bf16_t*)(L + DKS); float* Ls = (float*)(L + DLS); bf16_t* Wl = (bf16_t*)(L + DWL);
        float* gc = (float*)(L + DMISC); float* beta = gc + 64; float* egc = gc + 128; float* ekl = gc + 192; float* rnq = gc + 256;
        const int unit = it * 2 + hb, h = unit & 3, cn = unit >> 2, t0 = cn * 64, s0 = t0 % SEQ;
        __syncthreads();
        if (hw == 0) {
            const float g = gb[(t0 + lane) * 4 + h], be = bb[(t0 + lane) * 4 + h];
            float c = g;
#pragma unroll
            for (int o = 1; o < 64; o <<= 1) { const float t = __shfl_up(c, o); if (lane >= o) c += t; }
            const float gl = __shfl(c, 63);
            gc[lane] = c; beta[lane] = be; egc[lane] = expf(c); ekl[lane] = expf(gl - c);
            if (lane == 0) GL[unit] = expf(gl);
        }
        {
            const int cp = ht & 63, part = (ht >> 6) & 1, rh = ht >> 7, col = part * 512 + h * 128 + cp * 2, i0 = rh * 32;
            bf16_t* dstp = (part ? Ks : Qs) + cp * 2;
            float2 cw[4];
#pragma unroll
            for (int tap = 0; tap < 4; ++tap) cw[tap] = *(const float2*)(p.conv_w + tap * 1536 + col);
            float2 w0, w1, w2;
            {
                const unsigned r0 = (s0 + i0 >= 3) ? *(const unsigned*)(qkv + (size_t)(t0 + i0 - 3) * 1536 + col) : 0u;
                const unsigned r1 = (s0 + i0 >= 2) ? *(const unsigned*)(qkv + (size_t)(t0 + i0 - 2) * 1536 + col) : 0u;
                const unsigned r2 = (s0 + i0 >= 1) ? *(const unsigned*)(qkv + (size_t)(t0 + i0 - 1) * 1536 + col) : 0u;
                w0 = make_float2(__uint_as_float(r0 << 16), __uint_as_float(r0 & 0xffff0000u));
                w1 = make_float2(__uint_as_float(r1 << 16), __uint_as_float(r1 & 0xffff0000u));
                w2 = make_float2(__uint_as_float(r2 << 16), __uint_as_float(r2 & 0xffff0000u));
            }
            if (!(abl & 1)) {
#pragma unroll
            for (int i = 0; i < 32; ++i) {
                const unsigned r3 = *(const unsigned*)(qkv + (size_t)(t0 + i0 + i) * 1536 + col);
                const float2 w3 = make_float2(__uint_as_float(r3 << 16), __uint_as_float(r3 & 0xffff0000u));
                *(unsigned*)(dstp + (i0 + i) * 144) = pk2(fsilu_(w0.x * cw[0].x + w1.x * cw[1].x + w2.x * cw[2].x + w3.x * cw[3].x),
                                                          fsilu_(w0.y * cw[0].y + w1.y * cw[1].y + w2.y * cw[2].y + w3.y * cw[3].y));
                w0 = w1; w1 = w2; w2 = w3;
            }
            }
        }
        __syncthreads();
        if (ht < 128) {
            const int part = ht >> 6, row = ht & 63;
            const bf16_t* rp_ = (part ? Ks : Qs) + row * 144;
            float ss = 0.f;
#pragma unroll
            for (int q = 0; q < 16; ++q) { float v8[8]; unpack8(*(const uint4*)(rp_ + q * 8), v8);
#pragma unroll
                for (int j = 0; j < 8; ++j) ss += v8[j] * v8[j]; }
            rnq[part * 64 + row] = rsqrtf(ss + 1e-6f) * (part ? 1.f : 0.08838834764831845f);
        }
        __syncthreads();
        {
            f32x4 akk[4], aqk[4];
#pragma unroll
            for (int jt = 0; jt < 4; ++jt) { akk[jt] = (f32x4){0.f, 0.f, 0.f, 0.f}; aqk[jt] = akk[jt]; }
#pragma unroll
            for (int ks = 0; ks < 4; ++ks) {
                const bf16x8 aK = *(const bf16x8*)(Ks + (16 * hw + fr) * 144 + 32 * ks + 8 * fg);
                const bf16x8 aQ = *(const bf16x8*)(Qs + (16 * hw + fr) * 144 + 32 * ks + 8 * fg);
#pragma unroll
                for (int jt = 0; jt < 4; ++jt) {
                    if (jt <= hw) {
                        const bf16x8 bK = *(const bf16x8*)(Ks + (16 * jt + fr) * 144 + 32 * ks + 8 * fg);
                        akk[jt] = __builtin_amdgcn_mfma_f32_16x16x32_bf16(aK, bK, akk[jt], 0, 0, 0);
                        aqk[jt] = __builtin_amdgcn_mfma_f32_16x16x32_bf16(aQ, bK, aqk[jt], 0, 0, 0);
                    }
                }
            }
#pragma unroll
            for (int jt = 0; jt < 4; ++jt) {
                const int j = 16 * jt + fr;
                const float gj = gc[j], rkj = rnq[64 + j];
                float lt[4];
#pragma unroll
                for (int r = 0; r < 4; ++r) {
                    const int i = 16 * hw + 4 * fg + r;
                    const float dec = (i >= j) ? fexp_(gc[i] - gj) * rkj : 0.f;
                    lt[r] = (i > j) ? beta[i] * rnq[64 + i] * akk[jt][r] * dec : 0.f;
                    Wl[i * 72 + j] = f2bf(aqk[jt][r] * rnq[i] * dec);
                }
                *(float4*)(Ls + j * 64 + 16 * hw + 4 * fg) = make_float4(lt[0], lt[1], lt[2], lt[3]);
            }
        }
        __syncthreads();
#pragma unroll
        for (int m = 0; m < 2; ++m) {
            const int q = ht + 256 * m, frag = q >> 6, l = q & 63, row = 16 * (frag >> 1) + (l & 15), k0 = 32 * (frag & 1) + 4 * (l >> 4);
            const uint2 lo = *(const uint2*)(Wl + row * 72 + k0), hi = *(const uint2*)(Wl + row * 72 + k0 + 16);
            *(uint4*)(QKF + (size_t)unit * 4096 + q * 8) = make_uint4(lo.x, lo.y, hi.x, hi.y);
        }
        __syncthreads();
        {
            float x[64];
            const int c = ht;
            if (c < 128) {
                const int col = 1024 + h * 128 + c;
                float cw[4];
#pragma unroll
                for (int tap = 0; tap < 4; ++tap) cw[tap] = p.conv_w[tap * 1536 + col];
                float w0 = (s0 >= 3) ? bf2f(qkv[(size_t)(t0 - 3) * 1536 + col]) : 0.f;
                float w1 = (s0 >= 2) ? bf2f(qkv[(size_t)(t0 - 2) * 1536 + col]) : 0.f;
                float w2 = (s0 >= 1) ? bf2f(qkv[(size_t)(t0 - 1) * 1536 + col]) : 0.f;
#pragma unroll
                for (int i = 0; i < 64; ++i) {
                    const float w3 = bf2f(qkv[(size_t)(t0 + i) * 1536 + col]);
                    x[i] = fsilu_(w0 * cw[0] + w1 * cw[1] + w2 * cw[2] + w3 * cw[3]) * beta[i];
                    w0 = w1; w1 = w2; w2 = w3;
                }
            } else {
#pragma unroll
                for (int i = 0; i < 64; ++i) x[i] = bf2f(Ks[i * 144 + (c - 128)]) * rnq[64 + i] * beta[i] * egc[i];
            }
            if (!(abl & 2)) {
#pragma unroll
            for (int j = 0; j < 63; ++j) {
                const float xj = x[j];
#pragma unroll
                for (int i = j + 1; i < 64; ++i) x[i] -= Ls[j * 64 + i] * xj;
                if ((j & 1) == 1) __builtin_amdgcn_sched_barrier(0);
            }
            }
            if (c < 128) {
#pragma unroll
                for (int rt = 0; rt < 4; ++rt)
#pragma unroll
                    for (int g4 = 0; g4 < 4; ++g4)
                        *(float4*)(UF + (size_t)unit * 8192 + ((((c >> 4) * 4 + rt) * 64 + g4 * 16 + (c & 15)) << 2)) =
                            make_float4(x[16 * rt + 4 * g4], x[16 * rt + 4 * g4 + 1], x[16 * rt + 4 * g4 + 2], x[16 * rt + 4 * g4 + 3]);
            } else {
#pragma unroll
                for (int i = 0; i < 64; ++i) Wl[i * 144 + (c - 128)] = f2bf(x[i]);
            }
        }
        __syncthreads();
        if (!(abl & 4)) {
#pragma unroll
        for (int m = 0; m < 4; ++m) {
            const int q = ht + 256 * m, frag = q >> 6, l = q & 63, lfr = l & 15, lfg = l >> 4;
            {
                const int row = 16 * (frag >> 2) + lfr, k0 = 32 * (frag & 3) + 4 * lfg;
                const uint2 lo = *(const uint2*)(Wl + row * 144 + k0), hi = *(const uint2*)(Wl + row * 144 + k0 + 16);
                *(uint4*)(WC + (size_t)unit * 8192 + q * 8) = make_uint4(lo.x, lo.y, hi.x, hi.y);
                const uint2 ql = *(const uint2*)(Qs + row * 144 + k0), qh = *(const uint2*)(Qs + row * 144 + k0 + 16);
                const float e = egc[row] * rnq[row];
                float v[8]; unpack8(make_uint4(ql.x, ql.y, qh.x, qh.y), v);
#pragma unroll
                for (int j = 0; j < 8; ++j) v[j] *= e;
                *(uint4*)(QD + (size_t)unit * 8192 + q * 8) = pack8(v);
            }
            {
                const int kd = 16 * (frag >> 1) + lfr, c0 = 32 * (frag & 1) + 4 * lfg;
                float v[8];
#pragma unroll
                for (int j = 0; j < 8; ++j) { const int cpos = c0 + 16 * (j >> 2) + (j & 3); v[j] = bf2f(Ks[cpos * 144 + kd]) * ekl[cpos] * rnq[64 + cpos]; }
                *(uint4*)(KDT + (size_t)unit * 8192 + q * 8) = pack8(v);
            }
        }
        }
    }
}

__device__ void st_dnscan_fast(const P& p, char* lds) {
    const int tid = tidx(), lane = tid & 63, wid = tid >> 6, fr = lane & 15, fg = lane >> 4;
    const int sb = blockIdx.x, vq = sb & 3, h = (sb >> 2) & 3, b = sb >> 4;
    const float* GL = (const float*)(p.ws + OFF_GL);
    const char* KDT = p.ws + OFF_KDT; const char* QKF = p.ws + OFF_QKF;
    const char* UF = (const char*)p.out; const char* WC = (const char*)p.out + 64 * MiB; const char* QD = (const char*)p.out + 96 * MiB;
    bf16_t* ob = (bf16_t*)(p.ws + OFF_O);
    auto dma = [&](int n, int buf) {
        const size_t unit = (size_t)((b * 256 + n) * 4 + h);
        const int lw = wid - 2;
#pragma unroll
        for (int j = 0; j < 11; ++j) {
            const int pi = lw + 6 * j;
            if (pi < 64) {
                const char* src;
                if (pi < 16) src = WC + unit * 16384 + pi * 1024;
                else if (pi < 32) src = QD + unit * 16384 + (pi - 16) * 1024;
                else if (pi < 48) src = KDT + unit * 16384 + (pi - 32) * 1024;
                else if (pi < 56) src = QKF + unit * 8192 + (pi - 48) * 1024;
                else src = UF + unit * 32768 + (size_t)(2 * vq + ((pi - 56) >> 2)) * 4096 + ((pi - 56) & 3) * 1024;
                __builtin_amdgcn_global_load_lds((const unsigned*)(src + lane * 16), (LAS3 unsigned*)(lds + buf * 65536 + pi * 1024 + lane * 16), 16, 0, 0);
            }
        }
    };
    f32x4 S[8];
#pragma unroll
    for (int k = 0; k < 8; ++k) S[k] = (f32x4){0.f, 0.f, 0.f, 0.f};
    if (wid >= 2) dma(0, 0);
    asm volatile("s_waitcnt vmcnt(0)" ::: "memory");
    __syncthreads();
    for (int n = 0; n < 256; ++n) {
        if (wid >= 2) {
            if (n + 1 < 256) dma(n + 1, (n + 1) & 1);
        } else {
            const int vs = 2 * vq + wid;
            const char* B = lds + (n & 1) * 65536 + lane * 16;
            const float egl = GL[(b * 256 + n) * 4 + h];
            bf16x8 Sb[4];
#pragma unroll
            for (int s = 0; s < 4; ++s) Sb[s] = pack_b(S[2 * s], S[2 * s + 1]);
            f32x4 vn[4], o[4];
#pragma unroll
            for (int rt = 0; rt < 4; ++rt) {
                f32x4 pm = (f32x4){0.f, 0.f, 0.f, 0.f}, qo = pm;
#pragma unroll
                for (int s = 0; s < 4; ++s) {
                    pm = __builtin_amdgcn_mfma_f32_16x16x32_bf16(*(const bf16x8*)(B + (rt * 4 + s) * 1024), Sb[s], pm, 0, 0, 0);
                    qo = __builtin_amdgcn_mfma_f32_16x16x32_bf16(*(const bf16x8*)(B + (16 + rt * 4 + s) * 1024), Sb[s], qo, 0, 0, 0);
                }
                const float4 u4 = *(const float4*)(B + (56 + 4 * wid + rt) * 1024);
                vn[rt] = (f32x4){u4.x - pm[0], u4.y - pm[1], u4.z - pm[2], u4.w - pm[3]};
                o[rt] = qo;
            }
            bf16x8 Vb[2];
            Vb[0] = pack_b(vn[0], vn[1]); Vb[1] = pack_b(vn[2], vn[3]);
#pragma unroll
            for (int rt = 0; rt < 4; ++rt)
#pragma unroll
                for (int s2 = 0; s2 < 2; ++s2) o[rt] = __builtin_amdgcn_mfma_f32_16x16x32_bf16(*(const bf16x8*)(B + (48 + rt * 2 + s2) * 1024), Vb[s2], o[rt], 0, 0, 0);
#pragma unroll
            for (int kt = 0; kt < 8; ++kt) {
                S[kt] = S[kt] * egl;
#pragma unroll
                for (int s2 = 0; s2 < 2; ++s2) S[kt] = __builtin_amdgcn_mfma_f32_16x16x32_bf16(*(const bf16x8*)(B + (32 + kt * 2 + s2) * 1024), Vb[s2], S[kt], 0, 0, 0);
            }
            const size_t t0 = (size_t)(b * 256 + n) * 64;
#pragma unroll
            for (int rt = 0; rt < 4; ++rt)
#pragma unroll
                for (int r = 0; r < 4; ++r) ob[(t0 + 16 * rt + 4 * fg + r) * 512 + h * 128 + vs * 16 + fr] = f2bf(o[rt][r]);
        }
        if (wid >= 2) asm volatile("s_waitcnt vmcnt(0)" ::: "memory");
        __builtin_amdgcn_s_barrier();
    }
}

constexpr size_t OFF_MG  = 384 * MiB;
constexpr size_t OFF_BG  = 392 * MiB;
constexpr size_t OFF_SGS = 400 * MiB;

__device__ void st_scan_l1(const P& p, char* lds) {
    const int tid = tidx(), lane = tid & 63, wid = __builtin_amdgcn_readfirstlane(tid >> 6), fr = lane & 15, fg = lane >> 4;
    const float* GL = (const float*)(p.ws + OFF_GL);
    const char* KDT = p.ws + OFF_KDT;
    const char* UF = (const char*)p.out; const char* WC = (const char*)p.out + 64 * MiB;
    for (int blk = blockIdx.x; blk < 256; blk += gridDim.x) {
        const int g2 = blk >> 1, half = blk & 1, bh = g2 >> 4, g = g2 & 15, b = bh >> 2, h = bh & 3;
        const int npieces = half ? 64 : 32;
        auto dma = [&](int i, int buf) {
            const size_t unit = (size_t)((b * 256 + g * 16 + i) * 4 + h);
            for (int pi = wid; pi < npieces; pi += 8) {
                const char* src;
                if (pi < 16) src = WC + unit * 16384 + pi * 1024;
                else if (pi < 32) src = KDT + unit * 16384 + (pi - 16) * 1024;
                else src = UF + unit * 32768 + (pi - 32) * 1024;
                __builtin_amdgcn_global_load_lds((const unsigned*)(src + lane * 16), (LAS3 unsigned*)(lds + buf * 65536 + pi * 1024 + lane * 16), 16, 0, 0);
            }
        };
        f32x4 X[8];
#pragma unroll
        for (int t = 0; t < 8; ++t)
#pragma unroll
            for (int r = 0; r < 4; ++r) X[t][r] = (!half && (16 * t + 4 * fg + r == 16 * wid + fr)) ? 1.f : 0.f;
        __syncthreads();
        dma(0, 0);
        asm volatile("s_waitcnt vmcnt(0)" ::: "memory");
        __syncthreads();
        for (int i = 0; i < 16; ++i) {
            if (i + 1 < 16) dma(i + 1, (i + 1) & 1);
            const char* B = lds + (i & 1) * 65536 + lane * 16;
            const float egl = GL[(b * 256 + g * 16 + i) * 4 + h];
            bf16x8 Xb[4];
#pragma unroll
            for (int s = 0; s < 4; ++s) Xb[s] = pack_b(X[2 * s], X[2 * s + 1]);
            f32x4 vn[4];
#pragma unroll
            for (int rt = 0; rt < 4; ++rt) {
                f32x4 pm = (f32x4){0.f, 0.f, 0.f, 0.f};
#pragma unroll
                for (int s = 0; s < 4; ++s) pm = __builtin_amdgcn_mfma_f32_16x16x32_bf16(*(const bf16x8*)(B + (rt * 4 + s) * 1024), Xb[s], pm, 0, 0, 0);
                if (half) { const float4 u4 = *(const float4*)(B + (32 + 4 * wid + rt) * 1024); vn[rt] = (f32x4){u4.x - pm[0], u4.y - pm[1], u4.z - pm[2], u4.w - pm[3]}; }
                else vn[rt] = (f32x4){-pm[0], -pm[1], -pm[2], -pm[3]};
            }
            bf16x8 Vb[2];
            Vb[0] = pack_b(vn[0], vn[1]); Vb[1] = pack_b(vn[2], vn[3]);
#pragma unroll
            for (int kt = 0; kt < 8; ++kt) {
                X[kt] = X[kt] * egl;
#pragma unroll
                for (int s2 = 0; s2 < 2; ++s2) X[kt] = __builtin_amdgcn_mfma_f32_16x16x32_bf16(*(const bf16x8*)(B + (16 + kt * 2 + s2) * 1024), Vb[s2], X[kt], 0, 0, 0);
            }
            asm volatile("s_waitcnt vmcnt(0)" ::: "memory");
            __builtin_amdgcn_s_barrier();
        }
        if (half) {
            float4* bg = (float4*)(p.ws + OFF_BG) + ((size_t)(g2 * 8 + wid) * 8) * 64 + lane;
#pragma unroll
            for (int t = 0; t < 8; ++t) bg[t * 64] = make_float4(X[t][0], X[t][1], X[t][2], X[t][3]);
        } else {
            bf16_t* Ml = (bf16_t*)lds;
#pragma unroll
            for (int t = 0; t < 8; ++t)
#pragma unroll
                for (int r = 0; r < 4; ++r) Ml[(16 * t + 4 * fg + r) * 136 + 16 * wid + fr] = f2bf(X[t][r]);
            __syncthreads();
            bf16_t* mg = (bf16_t*)(p.ws + OFF_MG) + (size_t)g2 * 16384;
#pragma unroll
            for (int m = 0; m < 4; ++m) {
                const int q = tid + 512 * m, frag = q >> 6, l = q & 63, row = 16 * (frag >> 2) + (l & 15), k0 = 32 * (frag & 3) + 4 * (l >> 4);
                const uint2 lo = *(const uint2*)(Ml + row * 136 + k0), hi = *(const uint2*)(Ml + row * 136 + k0 + 16);
                *(uint4*)(mg + q * 8) = make_uint4(lo.x, lo.y, hi.x, hi.y);
            }
        }
    }
}

__device__ void st_scan_l2(const P& p, char* lds) {
    const int tid = tidx(), lane = tid & 63, wid = __builtin_amdgcn_readfirstlane(tid >> 6);
    const int bh = blockIdx.x;
    const char* MG = p.ws + OFF_MG;
    auto dma = [&](int g, int buf) {
#pragma unroll
        for (int j = 0; j < 4; ++j) {
            const int pi = wid + 8 * j;
            __builtin_amdgcn_global_load_lds((const unsigned*)(MG + (size_t)(bh * 16 + g) * 32768 + pi * 1024 + lane * 16), (LAS3 unsigned*)(lds + buf * 32768 + pi * 1024 + lane * 16), 16, 0, 0);
        }
    };
    f32x4 S[8];
#pragma unroll
    for (int t = 0; t < 8; ++t) S[t] = (f32x4){0.f, 0.f, 0.f, 0.f};
    __syncthreads();
    dma(0, 0);
    asm volatile("s_waitcnt vmcnt(0)" ::: "memory");
    __syncthreads();
    for (int g = 0; g < 16; ++g) {
        if (g + 1 < 16) dma(g + 1, (g + 1) & 1);
        float4* sg = (float4*)(p.ws + OFF_SGS) + ((size_t)((bh * 16 + g) * 8 + wid) * 8) * 64 + lane;
        const float4* bg = (const float4*)(p.ws + OFF_BG) + ((size_t)((bh * 16 + g) * 8 + wid) * 8) * 64 + lane;
#pragma unroll
        for (int t = 0; t < 8; ++t) sg[t * 64] = make_float4(S[t][0], S[t][1], S[t][2], S[t][3]);
        const char* B = lds + (g & 1) * 32768 + lane * 16;
        bf16x8 Sb[4];
#pragma unroll
        for (int s = 0; s < 4; ++s) Sb[s] = pack_b(S[2 * s], S[2 * s + 1]);
#pragma unroll
        for (int t = 0; t < 8; ++t) {
            const float4 b4 = bg[t * 64];
            f32x4 a = (f32x4){b4.x, b4.y, b4.z, b4.w};
#pragma unroll
            for (int s = 0; s < 4; ++s) a = __builtin_amdgcn_mfma_f32_16x16x32_bf16(*(const bf16x8*)(B + (t * 4 + s) * 1024), Sb[s], a, 0, 0, 0);
            S[t] = a;
        }
        asm volatile("s_waitcnt vmcnt(0)" ::: "memory");
        __builtin_amdgcn_s_barrier();
    }
}

__device__ void st_scan_l3(const P& p, char* lds) {
    const int tid = tidx(), lane = tid & 63, wid = __builtin_amdgcn_readfirstlane(tid >> 6), fr = lane & 15, fg = lane >> 4;
    const float* GL = (const float*)(p.ws + OFF_GL);
    const char* KDT = p.ws + OFF_KDT; const char* QKF = p.ws + OFF_QKF;
    const char* UF = (const char*)p.out; const char* WC = (const char*)p.out + 64 * MiB; const char* QD = (const char*)p.out + 96 * MiB;
    bf16_t* ob = (bf16_t*)(p.ws + OFF_O);
    for (int blk = blockIdx.x; blk < 256; blk += gridDim.x) {
        const int g2 = blk >> 1, vh = blk & 1, bh = g2 >> 4, g = g2 & 15, b = bh >> 2, h = bh & 3;
        auto dma = [&](int i, int buf) {
            const size_t unit = (size_t)((b * 256 + g * 16 + i) * 4 + h);
            for (int pi = wid - 4; pi < 72; pi += 4) {
                const char* src;
                if (pi < 16) src = WC + unit * 16384 + pi * 1024;
                else if (pi < 32) src = QD + unit * 16384 + (pi - 16) * 1024;
                else if (pi < 48) src = KDT + unit * 16384 + (pi - 32) * 1024;
                else if (pi < 56) src = QKF + unit * 8192 + (pi - 48) * 1024;
                else src = UF + unit * 32768 + (size_t)vh * 16384 + (pi - 56) * 1024;
                __builtin_amdgcn_global_load_lds((const unsigned*)(src + lane * 16), (LAS3 unsigned*)(lds + buf * 73728 + pi * 1024 + lane * 16), 16, 0, 0);
            }
        };
        f32x4 S[8];
        if (wid < 4) {
            const float4* sg = (const float4*)(p.ws + OFF_SGS) + ((size_t)(g2 * 8 + vh * 4 + wid) * 8) * 64 + lane;
#pragma unroll
            for (int t = 0; t < 8; ++t) { const float4 s4 = sg[t * 64]; S[t] = (f32x4){s4.x, s4.y, s4.z, s4.w}; }
        }
        __syncthreads();
        if (wid >= 4) dma(0, 0);
        asm volatile("s_waitcnt vmcnt(0)" ::: "memory");
        __syncthreads();
        for (int i = 0; i < 16; ++i) {
            if (wid >= 4) {
                if (i + 1 < 16) dma(i + 1, (i + 1) & 1);
            } else {
                const int vs = vh * 4 + wid, n = g * 16 + i;
                const char* B = lds + (i & 1) * 73728 + lane * 16;
                const float egl = GL[(b * 256 + n) * 4 + h];
                bf16x8 Sb[4];
#pragma unroll
                for (int s = 0; s < 4; ++s) Sb[s] = pack_b(S[2 * s], S[2 * s + 1]);
                f32x4 vn[4], o[4];
#pragma unroll
                for (int rt = 0; rt < 4; ++rt) {
                    f32x4 pm = (f32x4){0.f, 0.f, 0.f, 0.f}, qo = pm;
#pragma unroll
                    for (int s = 0; s < 4; ++s) {
                        pm = __builtin_amdgcn_mfma_f32_16x16x32_bf16(*(const bf16x8*)(B + (rt * 4 + s) * 1024), Sb[s], pm, 0, 0, 0);
                        qo = __builtin_amdgcn_mfma_f32_16x16x32_bf16(*(const bf16x8*)(B + (16 + rt * 4 + s) * 1024), Sb[s], qo, 0, 0, 0);
                    }
                    const float4 u4 = *(const float4*)(B + (56 + 4 * wid + rt) * 1024);
                    vn[rt] = (f32x4){u4.x - pm[0], u4.y - pm[1], u4.z - pm[2], u4.w - pm[3]};
                    o[rt] = qo;
                }
                bf16x8 Vb[2];
                Vb[0] = pack_b(vn[0], vn[1]); Vb[1] = pack_b(vn[2], vn[3]);
#pragma unroll
                for (int rt = 0; rt < 4; ++rt)
#pragma unroll
                    for (int s2 = 0; s2 < 2; ++s2) o[rt] = __builtin_amdgcn_mfma_f32_16x16x32_bf16(*(const bf16x8*)(B + (48 + rt * 2 + s2) * 1024), Vb[s2], o[rt], 0, 0, 0);
#pragma unroll
                for (int kt = 0; kt < 8; ++kt) {
                    S[kt] = S[kt] * egl;
#pragma unroll
                    for (int s2 = 0; s2 < 2; ++s2) S[kt] = __builtin_amdgcn_mfma_f32_16x16x32_bf16(*(const bf16x8*)(B + (32 + kt * 2 + s2) * 1024), Vb[s2], S[kt], 0, 0, 0);
                }
                const size_t t0 = (size_t)(b * 256 + n) * 64;
#pragma unroll
                for (int rt = 0; rt < 4; ++rt)
#pragma unroll
                    for (int r = 0; r < 4; ++r) ob[(t0 + 16 * rt + 4 * fg + r) * 512 + h * 128 + vs * 16 + fr] = f2bf(o[rt][r]);
            }
            if (wid >= 4) asm volatile("s_waitcnt vmcnt(0)" ::: "memory");
            __builtin_amdgcn_s_barrier();
        }
    }
}

__device__ void st_sg_fast(const P& p, char* lds, int first, int stride) {
    const int tid = tidx(), lane = tid & 63, wid = tid >> 6, fr = lane & 15, fg = lane >> 4;
    const bf16_t* vgg = (const bf16_t*)(p.ws + OFF_VGG); const bf16_t* ug = (const bf16_t*)(p.ws + OFF_UG);
    const bf16_t* tw = (const bf16_t*)(p.ws + OFF_TRILW);
    bf16_t* ysg = (bf16_t*)(p.ws + OFF_YSG);
    bf16_t* XT = (bf16_t*)lds;
    float* mean = (float*)(lds + 147456); float* rstd = mean + 128;
    for (int unit = first; unit < T / 128; unit += stride) {
        const size_t t0 = (size_t)unit * 128;
        __syncthreads();
        for (int rr = 0; rr < 16; ++rr) {
            const int s = wid * 16 + rr;
            float v[8]; unpack8(*(const uint4*)(vgg + (t0 + s) * 512 + lane * 8), v);
            float sm = 0.f;
#pragma unroll
            for (int j = 0; j < 8; ++j) sm += v[j];
            const float mu = wave_sum(sm) * (1.f / 512.f);
            float q = 0.f;
#pragma unroll
            for (int j = 0; j < 8; ++j) { const float d = v[j] - mu; q += d * d; }
            const float rs = rsqrtf(wave_sum(q) * (1.f / 512.f) + 1e-6f);
            if (lane == 0) { mean[s] = mu; rstd[s] = rs; }
        }
        __syncthreads();
        {
            const int s = tid & 127, cq = tid >> 7;
            const float mu = mean[s], rs = rstd[s];
            for (int cc = 0; cc < 16; ++cc) {
                const int c = cq * 128 + cc * 8;
                float v[8]; unpack8(*(const uint4*)(vgg + (t0 + s) * 512 + c), v);
#pragma unroll
                for (int j = 0; j < 8; ++j) XT[(c + j) * 144 + s] = f2bf((v[j] - mu) * rs * p.sg_ln_w[c + j] + p.sg_ln_b[c + j]);
            }
        }
        __syncthreads();
        const int g = wid >> 1;
        const bf16_t* W = tw + (size_t)g * 128 * 128;
#pragma unroll
        for (int th = 0; th < 2; ++th) {
            f32x4 acc[4][4];
#pragma unroll
            for (int ci = 0; ci < 4; ++ci)
#pragma unroll
                for (int tt = 0; tt < 4; ++tt) acc[ci][tt] = (f32x4){0.f, 0.f, 0.f, 0.f};
#pragma unroll
            for (int ks = 0; ks < 4; ++ks) {
                if (ks <= 2 * th + 1) {
                    bf16x8 a[4], bw[4];
#pragma unroll
                    for (int ci = 0; ci < 4; ++ci) a[ci] = *(const bf16x8*)(XT + (64 * wid + (ci >> 1) * 32 + 8 * (fr >> 2) + (fr & 3) + 4 * (ci & 1)) * 144 + 32 * ks + 8 * fg);
#pragma unroll
                    for (int tt = 0; tt < 4; ++tt) bw[tt] = *(const bf16x8*)(W + (64 * th + 16 * tt + fr) * 128 + 32 * ks + 8 * fg);
#pragma unroll
                    for (int ci = 0; ci < 4; ++ci)
#pragma unroll
                        for (int tt = 0; tt < 4; ++tt)
                            if (2 * ks <= 4 * th + tt) acc[ci][tt] = __builtin_amdgcn_mfma_f32_16x16x32_bf16(a[ci], bw[tt], acc[ci][tt], 0, 0, 0);
                }
            }
#pragma unroll
            for (int pp = 0; pp < 2; ++pp)
#pragma unroll
                for (int tt = 0; tt < 4; ++tt) {
                    const int tl = 64 * th + 16 * tt + fr, c0 = 64 * wid + pp * 32 + 8 * fg;
                    const float bsv = p.sg_b[g * 128 + tl];
                    float u[8], o[8]; unpack8(*(const uint4*)(ug + (t0 + tl) * 512 + c0), u);
#pragma unroll
                    for (int j = 0; j < 4; ++j) { o[j] = u[j] * (acc[2 * pp][tt][j] + bsv); o[4 + j] = u[4 + j] * (acc[2 * pp + 1][tt][j] + bsv); }
                    *(uint4*)(ysg + (t0 + tl) * 512 + c0) = pack8(o);
                }
        }
    }
}

#define XB_TMO      128
#define XB_XCNT(j)  (256  + 64 * (j))
#define XB_XSUB(j)  (1280 + 64 * (j))
#define XB_XGEN(j)  (2304 + 64 * (j))
#define XB_TOP      3328
#define XB_TOPGEN   3392
#define XCD_BAR_WORDS 3456
#define XB_SPIN_CAP (1u << 18)
#define LAS __attribute__((address_space(3)))

__device__ __forceinline__ unsigned xb_ld(unsigned* p)              { return __hip_atomic_load(p, __ATOMIC_RELAXED, __HIP_MEMORY_SCOPE_AGENT); }
__device__ __forceinline__ unsigned xb_add(unsigned* p, unsigned v) { return __hip_atomic_fetch_add(p, v, __ATOMIC_RELAXED, __HIP_MEMORY_SCOPE_AGENT); }
__device__ __forceinline__ unsigned xb_xcc_id() { return (unsigned)__builtin_amdgcn_s_getreg((3 << 11) | 20) & 0xFu; }
#define XB_SPIN(cond, bar) do { unsigned _sp = 0; while (cond) { __builtin_amdgcn_s_sleep(1); \
    if ((++_sp & 255u) == 0u) { if (xb_ld(&(bar)[XB_TMO])) break; if (_sp > XB_SPIN_CAP) { atomicAdd(&(bar)[XB_TMO], 1u); break; } } } } while (0)

struct XcdBarrier {
    unsigned* bar; unsigned x;
    volatile LAS unsigned* st;
};

__device__ __forceinline__ XcdBarrier xcd_barrier_post(unsigned* bar, volatile LAS unsigned* st) {
    XcdBarrier b; b.bar = bar; b.x = xb_xcc_id(); b.st = st;
    if (threadIdx.x == 0) (void)xb_add(&bar[XB_XCNT(b.x)], 1u);
    return b;
}
__device__ __forceinline__ void xcd_barrier_complete(unsigned* bar, unsigned x, unsigned& nloc, unsigned& nx) {
    const unsigned G = gridDim.x * gridDim.y * gridDim.z;
    unsigned sum, cnt, mine, sp = 0u;
    for (;;) {
        sum = 0u; cnt = 0u; mine = 0u;
#pragma unroll
        for (unsigned j = 0; j < 16; ++j) { const unsigned c = xb_ld(&bar[XB_XCNT(j)]); sum += c; cnt += (c > 0u) ? 1u : 0u; mine = (j == x) ? c : mine; }
        if (sum == G) break;
        __builtin_amdgcn_s_sleep(1);
        if ((++sp & 255u) == 0u) { if (xb_ld(&bar[XB_TMO])) break; if (sp > XB_SPIN_CAP) { atomicAdd(&bar[XB_TMO], 1u); break; } }
    }
    nloc = mine > 0u ? mine : 1u; nx = cnt > 0u ? cnt : 1u;
}

__device__ __forceinline__ void xcd_barrier(const XcdBarrier& b) {
    asm volatile("s_waitcnt vmcnt(0)" ::: "memory");
    __syncthreads();
    if (threadIdx.x == 0) {
        unsigned* bar = b.bar;
        __builtin_amdgcn_s_waitcnt(0);
        unsigned nloc = b.st[0], nx = b.st[1];
        if (nloc == 0u) { xcd_barrier_complete(bar, b.x, nloc, nx); b.st[0] = nloc; b.st[1] = nx; }
        const unsigned old = xb_add(&bar[XB_XSUB(b.x)], 1u);
        const unsigned gen = old / nloc;
        if (old + 1u == (gen + 1u) * nloc) {
            __builtin_amdgcn_fence(__ATOMIC_RELEASE, "agent");
            asm volatile("s_waitcnt vmcnt(0)" ::: "memory");
            const unsigned og = xb_add(&bar[XB_TOP], 1u);
            const unsigned tg = og / nx;
            if (og + 1u == (tg + 1u) * nx) xb_add(&bar[XB_TOPGEN], 1u);
            else XB_SPIN(xb_ld(&bar[XB_TOPGEN]) == tg, bar);
            __builtin_amdgcn_fence(__ATOMIC_ACQUIRE, "agent");
            xb_add(&bar[XB_XGEN(b.x)], 1u);
            asm volatile("s_waitcnt vmcnt(0)" ::: "memory");
        } else {
            XB_SPIN(xb_ld(&bar[XB_XGEN(b.x)]) == gen, bar);
            __builtin_amdgcn_fence(__ATOMIC_ACQUIRE, "agent");
            asm volatile("s_waitcnt vmcnt(0)" ::: "memory");
        }
    }
    __syncthreads();
}


constexpr size_t OFF_BAR = 480 * MiB + 256 * 1024;
constexpr int LDS_BARW = 152 * 1024 - 16;

constexpr int NSTAGE = 15;
#ifndef NP2
#define NP2 1
#endif
#ifndef ABL2
#define ABL2 0
#endif
#ifndef NP3
#define NP3 1
#endif
#ifndef ABL3
#define ABL3 0
#endif
#ifndef NP7
#define NP7 1
#endif
#ifndef NP9
#define NP9 1
#endif
#ifndef NP10
#define NP10 1
#endif
constexpr int NSTG = 11;
template <int S> __device__ __forceinline__ void run_stage(const P& p, float* lds) {
    if constexpr (S == 0) { st_mod(p, lds); st_convert(p, lds); }
    else if constexpr (S == 1) st_hm(p, lds);
    else if constexpr (S == 2) {
#pragma nounroll
        for (int ps = 0; ps < NP2; ++ps) st_inproj_fast(p, (char*)lds, ps == NP2 - 1 ? 0 : ABL2);
    }
    else if constexpr (S == 3) {
#pragma nounroll
        for (int ps = 0; ps < NP3; ++ps) st_dnprep_fast(p, (char*)lds, ps == NP3 - 1 ? 0 : ABL3);
    }
    else if constexpr (S == 4) st_scan_l1(p, (char*)lds);
    else if constexpr (S == 5) {
        if (blockIdx.x < 8) st_scan_l2(p, (char*)lds);
        st_sg_fast(p, (char*)lds, blockIdx.x < 8 ? 248 + (int)blockIdx.x : (int)blockIdx.x - 8, 256);
    }
    else if constexpr (S == 6) st_scan_l3(p, (char*)lds);
    else if constexpr (S == 7) {
#pragma nounroll
        for (int ps = 0; ps < NP7; ++ps) st_post_fast(p, (char*)lds, ps == NP7 - 1);
    }
    else if constexpr (S == 8 || S == 9) {
#pragma nounroll
        for (int ps = 0; ps < (S == 9 ? NP9 : 1); ++ps) st_moe_fast(p, (char*)lds, S == 8 || ps == NP9 - 1, S == 8 ? 1 : 0);
    }
    else if constexpr (S == 10) {
#pragma nounroll
        for (int ps = 0; ps < NP10; ++ps) st_combine(p, ps == NP10 - 1, lds);
    }
}

constexpr int LDS_BYTES = 152 * 1024;

#if !MEGA
template <int S> __global__ void __launch_bounds__(NT) k_stage(P p) {
    extern __shared__ __attribute__((aligned(16))) float lds[];
    run_stage<S>(p, lds);
}
template <int S> static void launch_all(const P& p, int grid, hipStream_t stream) {
    if constexpr (S < NSTG) {
        (void)hipFuncSetAttribute((const void*)k_stage<S>, hipFuncAttributeMaxDynamicSharedMemorySize, LDS_BYTES);
        k_stage<S><<<grid, NT, LDS_BYTES, stream>>>(p);
        launch_all<S + 1>(p, grid, stream);
    }
}
#else
template <int S> __device__ __forceinline__ void run_from(const P& p, float* lds, const XcdBarrier& bar) {
    if constexpr (S < NSTG) {
        run_stage<S>(p, lds);
#ifdef PROBE_REPEAT
        if constexpr (S == PROBE_REPEAT) { xcd_barrier(bar); run_stage<S>(p, lds); }
#endif
        if constexpr (S < NSTG - 1) xcd_barrier(bar);
        run_from<S + 1>(p, lds, bar);
    }
}
__global__ void __launch_bounds__(NT) k_mega(P p) {
    extern __shared__ __attribute__((aligned(16))) float lds[];
    volatile LAS unsigned* st = (volatile LAS unsigned*)((LAS char*)lds + LDS_BARW);
    if (threadIdx.x == 0) { st[0] = 0u; st[1] = 0u; }
    __syncthreads();
    const XcdBarrier bar = xcd_barrier_post((unsigned*)(p.ws + OFF_BAR), st);
#if USE_CG_SYNC
    cg::this_grid().sync();
#endif
    run_from<0>(p, lds, bar);
}
#endif

extern "C" void kernel_launch(void* const* d_in, const int* in_sizes, int n_in, void* d_out, int out_size, void* d_ws, size_t ws_size,
                              hipStream_t stream) {
    if (n_in != 30 || out_size != T * D || ws_size < WS_NEED) {
        fprintf(stderr, "kernel_launch: unexpected problem (n_in %d, out %d, ws %zu)\n", n_in, out_size, ws_size);
        return;
    }
    P p{};
    const float** f = (const float**)&p;
    for (int i = 0; i < 30; ++i) f[i] = (const float*)d_in[i];
    p.out = (float*)d_out;
    p.ws = (char*)d_ws;
    static int grid = 0;
    if (!grid) {
        int dev = 0, cus = 0;
        (void)hipGetDevice(&dev);
        (void)hipDeviceGetAttribute(&cus, hipDeviceAttributeMultiprocessorCount, dev);
#if MEGA
        int per_cu = 0;
        (void)hipFuncSetAttribute((const void*)k_mega, hipFuncAttributeMaxDynamicSharedMemorySize, LDS_BYTES);
        (void)hipOccupancyMaxActiveBlocksPerMultiprocessor(&per_cu, (const void*)k_mega, NT, LDS_BYTES);
        if (per_cu < 1) per_cu = 1;
        if (per_cu > 1) per_cu = 1;
        grid = cus * per_cu;
#else
        grid = cus;
#endif
    }
#if MEGA
    (void)hipMemsetAsync((char*)d_ws + OFF_BAR, 0, XCD_BAR_WORDS * sizeof(unsigned), stream);
    void* args[] = {&p};
    hipError_t e = hipLaunchCooperativeKernel((const void*)k_mega, dim3(grid), dim3(NT), args, LDS_BYTES, stream);
    if (e != hipSuccess) fprintf(stderr, "cooperative launch failed: %s (grid %d)\n", hipGetErrorString(e), grid);
#else
    launch_all<0>(p, grid, stream);
#endif
}
```
